# Optimizing an MI355X kernel written in HIP

```python
import jax
import jax.numpy as jnp
from jax import lax
import numpy as np

D_MODEL = 2048
BATCH = 8
SEQ = 2048
DEPTH = 2

GRID_W = 64
CTX_LEN = 256
HA = 8
DH_A = 64
WIN_ROWS = 8
WIN_COLS = 16
HB = 4
DK_B = 128
DV_B = 256
DEC_RANK = 16
GATE_TAU = 16.0
GLA_CHUNK = 64
GC = 4
CG = 128
MIX_CHUNK = 128
N_EXPERTS = 16
EXPERT_FF = 2048
CAP_FACTOR = 2
ROPE_BASE = 10000.0
EPS = 1e-6

WA = HA * DH_A
KB = HB * DK_B
VB = HB * DV_B
WC = GC * CG
MIX_WIDTH = WA + VB + WC
IN_SPLITS = (WA, WA, WA, KB, VB, 2 * DEC_RANK, KB, VB, WC, WC)
N_IN = sum(IN_SPLITS)
CTX_SPLITS = (WA, WA, KB, VB, 2 * DEC_RANK)
CTX_KV_END = WA + sum(CTX_SPLITS)

kernel_name = 'hybrid_na_gla_gmlp_ecmoe_block'


def _split(t, sizes):
    cuts = [int(s) for s in np.cumsum(sizes)[:-1]]
    return jnp.split(t, cuts, axis=-1)


def _heads(t, n):
    return t.reshape(t.shape[:-1] + (n, t.shape[-1] // n))


def rmsnorm(x, g):
    xf = x.astype(jnp.float32)
    y = xf * lax.rsqrt(jnp.mean(xf * xf, axis=-1, keepdims=True) + EPS)
    return y.astype(x.dtype) * g


def layernorm(x, g, b):
    xf = x.astype(jnp.float32)
    mu = jnp.mean(xf, axis=-1, keepdims=True)
    var = jnp.mean(jnp.square(xf - mu), axis=-1, keepdims=True)
    return ((xf - mu) * lax.rsqrt(var + EPS)).astype(x.dtype) * g + b


def modulate(h, shift, scale):
    return h * (1 + scale) + shift


def axial_rope_tables(n_tok):
    t = jnp.arange(n_tok)
    half = DK_B // 2
    inv = ROPE_BASE ** (-jnp.arange(0, half, 2, dtype=jnp.float32) / half)

    def tab(pos):
        ang = pos.astype(jnp.float32)[:, None] * inv[None, :]
        return jnp.concatenate([ang, ang], axis=-1)

    ang = jnp.concatenate([tab(t // GRID_W), tab(t % GRID_W)], axis=-1)
    return jnp.cos(ang), jnp.sin(ang)


def apply_axial_rope(x, cos, sin):
    qd = DK_B // 4
    z = x.reshape(x.shape[:-1] + (2, 2, qd))
    rot = jnp.concatenate([-z[..., 1:, :], z[..., :1, :]], axis=-2).reshape(x.shape)
    cos = cos.astype(x.dtype)[None, :, None, :]
    sin = sin.astype(x.dtype)[None, :, None, :]
    return x * cos + rot * sin


def neighbourhood_attention(q, k, v, k_ctx, v_ctx, rpb, rows):
    bsz = q.shape[0]
    wr = min(WIN_ROWS, rows)
    r = np.arange(rows)
    row_idx = np.clip(r - wr // 2, 0, rows - wr)[:, None] + np.arange(wr)[None, :]
    cq = np.arange(GRID_W)
    col_start = np.clip(cq - WIN_COLS // 2, 0, GRID_W - WIN_COLS)
    col_mask = (cq[None, :] >= col_start[:, None]) & (cq[None, :] < col_start[:, None] + WIN_COLS)
    dr = row_idx - r[:, None] + WIN_ROWS - 1
    dc = np.clip(cq[None, :] - cq[:, None] + WIN_COLS - 1, 0, 2 * WIN_COLS - 2)
    bias = rpb[:, dr[:, None, :, None], dc[None, :, None, :]]
    qg = q.reshape(bsz, rows, GRID_W, HA, DH_A)
    kw = k.reshape(bsz, rows, GRID_W, HA, DH_A)[:, row_idx]
    vw = v.reshape(bsz, rows, GRID_W, HA, DH_A)[:, row_idx]
    s_loc = jnp.einsum('brqhd,brikhd->bhrqik', qg, kw).astype(jnp.float32) + bias[None].astype(jnp.float32)
    s_loc = jnp.where(col_mask[None, None, None, :, None, :], s_loc, -jnp.inf)
    s_loc = s_loc.reshape(bsz, HA, rows, GRID_W, wr * GRID_W)
    s_ctx = jnp.einsum('brqhd,blhd->bhrql', qg, k_ctx).astype(jnp.float32)
    p = jax.nn.softmax(jnp.concatenate([s_loc, s_ctx], axis=-1), axis=-1).astype(v.dtype)
    p_loc = p[..., :wr * GRID_W].reshape(bsz, HA, rows, GRID_W, wr, GRID_W)
    p_ctx = p[..., wr * GRID_W:]
    o = jnp.einsum('bhrqik,brikhd->brqhd', p_loc, vw) + jnp.einsum('bhrql,blhd->brqhd', p_ctx, v_ctx)
    return o.reshape(bsz, rows * GRID_W, WA)


def context_attention(q, k, v):
    s = jnp.einsum('blhd,bmhd->bhlm', q, k).astype(jnp.float32)
    p = jax.nn.softmax(s, axis=-1).astype(v.dtype)
    o = jnp.einsum('bhlm,bmhd->blhd', p, v)
    return o.reshape(o.shape[:2] + (WA,))


def log_decays(dec, w_dec, b_dec):
    def one(z):
        return (jax.nn.log_sigmoid(z.astype(jnp.float32)) / GATE_TAU).reshape(z.shape[:-1] + (HB, DK_B))
    z_f = dec[..., :DEC_RANK] @ w_dec[0] + b_dec[0]
    z_b = dec[..., DEC_RANK:] @ w_dec[1] + b_dec[1]
    return one(z_f), one(z_b)


def gla_scan(q, k, v, log_a, s0):
    bsz, n, h, _ = q.shape
    nc = n // GLA_CHUNK

    def chunks(a):
        a = a.astype(jnp.float32)
        return jnp.moveaxis(a.reshape((bsz, nc, GLA_CHUNK) + a.shape[2:]), 1, 0)

    tril = jnp.tril(jnp.ones((GLA_CHUNK, GLA_CHUNK), dtype=bool))[None, :, :, None, None]

    def step(s, inp):
        qc, kc, vc, lc = inp
        b = jnp.cumsum(lc, axis=1)
        o_inter = jnp.einsum('bihk,bhkv->bihv', qc * jnp.exp(b), s)
        dec = jnp.exp(jnp.where(tril, b[:, :, None] - b[:, None, :], -jnp.inf))
        att = jnp.einsum('bihk,bjhk,bijhk->bhij', qc, kc, dec)
        o_intra = jnp.einsum('bhij,bjhv->bihv', att, vc)
        b_last = b[:, -1]
        s = jnp.exp(b_last)[..., None] * s + jnp.einsum('bjhk,bjhv->bhkv', kc * jnp.exp(b_last[:, None] - b), vc)
        return s, o_inter + o_intra

    s_fin, o = lax.scan(step, s0, (chunks(q), chunks(k), chunks(v), chunks(log_a)))
    o = jnp.moveaxis(o, 0, 1).reshape(bsz, n, h, v.shape[-1])
    return o, s_fin


def gla_bidir(q, k, v, la_f, la_b, s0_f, s0_b):
    flip = lambda a: jnp.flip(a, axis=1)
    o_f, s_f = gla_scan(q, k, v, la_f, s0_f)
    o_b, s_b = gla_scan(flip(q), flip(k), flip(v), flip(la_b), s0_b)
    return o_f + flip(o_b), s_f, s_b


def gla_final_state(k, v, log_a):
    b = jnp.cumsum(log_a, axis=1)
    w = jnp.exp(b[:, -1:] - b)
    return jnp.einsum('bthk,bthv->bhkv', k.astype(jnp.float32) * w, v.astype(jnp.float32))


def gla_output(o, g, gain):
    o = rmsnorm(o.astype(g.dtype), gain.reshape(HB, DV_B))
    return o.reshape(g.shape) * jax.nn.silu(g)


def chunk_mlp(u, v, ln_g, ln_b, w_sp, b_sp):
    bsz, n, _ = u.shape
    u = jax.nn.gelu(u)
    v = jax.nn.gelu(v)
    v = layernorm(_heads(v, GC), ln_g.reshape(GC, CG), ln_b.reshape(GC, CG))
    v = v.reshape(bsz, n // MIX_CHUNK, MIX_CHUNK, GC, CG)
    s = jnp.einsum('gpq,bnqgc->bnpgc', w_sp, v) + b_sp.T[:, :, None]
    return u * s.reshape(bsz, n, WC)


def ec_moe(h, w_router, w_gate, w_up, w_down):
    bsz, n, d = h.shape
    cap = CAP_FACTOR * n // N_EXPERTS
    aff = jax.nn.softmax((h @ w_router).astype(jnp.float32), axis=-1)
    g, idx = lax.top_k(jnp.swapaxes(aff, 1, 2), cap)
    xs = jax.vmap(lambda hb, ib: hb[ib])(h, idx)
    a = jnp.einsum('becd,edf->becf', xs, w_gate)
    u = jnp.einsum('becd,edf->becf', xs, w_up)
    y = jnp.einsum('becf,efd->becd', jax.nn.silu(a) * u, w_down) * g[..., None].astype(h.dtype)
    return jax.vmap(lambda yb, ib: jnp.zeros((n, d), yb.dtype).at[ib.reshape(-1)].add(yb.reshape(-1, d)))(y, idx)


def setup_inputs(seed: int = 0) -> dict:
    key = jax.random.key(seed)
    ks = jax.random.split(key, 24)
    f32 = jnp.float32
    D = D_MODEL

    def nrm(k, shape, scale):
        return jax.random.normal(k, shape, f32) * scale

    return {
        'x': nrm(ks[0], (BATCH, SEQ, D), 1.0),
        'c': nrm(ks[1], (BATCH, D), 1.0),
        'ctx': nrm(ks[2], (BATCH, CTX_LEN, D), 1.0),
        'c_ctx': nrm(ks[3], (D,), 1.0),
        'w_ada': nrm(ks[4], (DEPTH, D, 6 * D), 0.5 * D ** -0.5),
        'b_ada': nrm(ks[5], (DEPTH, 6 * D), 0.02),
        'g_pre_mix': 1.0 + nrm(ks[6], (DEPTH, D), 0.1),
        'g_post_mix': 1.0 + nrm(ks[7], (DEPTH, D), 0.1),
        'g_pre_ffn': 1.0 + nrm(ks[8], (DEPTH, D), 0.1),
        'g_post_ffn': 1.0 + nrm(ks[9], (DEPTH, D), 0.1),
        'w_in': nrm(ks[10], (DEPTH, D, N_IN), D ** -0.5),
        'w_dec': nrm(ks[11], (DEPTH, 2, DEC_RANK, KB), DEC_RANK ** -0.5),
        'b_dec': nrm(ks[12], (DEPTH, 2, KB), 0.5),
        'rpb': nrm(ks[13], (DEPTH, HA, 2 * WIN_ROWS - 1, 2 * WIN_COLS - 1), 0.2),
        'g_gla': 1.0 + nrm(ks[14], (DEPTH, VB), 0.1),
        'ln_v_g': 1.0 + nrm(ks[15], (DEPTH, WC), 0.1),
        'ln_v_b': nrm(ks[16], (DEPTH, WC), 0.02),
        'w_sp': nrm(ks[17], (DEPTH, GC, MIX_CHUNK, MIX_CHUNK), MIX_CHUNK ** -0.5),
        'b_sp': 1.0 + nrm(ks[18], (DEPTH, GC, MIX_CHUNK), 0.1),
        'w_out': nrm(ks[19], (DEPTH, MIX_WIDTH, D), MIX_WIDTH ** -0.5),
        'w_router': nrm(ks[20], (DEPTH, D, N_EXPERTS), D ** -0.5),
        'w_gate': nrm(ks[21], (DEPTH, N_EXPERTS, D, EXPERT_FF), D ** -0.5),
        'w_up': nrm(ks[22], (DEPTH, N_EXPERTS, D, EXPERT_FF), D ** -0.5),
        'w_down': nrm(ks[23], (DEPTH, N_EXPERTS, EXPERT_FF, D), EXPERT_FF ** -0.5),
    }


def reference(x, c, ctx, c_ctx, w_ada, b_ada, g_pre_mix, g_post_mix, g_pre_ffn, g_post_ffn,
              w_in, w_dec, b_dec, rpb, g_gla, ln_v_g, ln_v_b, w_sp, b_sp, w_out,
              w_router, w_gate, w_up, w_down):
    bsz, n_tok, d = x.shape
    rows = n_tok // GRID_W
    cos, sin = axial_rope_tables(n_tok)
    s_lat = jax.nn.silu(c)
    s_ctx = jax.nn.silu(c_ctx)
    zero_state = jnp.zeros((bsz, HB, DK_B, DV_B), jnp.float32)
    q_scale_a = DH_A ** -0.5
    q_scale_b = DK_B ** -0.5
    xc = ctx
    for l in range(DEPTH):
        last = l == DEPTH - 1
        sh1, sc1, gt1, sh2, sc2, gt2 = jnp.split((s_lat @ w_ada[l] + b_ada[l])[:, None, :], 6, axis=-1)
        n_mod = 2 if last else 6
        modc = jnp.split(s_ctx @ w_ada[l][:, :n_mod * d] + b_ada[l][:n_mod * d], n_mod)

        h = modulate(rmsnorm(x, g_pre_mix[l]), sh1, sc1)
        qa, ka, va, kb, vb, dec, qb, gb, uc, vc = _split(h @ w_in[l], IN_SPLITS)
        hc = modulate(rmsnorm(xc, g_pre_mix[l]), modc[0], modc[1])
        if last:
            kac, vac, kbc, vbc, decc = _split(hc @ w_in[l][:, WA:CTX_KV_END], CTX_SPLITS)
        else:
            qac, kac, vac, kbc, vbc, decc, qbc, gbc, ucc, vcc = _split(hc @ w_in[l], IN_SPLITS)
        kac_h, vac_h = _heads(kac, HA), _heads(vac, HA)

        o_a = neighbourhood_attention(_heads(qa, HA) * q_scale_a, _heads(ka, HA), _heads(va, HA),
                                      kac_h, vac_h, rpb[l], rows)

        la_f, la_b = log_decays(dec, w_dec[l], b_dec[l])
        lac_f, lac_b = log_decays(decc, w_dec[l], b_dec[l])
        kbc_h, vbc_h = _heads(kbc, HB), _heads(vbc, HB)
        if last:
            st_f = gla_final_state(kbc_h, vbc_h, lac_f)
            st_b = gla_final_state(jnp.flip(kbc_h, 1), jnp.flip(vbc_h, 1), jnp.flip(lac_b, 1))
        else:
            o_bc, st_f, st_b = gla_bidir(_heads(qbc, HB) * q_scale_b, kbc_h, vbc_h, lac_f, lac_b,
                                         zero_state, zero_state)
        qb_h = apply_axial_rope(_heads(qb, HB), cos, sin) * q_scale_b
        kb_h = apply_axial_rope(_heads(kb, HB), cos, sin)
        o_b, _, _ = gla_bidir(qb_h, kb_h, _heads(vb, HB), la_f, la_b, st_f, st_b)

        o_c = chunk_mlp(uc, vc, ln_v_g[l], ln_v_b[l], w_sp[l], b_sp[l])

        y = jnp.concatenate([o_a, gla_output(o_b, gb, g_gla[l]), o_c], axis=-1) @ w_out[l]
        x = x + gt1 * rmsnorm(y, g_post_mix[l])
        if not last:
            o_ac = context_attention(_heads(qac, HA) * q_scale_a, kac_h, vac_h)
            o_cc = chunk_mlp(ucc, vcc, ln_v_g[l], ln_v_b[l], w_sp[l], b_sp[l])
            yc = jnp.concatenate([o_ac, gla_output(o_bc, gbc, g_gla[l]), o_cc], axis=-1) @ w_out[l]
            xc = xc + modc[2] * rmsnorm(yc, g_post_mix[l])

        h2 = modulate(rmsnorm(x, g_pre_ffn[l]), sh2, sc2)
        x = x + gt2 * rmsnorm(ec_moe(h2, w_router[l], w_gate[l], w_up[l], w_down[l]), g_post_ffn[l])
        if not last:
            hc2 = modulate(rmsnorm(xc, g_pre_ffn[l]), modc[3], modc[4])
            xc = xc + modc[5] * rmsnorm(ec_moe(hc2, w_router[l], w_gate[l], w_up[l], w_down[l]), g_post_ffn[l])
    return x
```

```cpp
#include <hip/hip_runtime.h>
#include <cstdio>
#include <cstdint>

#ifndef MK_N_LAUNCHES
#define MK_N_LAUNCHES 1
#endif

namespace pg8 {
#define PG8_LAS __attribute__((address_space(3)))
typedef unsigned short bf16_t;
typedef short bf16x8 __attribute__((ext_vector_type(8)));
typedef float f32x4 __attribute__((ext_vector_type(4)));
typedef unsigned u32x4 __attribute__((ext_vector_type(4)));
constexpr int BM = 256, BK = 64, HALF = 128, HTB = HALF * BK * 2  , STAGE_BYTES = 8 * HTB, NXCD = 8, WGM = 8;

__host__ __device__ __forceinline__ int lds_byte(int r, int c) { const int st = (r >> 4) * 2 + (c >> 5), rr = r & 15, cc = c & 31, ob = rr * 64 + cc * 2; return st * 1024 + (ob ^ (((ob >> 9) & 1) << 5)); }
__host__ __device__ __forceinline__ void stage_rc(int b, int& R, int& C) { const int st = b / 1024, sb = b % 1024, swz = sb ^ (((sb >> 9) & 1) << 5); R = (st >> 1) * 16 + swz / 64; C = (st & 1) * 32 + (swz % 64) / 2; }
__host__ __device__ __forceinline__ int perm32(int rho) { const int n = rho >> 4, i = rho & 15; return 8 * (i >> 2) + 4 * n + (i & 3); }

struct Unit { int pm, pn, last; };
struct Gemm { const bf16_t* A; const bf16_t* Bt; int M, N, K; };

typedef __bf16 hwbf16x2_t __attribute__((ext_vector_type(2))); typedef float f32x2_cv __attribute__((ext_vector_type(2)));
__device__ __forceinline__ unsigned cvt_pk_bf16(float lo, float hi) { const f32x2_cv v = {lo, hi}; const hwbf16x2_t b = __builtin_convertvector(v, hwbf16x2_t); return __builtin_bit_cast(unsigned, b); }
typedef float f32x2 __attribute__((ext_vector_type(2)));
typedef int i32x4 __attribute__((ext_vector_type(4)));
__device__ __forceinline__ f32x4 mma16(bf16x8 a, bf16x8 b, f32x4 c) { return __builtin_amdgcn_mfma_f32_16x16x32_bf16(a, b, c, 0, 0, 0); }
__device__ __forceinline__ i32x4 mma16(bf16x8 a, bf16x8 b, i32x4 c) { return __builtin_amdgcn_mfma_i32_16x16x64_i8(__builtin_bit_cast(i32x4, a), __builtin_bit_cast(i32x4, b), c, 0, 0, 0); }
__device__ __forceinline__ void tile_of(int wgid, int nM, int nN, int& pm, int& pn) {
    const int nwg = nM * nN;
    { const int q = nwg / NXCD, r = nwg % NXCD, xcd = wgid % NXCD, off = wgid / NXCD; wgid = (xcd < r ? xcd * (q + 1) : r * (q + 1) + (xcd - r) * q) + off; }
    const int nig = WGM * nN, gid = wgid / nig, fm = gid * WGM, gsz = (nM - fm) < WGM ? (nM - fm) : WGM;
    pm = fm + ((wgid % nig) % gsz); pn = (wgid % nig) / gsz;
}
struct GroupedOrder {
    int mM, mN, per, total, G, c; unsigned* sig;
    __device__ __forceinline__ void init(int E, int mM_, int mN_, int G_, int c_, unsigned* sig_ = nullptr) { mM = mM_; mN = mN_; per = mM * mN; total = E * per; G = G_; c = c_; sig = sig_; }
    __device__ __forceinline__ bool next(int i, Unit& u) const {
        const long L = (long)i * G + c; if (L >= total) return false;
        const int e = (int)(L / per), l = (int)(L % per); int pm, pn; tile_of(l, mM, mN, pm, pn);
        u.pm = e * mM + pm; u.pn = e * mN + pn; u.last = (i == (total + G - 1) / G - 1) ? 1 : 0; return true;
    }
    __device__ __forceinline__ void a_ready(const Unit& u) const { if (sig && u.last && threadIdx.x == 0) __hip_atomic_store(sig, 1u, __ATOMIC_RELAXED, __HIP_MEMORY_SCOPE_AGENT); }
    __device__ __forceinline__ void done(const Unit&) const {}
};
__device__ __forceinline__ float xmax16(float v) { const auto r = __builtin_amdgcn_permlane16_swap(__builtin_bit_cast(unsigned, v), __builtin_bit_cast(unsigned, v), false, false); return fmaxf(__builtin_bit_cast(float, r[0]), __builtin_bit_cast(float, r[1])); }
__device__ __forceinline__ float xmax32(float v) { const auto r = __builtin_amdgcn_permlane32_swap(__builtin_bit_cast(unsigned, v), __builtin_bit_cast(unsigned, v), false, false); return fmaxf(__builtin_bit_cast(float, r[0]), __builtin_bit_cast(float, r[1])); }
__device__ __forceinline__ float xsum16(float v) { const auto r = __builtin_amdgcn_permlane16_swap(__builtin_bit_cast(unsigned, v), __builtin_bit_cast(unsigned, v), false, false); return __builtin_bit_cast(float, r[0]) + __builtin_bit_cast(float, r[1]); }
__device__ __forceinline__ float xsum32(float v) { const auto r = __builtin_amdgcn_permlane32_swap(__builtin_bit_cast(unsigned, v), __builtin_bit_cast(unsigned, v), false, false); return __builtin_bit_cast(float, r[0]) + __builtin_bit_cast(float, r[1]); }
__device__ __forceinline__ float silu_f(float x) { return x * __builtin_amdgcn_rcpf(1.0f + __expf(-x)); }
struct EpiStore {
    static constexpr bool PERM = true, AFTER_DRAIN = false; typedef f32x4 acc_t;
    bf16_t* O; int ldc; int nN;
    __device__ __forceinline__ void operator()(const f32x4 (&acc)[2][2][4][2], const Unit& u, int wr, int wc, int fr, int fq) const {
        const int row0 = u.pm * BM + wr * 64 + fr, col0 = (u.pn % nN) * BM + wc * 32 + 8 * fq;
#pragma unroll
        for (int ai = 0; ai < 2; ++ai)
#pragma unroll
            for (int m = 0; m < 4; ++m) { bf16_t* rowp = O + (size_t)(row0 + ai * HALF + m * 16) * ldc + col0;
#pragma unroll
                for (int bj = 0; bj < 2; ++bj) { const f32x4 v0 = acc[ai][bj][m][0], v1 = acc[ai][bj][m][1];
                    u32x4 w; w.x = cvt_pk_bf16(v0[0], v0[1]); w.y = cvt_pk_bf16(v0[2], v0[3]); w.z = cvt_pk_bf16(v1[0], v1[1]); w.w = cvt_pk_bf16(v1[2], v1[3]);
                    *(u32x4*)(rowp + bj * HALF) = w; } }
    }
};
struct EpiSwiGLU {
    static constexpr bool PERM = true, AFTER_DRAIN = false; typedef f32x4 acc_t;
    bf16_t* O; int ldc; int nN;
    __device__ __forceinline__ void operator()(const f32x4 (&acc)[2][2][4][2], const Unit& u, int wr, int wc, int fr, int fq) const {
        const int row0 = u.pm * BM + wr * 64 + fr, col0 = (u.pn % nN) * HALF + wc * 32 + 8 * fq;
#pragma unroll
        for (int ai = 0; ai < 2; ++ai)
#pragma unroll
            for (int m = 0; m < 4; ++m) { bf16_t* rowp = O + (size_t)(row0 + ai * HALF + m * 16) * ldc + col0;
                f32x4 a0 = acc[ai][0][m][0], a1 = acc[ai][0][m][1]; const f32x4 b0 = acc[ai][1][m][0], b1 = acc[ai][1][m][1];
#pragma unroll
                for (int j = 0; j < 4; ++j) { a0[j] = silu_f(a0[j]) * b0[j]; a1[j] = silu_f(a1[j]) * b1[j]; }
                u32x4 w; w.x = cvt_pk_bf16(a0[0], a0[1]); w.y = cvt_pk_bf16(a0[2], a0[3]); w.z = cvt_pk_bf16(a1[0], a1[1]); w.w = cvt_pk_bf16(a1[2], a1[3]);
                *(u32x4*)rowp = w; }
    }
};
struct EpiStoreI8 {
    static constexpr bool PERM = true, AFTER_DRAIN = false; typedef i32x4 acc_t;
    bf16_t* O; int ldc; int nN; const float* sa; const float* sb;
    __device__ __forceinline__ void operator()(const i32x4 (&acc)[2][2][4][2], const Unit& u, int wr, int wc, int fr, int fq) const {
        const int row0 = u.pm * BM + wr * 64 + fr, col0 = (u.pn % nN) * BM + wc * 32 + 8 * fq; const float* sbp = sb + (size_t)u.pn * BM + wc * 32 + 8 * fq;
        f32x4 bs[2][2];
#pragma unroll
        for (int bj = 0; bj < 2; ++bj) { bs[bj][0] = *(const f32x4*)(sbp + bj * HALF); bs[bj][1] = *(const f32x4*)(sbp + bj * HALF + 4); }
#pragma unroll
        for (int ai = 0; ai < 2; ++ai)
#pragma unroll
            for (int m = 0; m < 4; ++m) { const int row = row0 + ai * HALF + m * 16; const float as = sa[row]; bf16_t* rowp = O + (size_t)row * ldc + col0;
#pragma unroll
                for (int bj = 0; bj < 2; ++bj) { const i32x4 i0 = acc[ai][bj][m][0], i1 = acc[ai][bj][m][1]; f32x4 v0, v1;
#pragma unroll
                    for (int j = 0; j < 4; ++j) { v0[j] = (float)i0[j] * as * bs[bj][0][j]; v1[j] = (float)i1[j] * as * bs[bj][1][j]; }
                    u32x4 w; w.x = cvt_pk_bf16(v0[0], v0[1]); w.y = cvt_pk_bf16(v0[2], v0[3]); w.z = cvt_pk_bf16(v1[0], v1[1]); w.w = cvt_pk_bf16(v1[2], v1[3]);
                    *(u32x4*)(rowp + bj * HALF) = w; } }
    }
};
struct EpiSwiGLUI8 {
    static constexpr bool PERM = true, AFTER_DRAIN = false; typedef i32x4 acc_t;
    bf16_t* O; int ldc; int nN; const float* sa; const float* sb; float* TM;
    __device__ __forceinline__ void operator()(const i32x4 (&acc)[2][2][4][2], const Unit& u, int wr, int wc, int fr, int fq) const {
        const int pnl = u.pn % nN, row0 = u.pm * BM + wr * 64 + fr, col0 = pnl * HALF + wc * 32 + 8 * fq; const float* sbp = sb + (size_t)u.pn * BM + wc * 32 + 8 * fq;
        f32x4 bs[2][2];
#pragma unroll
        for (int bj = 0; bj < 2; ++bj) { bs[bj][0] = *(const f32x4*)(sbp + bj * HALF); bs[bj][1] = *(const f32x4*)(sbp + bj * HALF + 4); }
#pragma unroll
        for (int ai = 0; ai < 2; ++ai)
#pragma unroll
            for (int m = 0; m < 4; ++m) { const int row = row0 + ai * HALF + m * 16; const float as = sa[row]; bf16_t* rowp = O + (size_t)row * ldc + col0;
                const i32x4 g0 = acc[ai][0][m][0], g1 = acc[ai][0][m][1], u0 = acc[ai][1][m][0], u1 = acc[ai][1][m][1]; f32x4 a0, a1; float mx = 0.f;
#pragma unroll
                for (int j = 0; j < 4; ++j) { a0[j] = silu_f((float)g0[j] * as * bs[0][0][j]) * ((float)u0[j] * as * bs[1][0][j]); a1[j] = silu_f((float)g1[j] * as * bs[0][1][j]) * ((float)u1[j] * as * bs[1][1][j]);
                    mx = fmaxf(mx, fmaxf(fabsf(a0[j]), fabsf(a1[j]))); }
                u32x4 w; w.x = cvt_pk_bf16(a0[0], a0[1]); w.y = cvt_pk_bf16(a0[2], a0[3]); w.z = cvt_pk_bf16(a1[0], a1[1]); w.w = cvt_pk_bf16(a1[2], a1[3]);
                *(u32x4*)rowp = w;
                mx = fmaxf(mx, __shfl_xor(mx, 16)); mx = fmaxf(mx, __shfl_xor(mx, 32));
                if (fq == 0) TM[(size_t)row * 64 + pnl * 4 + wc] = mx; }
    }
};
template <class Epi, class Sched, bool ALIGN_EPI = false, bool SP2 = false>
__device__ __forceinline__ void gemm_phase(PG8_LAS unsigned char* lds, const Gemm g, const Sched& S, const Epi& E, int tid_in) {
    int tid_l = tid_in; asm volatile("" : "+v"(tid_l)); const int tid = tid_l, wid = __builtin_amdgcn_readfirstlane(tid >> 6), lane = tid & 63, wr = wid >> 2, wc = wid & 3, fr = lane & 15, fq = lane >> 4;
    const int K = g.K, nt = K / BK;
    unsigned voffA[2], voffB[2];
#pragma unroll
    for (int i = 0; i < 2; ++i) { int R, C; stage_rc(tid * 16 + i * 8192, R, C); const int Rb = Epi::PERM ? ((R & ~31) + perm32(R & 31)) : R;
        voffA[i] = (unsigned)(R * K + C) * 2u; voffB[i] = (unsigned)(Rb * K + C) * 2u; }
    const size_t kstep = (size_t)(BK * 2);
    const size_t hstep = (size_t)HALF * K * 2;
    const size_t tstep = 2 * hstep;
    const unsigned ldsw = (unsigned)wid * 1024u;
    const int aoff = lds_byte(wr * 64 + fr, fq * 8), boff = lds_byte(wc * 32 + fr, fq * 8);
#define PG8_SA(b, h) (((b) * 2 + (h)) * HTB)
#define PG8_SB(b, h) ((4 + (b) * 2 + (h)) * HTB)
#define PG8_STAGE(bufoff, gbase, voff) do { _Pragma("unroll") for (int _i = 0; _i < 2; ++_i) \
        __builtin_amdgcn_global_load_lds((const unsigned*)((const char*)(gbase) + (voff)[_i]), (PG8_LAS unsigned*)(lds + (bufoff) + ldsw + _i * 8192), 16, 0, 0); } while (0)
#define PG8_LDA(dst, b, h) do { _Pragma("unroll") for (int m = 0; m < 4; ++m) _Pragma("unroll") for (int k = 0; k < 2; ++k) dst[m][k] = *(const PG8_LAS bf16x8*)(lds + PG8_SA(b, h) + aoff + m * 2048 + k * 1024); } while (0)
#define PG8_LDB(dst, b, h) do { _Pragma("unroll") for (int n = 0; n < 2; ++n) _Pragma("unroll") for (int k = 0; k < 2; ++k) dst[n][k] = *(const PG8_LAS bf16x8*)(lds + PG8_SB(b, h) + boff + n * 2048 + k * 1024); } while (0)
#define PG8_MMA(ai, bj, At, Bt) do { __builtin_amdgcn_s_setprio(1); _Pragma("unroll") for (int m = 0; m < 4; ++m) _Pragma("unroll") for (int n = 0; n < 2; ++n) _Pragma("unroll") for (int k = 0; k < 2; ++k) \
        acc[ai][bj][m][n] = mma16(Bt[n][k], At[m][k], acc[ai][bj][m][n]); __builtin_amdgcn_s_setprio(0); } while (0)
#define PG8_WAIT_V(n) asm volatile("s_waitcnt vmcnt(" #n ")" ::: "memory")
#define PG8_WAIT_L(n) asm volatile("s_waitcnt lgkmcnt(" #n ")" ::: "memory")
#define PG8_BAR __builtin_amdgcn_s_barrier()
#define PG8_SCHED __builtin_amdgcn_sched_barrier(0)
    Unit cur, nxt; int ui = 0;
    if (!S.next(0, cur)) return;
    typename Epi::acc_t acc[2][2][4][2];
#pragma unroll
    for (int a = 0; a < 2; ++a)
#pragma unroll
        for (int b = 0; b < 2; ++b)
#pragma unroll
            for (int m = 0; m < 4; ++m)
#pragma unroll
                for (int n = 0; n < 2; ++n) acc[a][b][m][n] = (typename Epi::acc_t){0, 0, 0, 0};
    bf16x8 At[4][2], B0[2][2], B1[2][2];
    const char* cA = (const char*)g.A + (size_t)cur.pm * tstep; const char* cB = (const char*)g.Bt + (size_t)cur.pn * tstep;
    S.a_ready(cur);
    if constexpr (SP2) {
        PG8_STAGE(PG8_SB(0, 0), cB, voffB); PG8_STAGE(PG8_SB(0, 1), cB + hstep, voffB); PG8_STAGE(PG8_SA(0, 0), cA, voffA); PG8_STAGE(PG8_SA(0, 1), cA + hstep, voffA);
        if (wr == 1) PG8_BAR;
        PG8_WAIT_V(2); PG8_BAR;
        PG8_STAGE(PG8_SB(1, 0), cB + kstep, voffB); PG8_STAGE(PG8_SA(1, 0), cA + kstep, voffA); PG8_STAGE(PG8_SB(1, 1), cB + hstep + kstep, voffB);
        PG8_WAIT_V(6); PG8_BAR;
    } else {
        PG8_STAGE(PG8_SB(0, 0), cB, voffB); PG8_STAGE(PG8_SA(0, 0), cA, voffA); PG8_STAGE(PG8_SB(0, 1), cB + hstep, voffB); PG8_STAGE(PG8_SA(0, 1), cA + hstep, voffA);
        if (wr == 1) PG8_BAR;
        PG8_WAIT_V(4); PG8_BAR;
        PG8_STAGE(PG8_SB(1, 0), cB + kstep, voffB); PG8_STAGE(PG8_SA(1, 0), cA + kstep, voffA); PG8_STAGE(PG8_SB(1, 1), cB + hstep + kstep, voffB);
        PG8_WAIT_V(6); PG8_BAR;
    }
    for (;;) {
        const bool has_next = S.next(ui + 1, nxt);
        const char* nA = has_next ? (const char*)g.A + (size_t)nxt.pm * tstep : cA; const char* nB = has_next ? (const char*)g.Bt + (size_t)nxt.pn * tstep : cB;
        for (int t = 0; t < nt; t += 2) {
            const bool last = (t == nt - 2);
            const char* a1 = cA + (size_t)(t + 1) * kstep;
            const char* a2 = last ? nA : cA + (size_t)(t + 2) * kstep; const char* b2 = last ? nB : cB + (size_t)(t + 2) * kstep;
            const char* a3 = a2 + kstep; const char* b3 = b2 + kstep;
            if (last && has_next) S.a_ready(nxt);
            if constexpr (SP2) {
            PG8_LDB(B0, 0, 0); PG8_LDB(B1, 0, 1); PG8_SCHED; PG8_LDA(At, 0, 0); PG8_STAGE(PG8_SA(1, 1), a1 + hstep, voffA);
            PG8_WAIT_V(8); PG8_WAIT_L(0); PG8_BAR; PG8_MMA(0, 0, At, B0); PG8_MMA(0, 1, At, B1); PG8_BAR; PG8_SCHED;
            PG8_LDA(At, 0, 1); PG8_STAGE(PG8_SB(0, 0), b2, voffB); PG8_STAGE(PG8_SB(0, 1), b2 + hstep, voffB); PG8_STAGE(PG8_SA(0, 0), a2, voffA);
            PG8_WAIT_V(8); PG8_WAIT_L(0); PG8_BAR; PG8_MMA(1, 0, At, B0); PG8_MMA(1, 1, At, B1); PG8_BAR; PG8_SCHED;
            PG8_LDB(B0, 1, 0); PG8_LDB(B1, 1, 1); PG8_SCHED; PG8_LDA(At, 1, 0); PG8_STAGE(PG8_SA(0, 1), a2 + hstep, voffA);
            PG8_WAIT_V(8); PG8_WAIT_L(0); PG8_BAR; PG8_MMA(0, 0, At, B0); PG8_MMA(0, 1, At, B1); PG8_BAR; PG8_SCHED;
            PG8_LDA(At, 1, 1); PG8_STAGE(PG8_SB(1, 0), b3, voffB); PG8_STAGE(PG8_SB(1, 1), b3 + hstep, voffB); PG8_STAGE(PG8_SA(1, 0), a3, voffA);
            PG8_WAIT_V(8); PG8_WAIT_L(0); PG8_BAR; PG8_MMA(1, 0, At, B0); PG8_MMA(1, 1, At, B1); PG8_BAR; PG8_SCHED;
            } else {
            PG8_LDB(B0, 0, 0); PG8_SCHED; PG8_LDA(At, 0, 0); PG8_STAGE(PG8_SA(1, 1), a1 + hstep, voffA);
            PG8_WAIT_L(8); PG8_BAR; PG8_WAIT_L(0); PG8_MMA(0, 0, At, B0); PG8_BAR; PG8_SCHED;
            PG8_LDB(B1, 0, 1); PG8_STAGE(PG8_SB(0, 0), b2, voffB);
            PG8_BAR; PG8_WAIT_L(0); PG8_MMA(0, 1, At, B1); PG8_BAR;
            PG8_LDA(At, 0, 1); PG8_STAGE(PG8_SA(0, 0), a2, voffA);
            PG8_BAR; PG8_WAIT_L(0); PG8_MMA(1, 0, At, B0); PG8_BAR; PG8_SCHED;
            PG8_STAGE(PG8_SB(0, 1), b2 + hstep, voffB);
            PG8_WAIT_V(6); PG8_BAR; PG8_MMA(1, 1, At, B1); PG8_BAR;
            PG8_LDB(B0, 1, 0); PG8_SCHED; PG8_LDA(At, 1, 0); PG8_STAGE(PG8_SA(0, 1), a2 + hstep, voffA);
            PG8_WAIT_L(8); PG8_BAR; PG8_WAIT_L(0); PG8_MMA(0, 0, At, B0); PG8_BAR; PG8_SCHED;
            PG8_LDB(B1, 1, 1); PG8_STAGE(PG8_SB(1, 0), b3, voffB);
            PG8_BAR; PG8_WAIT_L(0); PG8_MMA(0, 1, At, B1); PG8_BAR;
            PG8_LDA(At, 1, 1); PG8_STAGE(PG8_SA(1, 0), a3, voffA);
            PG8_BAR; PG8_WAIT_L(0); PG8_MMA(1, 0, At, B0); PG8_BAR; PG8_SCHED;
            PG8_STAGE(PG8_SB(1, 1), b3 + hstep, voffB);
            PG8_WAIT_V(6); PG8_BAR; PG8_MMA(1, 1, At, B1); PG8_BAR;
            }
        }
        if constexpr (ALIGN_EPI) { if (wr == 0) PG8_BAR; }
        if constexpr (!Epi::AFTER_DRAIN) { E(acc, cur, wr, wc, fr, fq); S.done(cur); }
        if (!has_next) break;
#pragma unroll
        for (int a = 0; a < 2; ++a)
#pragma unroll
            for (int b = 0; b < 2; ++b)
#pragma unroll
                for (int m = 0; m < 4; ++m)
#pragma unroll
                    for (int n = 0; n < 2; ++n) acc[a][b][m][n] = (typename Epi::acc_t){0, 0, 0, 0};
        cur = nxt; cA = nA; cB = nB; ++ui;
        if constexpr (ALIGN_EPI) { if (wr == 1) PG8_BAR; }
    }
    PG8_WAIT_V(0);
    if constexpr (!ALIGN_EPI) { if (wr == 0) PG8_BAR; }
    PG8_BAR;
    if constexpr (Epi::AFTER_DRAIN) { E.fused(acc, cur, wr, wc, fr, fq, lds, wid, lane); S.done(cur); }
#undef PG8_SA
#undef PG8_SB
#undef PG8_STAGE
#undef PG8_LDA
#undef PG8_LDB
#undef PG8_MMA
#undef PG8_WAIT_V
#undef PG8_WAIT_L
#undef PG8_BAR
#undef PG8_SCHED
}
}
#define LAS __attribute__((address_space(3)))
typedef unsigned short bf16;
typedef short bf16x8 __attribute__((ext_vector_type(8)));
typedef short bf16x4 __attribute__((ext_vector_type(4)));
typedef float f32x4 __attribute__((ext_vector_type(4)));
typedef float f32x2 __attribute__((ext_vector_type(2)));
typedef unsigned u32x4 __attribute__((ext_vector_type(4)));
typedef unsigned u32x2 __attribute__((ext_vector_type(2)));

constexpr int D = 2048, NB = 8, SEQ = 2048, CTXL = 256, DEPTH = 2, GRIDW = 64;
constexpr int NLAT = NB * SEQ, NCTX = NB * CTXL, NROW = NLAT + NCTX;
constexpr int HA = 8, DHA = 64, HB = 4, DKB = 128, DVB = 256, DECR = 16, GC = 4, CG = 128, MIXC = 128;
constexpr int NE = 16, FF = 2048, CAPL = 256, CAPC = 32;
constexpr int N_IN = 5664, NU = 5888;
constexpr int U_QA = 0, U_KA = 512, U_VA = 1024, U_KB = 1536, U_VB = 2048, U_QB = 3072, U_GB = 3584, U_UC = 4608, U_VC = 5120, U_DEC = 5632;
constexpr int MIX_A = 0, MIX_B = 512, MIX_C = 1536;
constexpr float EPS = 1e-6f;
constexpr int ME0 = NB * CAPL + NB * CAPC, ME1 = NB * CAPL;

constexpr size_t MiB = 1u << 20;
constexpr size_t WS_CTL = 0, CTL_ZERO_BYTES = 65536;
constexpr size_t WS_MOD = 1 * MiB;
constexpr size_t WS_ROPE = 2 * MiB;
constexpr size_t WS_CV = WS_ROPE + 65536;
constexpr size_t WS_AFF = 3 * MiB;
constexpr size_t WS_TSLOT = 5 * MiB;
constexpr size_t WS_GD = 6656 * 1024;
constexpr size_t WS_WIN = 8 * MiB;
constexpr size_t WS_SIN = WS_WIN + 24 * MiB;
constexpr size_t WS_WOUT = 54 * MiB;
constexpr size_t WS_W1 = 70 * MiB;
constexpr size_t WS_S1 = WS_W1 + 256 * MiB;
constexpr size_t WS_W2 = 582 * MiB;
constexpr size_t WS_S2 = WS_W2 + 128 * MiB;
constexpr size_t WS_H = 838 * MiB;
constexpr size_t WS_HS = WS_H + 36 * MiB;
constexpr size_t WS_XC = 910 * MiB;
constexpr size_t WS_R1 = 926 * MiB;
constexpr size_t WS_R2 = 1133 * MiB;
constexpr size_t WS_XSS = WS_R2 + 72 * MiB;
constexpr size_t WS_TM = WS_R1 + 144 * MiB;
constexpr size_t WS_ACTS = WS_TM + 9 * MiB;
constexpr size_t WS_ACTQ = 1349 * MiB;
constexpr size_t WS_GQ = WS_R2, WS_GK = WS_R2 + 36 * MiB, WS_GV = WS_R2 + 72 * MiB;
constexpr size_t WS_MIX = 1277 * MiB;
constexpr size_t WS_OB = 1349 * MiB;
constexpr size_t WS_END = 1421 * MiB;
constexpr size_t WS_DUMMY = WS_END;
constexpr size_t WS_XB = WS_END + 72 * MiB;
constexpr size_t WS_END2 = WS_XB + 72 * MiB;
static_assert((size_t)DEPTH * NU * D * 2 <= 46 * MiB && (size_t)NROW * NU * 2 <= 207 * MiB && (size_t)NE * ME0 * D * 2 <= 144 * MiB && (size_t)NROW * D * 2 <= 72 * MiB, "ws map");
constexpr int CW_TMO = 0, CW_BAR = 4096, CW_BG = 8192, CW_SIG = 8256;

constexpr int LDS_BYTES = 147456, NWAVES = 8, NTHR = 512;
constexpr int LDS_XB = 147456 - 64;

using pg8::silu_f; using pg8::xmax16; using pg8::xmax32; using pg8::xsum16; using pg8::xsum32;
typedef __bf16 hwbf16x2 __attribute__((ext_vector_type(2)));
__device__ __forceinline__ unsigned pk2(float lo, float hi) { const f32x2 v = {lo, hi}; const hwbf16x2 b = __builtin_convertvector(v, hwbf16x2); return __builtin_bit_cast(unsigned, b); }
__device__ __forceinline__ unsigned f2bf(float f) { return pk2(f, 0.f) & 0xffffu; }
__device__ __forceinline__ float bf2f(unsigned b) { return __builtin_bit_cast(float, b << 16); }
__device__ __forceinline__ float bflo(unsigned w) { return __builtin_bit_cast(float, w << 16); }
__device__ __forceinline__ float bfhi(unsigned w) { return __builtin_bit_cast(float, w & 0xffff0000u); }
template <int CTRL, int ROWMASK> __device__ __forceinline__ float dpp_f(float old, float v) { return __builtin_bit_cast(float, __builtin_amdgcn_update_dpp(__builtin_bit_cast(int, old), __builtin_bit_cast(int, v), CTRL, ROWMASK, 0xf, false)); }
__device__ __forceinline__ float wave_sum(float v) {
    v += dpp_f<0xB1, 0xf>(0.f, v); v += dpp_f<0x4E, 0xf>(0.f, v); v += dpp_f<0x141, 0xf>(0.f, v); v += dpp_f<0x140, 0xf>(0.f, v);
    v += dpp_f<0x142, 0xa>(0.f, v); v += dpp_f<0x143, 0xc>(0.f, v);
    return __builtin_bit_cast(float, __builtin_amdgcn_readlane(__builtin_bit_cast(int, v), 63));
}
__device__ __forceinline__ float gelu_tanh(float x) { const float u = 0.7978845608028654f * (x + 0.044715f * x * x * x); const float e = __expf(2.0f * u); return 0.5f * x * (2.0f - 2.0f * __builtin_amdgcn_rcpf(1.0f + e)); }
__device__ __forceinline__ float log_sigmoid(float z) { return fminf(z, 0.0f) - __logf(1.0f + __expf(-fabsf(z))); }
#define LDS_WAIT() asm volatile("s_waitcnt lgkmcnt(0)" ::: "memory")

__device__ __forceinline__ void row_load_f32(const float* p, int lane, float (&v)[32]) {
#pragma unroll
    for (int j = 0; j < 4; ++j) { const f32x4 a = *(const f32x4*)(p + 512 * j + 8 * lane), b = *(const f32x4*)(p + 512 * j + 8 * lane + 4);
        v[8 * j + 0] = a[0]; v[8 * j + 1] = a[1]; v[8 * j + 2] = a[2]; v[8 * j + 3] = a[3]; v[8 * j + 4] = b[0]; v[8 * j + 5] = b[1]; v[8 * j + 6] = b[2]; v[8 * j + 7] = b[3]; }
}
__device__ __forceinline__ void row_load_f32_nt(const float* p, int lane, float (&v)[32]) {
#pragma unroll
    for (int j = 0; j < 4; ++j) { const f32x4 a = __builtin_nontemporal_load((const f32x4*)(p + 512 * j + 8 * lane)), b = __builtin_nontemporal_load((const f32x4*)(p + 512 * j + 8 * lane + 4));
        v[8 * j + 0] = a[0]; v[8 * j + 1] = a[1]; v[8 * j + 2] = a[2]; v[8 * j + 3] = a[3]; v[8 * j + 4] = b[0]; v[8 * j + 5] = b[1]; v[8 * j + 6] = b[2]; v[8 * j + 7] = b[3]; }
}
__device__ __forceinline__ void row_load_bf16_nt(const bf16* p, int lane, float (&v)[32]) {
#pragma unroll
    for (int j = 0; j < 4; ++j) { const u32x4 a = __builtin_nontemporal_load((const u32x4*)(p + 512 * j + 8 * lane));
        v[8 * j + 0] = bflo(a.x); v[8 * j + 1] = bfhi(a.x); v[8 * j + 2] = bflo(a.y); v[8 * j + 3] = bfhi(a.y); v[8 * j + 4] = bflo(a.z); v[8 * j + 5] = bfhi(a.z); v[8 * j + 6] = bflo(a.w); v[8 * j + 7] = bfhi(a.w); }
}
__device__ __forceinline__ void row_store_f32(float* p, int lane, const float (&v)[32]) {
#pragma unroll
    for (int j = 0; j < 4; ++j) { __builtin_nontemporal_store((f32x4){v[8 * j], v[8 * j + 1], v[8 * j + 2], v[8 * j + 3]}, (f32x4*)(p + 512 * j + 8 * lane)); __builtin_nontemporal_store((f32x4){v[8 * j + 4], v[8 * j + 5], v[8 * j + 6], v[8 * j + 7]}, (f32x4*)(p + 512 * j + 8 * lane + 4)); }
}
__device__ __forceinline__ void row_load_bf16(const bf16* p, int lane, float (&v)[32]) {
#pragma unroll
    for (int j = 0; j < 4; ++j) { const u32x4 a = *(const u32x4*)(p + 512 * j + 8 * lane);
        v[8 * j + 0] = bflo(a.x); v[8 * j + 1] = bfhi(a.x); v[8 * j + 2] = bflo(a.y); v[8 * j + 3] = bfhi(a.y); v[8 * j + 4] = bflo(a.z); v[8 * j + 5] = bfhi(a.z); v[8 * j + 6] = bflo(a.w); v[8 * j + 7] = bfhi(a.w); }
}
__device__ __forceinline__ void row_store_bf16(bf16* p, int lane, const float (&v)[32]) {
#pragma unroll
    for (int j = 0; j < 4; ++j) { u32x4 a; a.x = pk2(v[8 * j], v[8 * j + 1]); a.y = pk2(v[8 * j + 2], v[8 * j + 3]); a.z = pk2(v[8 * j + 4], v[8 * j + 5]); a.w = pk2(v[8 * j + 6], v[8 * j + 7]); __builtin_nontemporal_store(a, (u32x4*)(p + 512 * j + 8 * lane)); }
}
__device__ __forceinline__ float row_sumsq(const float (&v)[32]) { float s = 0.f;
#pragma unroll
    for (int i = 0; i < 32; ++i) s += v[i] * v[i];
    return wave_sum(s); }

#define XB_TMO      128
#define XB_XCNT(j)  (256  + 64 * (j))
#define XB_XSUB(j)  (1280 + 64 * (j))
#define XB_XGEN(j)  (2304 + 64 * (j))
#define XB_TOP      3328
#define XB_TOPGEN   3392
#define XCD_BAR_WORDS 3456
#define XB_SPIN_CAP (1u << 18)
#define LAS __attribute__((address_space(3)))

__device__ __forceinline__ unsigned xb_ld(unsigned* p)              { return __hip_atomic_load(p, __ATOMIC_RELAXED, __HIP_MEMORY_SCOPE_AGENT); }
__device__ __forceinline__ unsigned xb_add(unsigned* p, unsigned v) { return __hip_atomic_fetch_add(p, v, __ATOMIC_RELAXED, __HIP_MEMORY_SCOPE_AGENT); }
__device__ __forceinline__ unsigned xb_xcc_id() { return (unsigned)__builtin_amdgcn_s_getreg((3 << 11) | 20) & 0xFu; }
#define XB_SPIN(cond, bar) do { unsigned _sp = 0; while (cond) { __builtin_amdgcn_s_sleep(1); \
    if ((++_sp & 255u) == 0u) { if (xb_ld(&(bar)[XB_TMO])) break; if (_sp > XB_SPIN_CAP) { atomicAdd(&(bar)[XB_TMO], 1u); break; } } } } while (0)

struct XcdBarrier {
    unsigned* bar; unsigned x;
    volatile LAS unsigned* st;
};

__device__ __forceinline__ XcdBarrier xcd_barrier_post(unsigned* bar, volatile LAS unsigned* st) {
    XcdBarrier b; b.bar = bar; b.x = xb_xcc_id(); b.st = st;
    if (threadIdx.x == 0) (void)xb_add(&bar[XB_XCNT(b.x)], 1u);
    return b;
}
__device__ __forceinline__ void xcd_barrier_complete(unsigned* bar, unsigned x, unsigned& nloc, unsigned& nx) {
    const unsigned G = gridDim.x * gridDim.y * gridDim.z;
    unsigned sum, cnt, mine, sp = 0u;
    for (;;) {
        sum = 0u; cnt = 0u; mine = 0u;
#pragma unroll
        for (unsigned j = 0; j < 16; ++j) { const unsigned c = xb_ld(&bar[XB_XCNT(j)]); sum += c; cnt += (c > 0u) ? 1u : 0u; mine = (j == x) ? c : mine; }
        if (sum == G) break;
        __builtin_amdgcn_s_sleep(1);
        if ((++sp & 255u) == 0u) { if (xb_ld(&bar[XB_TMO])) break; if (sp > XB_SPIN_CAP) { atomicAdd(&bar[XB_TMO], 1u); break; } }
    }
    nloc = mine > 0u ? mine : 1u; nx = cnt > 0u ? cnt : 1u;
}

__device__ __forceinline__ void xcd_barrier(const XcdBarrier& b) {
    asm volatile("s_waitcnt vmcnt(0)" ::: "memory");
    __syncthreads();
    if (threadIdx.x == 0) {
        unsigned* bar = b.bar;
        __builtin_amdgcn_s_waitcnt(0);
        unsigned nloc = b.st[0], nx = b.st[1];
        if (nloc == 0u) { xcd_barrier_complete(bar, b.x, nloc, nx); b.st[0] = nloc; b.st[1] = nx; }
        const unsigned old = xb_add(&bar[XB_XSUB(b.x)], 1u);
        const unsigned gen = old / nloc;
        if (old + 1u == (gen + 1u) * nloc) {
            __builtin_amdgcn_fence(__ATOMIC_RELEASE, "agent");
            asm volatile("s_waitcnt vmcnt(0)" ::: "memory");
            const unsigned og = xb_add(&bar[XB_TOP], 1u);
            const unsigned tg = og / nx;
            if (og + 1u == (tg + 1u) * nx) xb_add(&bar[XB_TOPGEN], 1u);
            else XB_SPIN(xb_ld(&bar[XB_TOPGEN]) == tg, bar);
            __builtin_amdgcn_fence(__ATOMIC_ACQUIRE, "agent");
            xb_add(&bar[XB_XGEN(b.x)], 1u);
            asm volatile("s_waitcnt vmcnt(0)" ::: "memory");
        } else {
            XB_SPIN(xb_ld(&bar[XB_XGEN(b.x)]) == gen, bar);
            __builtin_amdgcn_fence(__ATOMIC_ACQUIRE, "agent");
            asm volatile("s_waitcnt vmcnt(0)" ::: "memory");
        }
    }
    __syncthreads();
}

struct Frame {
    LAS unsigned char* lds;
    int tid, lane, wave, vcu, G;
    const float *x, *c, *ctx, *c_ctx, *w_ada, *b_ada, *g_pre_mix, *g_post_mix, *g_pre_ffn, *g_post_ffn, *w_in, *w_dec, *b_dec, *rpb, *g_gla, *ln_v_g, *ln_v_b, *w_sp, *b_sp, *w_out, *w_router, *w_gate, *w_up, *w_down;
    float* out; unsigned char* ws;
};

#define W_MOD(F) ((float*)((F).ws + WS_MOD))
#define W_ROPE(F) ((float*)((F).ws + WS_ROPE))
#define W_CV(F) ((bf16*)((F).ws + WS_CV))
#define W_AFF(F) ((float*)((F).ws + WS_AFF))
#define W_XC(F) ((float*)((F).ws + WS_XC))
#define W_XB(F) ((bf16*)((F).ws + WS_XB))
#define W_TSLOT(F) ((int*)((F).ws + WS_TSLOT))
#define W_WIN(F) ((bf16*)((F).ws + WS_WIN))
#define W_WOUT(F) ((bf16*)((F).ws + WS_WOUT))
#define W_W1(F) ((bf16*)((F).ws + WS_W1))
#define W_W2(F) ((bf16*)((F).ws + WS_W2))
#define W_H(F) ((bf16*)((F).ws + WS_H))
#define W_U(F) ((bf16*)((F).ws + WS_R1))
#define W_Y(F) ((bf16*)((F).ws + WS_R1))
#define W_ACT(F) ((bf16*)((F).ws + WS_R1))
#define W_XS(F) ((bf16*)((F).ws + WS_R2))
#define W_MIX(F) ((bf16*)((F).ws + WS_MIX))
#define W_OB(F) ((bf16*)((F).ws + WS_OB))
#define W_SIN(F) ((float*)((F).ws + WS_SIN))
#define W_S1(F) ((float*)((F).ws + WS_S1))
#define W_S2(F) ((float*)((F).ws + WS_S2))
#define W_HQ(F) ((signed char*)((F).ws + WS_H))
#define W_HS(F) ((float*)((F).ws + WS_HS))
#define W_XSQ(F) ((signed char*)((F).ws + WS_R2))
#define W_XSS(F) ((float*)((F).ws + WS_XSS))
#define W_TM(F) ((float*)((F).ws + WS_TM))
#define W_ACTS(F) ((float*)((F).ws + WS_ACTS))
#define W_ACTQ(F) ((signed char*)((F).ws + WS_ACTQ))
__device__ __forceinline__ void launder(Frame& F) {
    int wv = F.wave; asm volatile("" : "+s"(wv)); F.wave = wv;
    unsigned ones = ~0u; asm volatile("" : "+s"(ones));
    int t = wv * 64 + (int)__builtin_amdgcn_mbcnt_hi(ones, __builtin_amdgcn_mbcnt_lo(ones, 0u)); asm volatile("" : "+v"(t)); F.tid = t; F.lane = t & 63;
    int v = F.vcu; asm volatile("" : "+s"(v)); F.vcu = v;
    __attribute__((address_space(1))) unsigned char* w = (__attribute__((address_space(1))) unsigned char*)F.ws; asm volatile("" : "+s"(w)); F.ws = (unsigned char*)w;
}

__device__ __forceinline__ float wave_max(float v) {
    v = fmaxf(v, dpp_f<0xB1, 0xf>(v, v)); v = fmaxf(v, dpp_f<0x4E, 0xf>(v, v)); v = fmaxf(v, dpp_f<0x141, 0xf>(v, v)); v = fmaxf(v, dpp_f<0x140, 0xf>(v, v));
    v = fmaxf(v, dpp_f<0x142, 0xa>(v, v)); v = fmaxf(v, dpp_f<0x143, 0xc>(v, v));
    return __builtin_bit_cast(float, __builtin_amdgcn_readlane(__builtin_bit_cast(int, v), 63));
}
__device__ __forceinline__ unsigned pack4_i8(float a, float b, float c, float d) { return ((unsigned)(int)a & 0xffu) | (((unsigned)(int)b & 0xffu) << 8) | (((unsigned)(int)c & 0xffu) << 16) | (((unsigned)(int)d & 0xffu) << 24); }
__device__ __forceinline__ unsigned q4_i8(float a, float b, float c, float d, float inv) {
    const unsigned x0 = __builtin_bit_cast(unsigned, fmaf(a, inv, 12582912.f)), x1 = __builtin_bit_cast(unsigned, fmaf(b, inv, 12582912.f)), x2 = __builtin_bit_cast(unsigned, fmaf(c, inv, 12582912.f)), x3 = __builtin_bit_cast(unsigned, fmaf(d, inv, 12582912.f));
    return __builtin_amdgcn_perm(x1, x0, 0x0c0c0400u) | __builtin_amdgcn_perm(x3, x2, 0x04000c0cu);
}
__device__ __forceinline__ void row_store_i8(signed char* p, int lane, const float (&v)[32], float inv) {
#pragma unroll
    for (int j = 0; j < 4; ++j) { u32x2 o; o.x = q4_i8(v[8 * j], v[8 * j + 1], v[8 * j + 2], v[8 * j + 3], inv); o.y = q4_i8(v[8 * j + 4], v[8 * j + 5], v[8 * j + 6], v[8 * j + 7], inv);
        __builtin_nontemporal_store(o, (u32x2*)(p + 512 * j + 8 * lane)); }
}

#define LBAR() do { asm volatile("s_waitcnt lgkmcnt(0)" ::: "memory"); __builtin_amdgcn_s_barrier(); asm volatile("" ::: "memory"); } while (0)
__device__ __forceinline__ int dest_row(int mode, int n) {
    if (mode == 1) return n < 3072 ? n : (n < 3104 ? U_DEC + (n - 3072) : n - 32);
    if (mode == 2) return ((n >> 7) << 8) + (n & 127);
    if (mode == 3) return ((n >> 7) << 8) + 128 + (n & 127);
    return n;
}
constexpr int IN_ITEMS = (N_IN + 63) / 64;
constexpr int BG_IN0 = IN_ITEMS, BG_A = BG_IN0 + NE * 3 * 32, BG_B = BG_A + IN_ITEMS, BG_TOTAL = BG_B + NE * 3 * 32;
__device__ __forceinline__ unsigned pkbf(float lo, float hi) { unsigned r; asm volatile("v_cvt_pk_bf16_f32 %0, %1, %2" : "=v"(r) : "v"(lo), "v"(hi)); return r; }
__device__ __forceinline__ void strip_item(Frame& F, int id) {
    const int lane = F.lane, n16 = lane & 15, kq = lane >> 4;
    LAS float* cm = (LAS float*)(F.lds); LAS unsigned* qb = (LAS unsigned*)(F.lds + 2048);
    const int l = id >= BG_A ? 1 : 0, idl = l ? id - BG_A : id; const bool isin = idl < IN_ITEMS; const int itm = isin ? idl : idl - IN_ITEMS;
    const int mi = itm >> 5, n0 = isin ? itm * 64 : (itm & 31) * 64, e = mi / 3, which = isin ? 3 : mi % 3; const size_t le = (size_t)l * NE + e;
    const float* W = isin ? F.w_in + (size_t)l * D * N_IN : (which == 0 ? F.w_gate + le * D * FF : (which == 1 ? F.w_up + le * D * FF : F.w_down + le * FF * D));
    const int mode = isin ? 1 : (which == 0 ? 2 : (which == 1 ? 3 : 0)), pitch = isin ? N_IN : D, N = isin ? N_IN : D;
    signed char* dq = isin ? (signed char*)(F.ws + WS_WIN) + (size_t)l * NU * D : (which == 2 ? (signed char*)(F.ws + WS_W2) + le * D * FF : (signed char*)(F.ws + WS_W1) + le * (2 * FF) * D);
    float* ds = isin ? W_SIN(F) + (size_t)l * NU : (which == 2 ? W_S2(F) + le * D : W_S1(F) + le * (2 * FF));
    const bool colok = (n0 + 4 * n16) < N;
    const float* src = W + (size_t)(256 * F.wave + 4 * kq) * pitch + n0 + 4 * n16;
    unsigned pk[16][4][2];
#pragma unroll
    for (int hb = 0; hb < 4; ++hb) {
        f32x4 t[4][4];
#pragma unroll
        for (int j = 0; j < 4; ++j)
#pragma unroll
            for (int e4 = 0; e4 < 4; ++e4) t[j][e4] = colok ? __builtin_nontemporal_load((const f32x4*)(src + (size_t)(16 * (4 * hb + j) + e4) * pitch)) : (f32x4){0.f, 0.f, 0.f, 0.f};
#pragma unroll
        for (int j = 0; j < 4; ++j) {
#pragma unroll
            for (int e4 = 0; e4 < 4; ++e4) { pk[4 * hb + j][e4][0] = pkbf(t[j][e4][0], t[j][e4][1]); pk[4 * hb + j][e4][1] = pkbf(t[j][e4][2], t[j][e4][3]); }
            asm volatile("" : "+v"(pk[4 * hb + j][0][0]), "+v"(pk[4 * hb + j][0][1]), "+v"(pk[4 * hb + j][1][0]), "+v"(pk[4 * hb + j][1][1]), "+v"(pk[4 * hb + j][2][0]), "+v"(pk[4 * hb + j][2][1]), "+v"(pk[4 * hb + j][3][0]), "+v"(pk[4 * hb + j][3][1]) :: "memory");
        }
    }
    typedef unsigned short u16x2 __attribute__((ext_vector_type(2)));
    u16x2 m01 = {0, 0}, m23 = {0, 0};
#pragma unroll
    for (int j = 0; j < 16; ++j)
#pragma unroll
        for (int e4 = 0; e4 < 4; ++e4) { m01 = __builtin_elementwise_max(m01, __builtin_bit_cast(u16x2, pk[j][e4][0] & 0x7fff7fffu)); m23 = __builtin_elementwise_max(m23, __builtin_bit_cast(u16x2, pk[j][e4][1] & 0x7fff7fffu)); }
    float mx[4] = {bf2f(m01[0]), bf2f(m01[1]), bf2f(m23[0]), bf2f(m23[1])};
#pragma unroll
    for (int c = 0; c < 4; ++c) { mx[c] = fmaxf(mx[c], __shfl_xor(mx[c], 16)); mx[c] = fmaxf(mx[c], __shfl_xor(mx[c], 32)); }
    if (lane < 16) *(LAS f32x4*)(cm + F.wave * 64 + 4 * lane) = (f32x4){mx[0], mx[1], mx[2], mx[3]};
#pragma unroll
    for (int j = 0; j < 16; ++j)
        asm volatile("" : "+v"(pk[j][0][0]), "+v"(pk[j][0][1]), "+v"(pk[j][1][0]), "+v"(pk[j][1][1]), "+v"(pk[j][2][0]), "+v"(pk[j][2][1]), "+v"(pk[j][3][0]), "+v"(pk[j][3][1]));
    LBAR();
    f32x4 cmx = (f32x4){0.f, 0.f, 0.f, 0.f};
#pragma unroll
    for (int w = 0; w < 8; ++w) { const f32x4 c4 = *(const LAS f32x4*)(cm + w * 64 + 4 * n16); cmx = __builtin_elementwise_max(cmx, c4); }
    float sc[4], iv[4];
#pragma unroll
    for (int c = 0; c < 4; ++c) { sc[c] = cmx[c] > 0.f ? cmx[c] * (1.0f / 127.0f) : 1.0f; iv[c] = 1.0f / sc[c]; }
    if (F.tid < 16 && colok) {
#pragma unroll
        for (int c = 0; c < 4; ++c) ds[dest_row(mode, n0 + 4 * F.tid + c)] = sc[c]; }
    const int sw = (n16 >> 1);
#pragma unroll
    for (int j = 0; j < 16; ++j) {
        unsigned o[4];
#pragma unroll
        for (int c = 0; c < 4; ++c) { unsigned x[4];
#pragma unroll
            for (int e4 = 0; e4 < 4; ++e4) { const unsigned wv = pk[j][e4][c >> 1]; const float xf = (c & 1) ? bfhi(wv) : bflo(wv); x[e4] = __builtin_bit_cast(unsigned, fmaf(xf, iv[c], 12582912.f)); }
            o[c] = __builtin_amdgcn_perm(x[1], x[0], 0x0c0c0400u) | __builtin_amdgcn_perm(x[3], x[2], 0x04000c0cu); }
        const int idx4 = (16 * F.wave + j) ^ sw;
#pragma unroll
        for (int c = 0; c < 4; ++c) qb[(4 * n16 + c) * 516 + 4 * idx4 + kq] = o[c];
    }
    LBAR();
#pragma unroll
    for (int q16 = 0; q16 < 16; ++q16) { const int p = F.tid + 512 * q16, n = p >> 7, c16 = p & 127;
        if (n0 + n < N) __builtin_nontemporal_store(*(const LAS u32x4*)(qb + n * 516 + 4 * (c16 ^ (n >> 3))), (u32x4*)(dq + (size_t)dest_row(mode, n0 + n) * D + 16 * c16)); }
    LBAR();
}
__device__ __forceinline__ void bg_loop(Frame& F, unsigned* ctl, const unsigned* sig, int limit) {
    LAS int* flag = (LAS int*)(F.lds + 140000);
    unsigned* head = ctl + CW_BG;
    __syncthreads();
    for (;;) {
        if (F.tid == 0) { int idx = -1;
            const bool stop = sig && __hip_atomic_load(sig, __ATOMIC_RELAXED, __HIP_MEMORY_SCOPE_AGENT) != 0u;
            if (!stop && (int)__hip_atomic_load(head, __ATOMIC_RELAXED, __HIP_MEMORY_SCOPE_AGENT) + BG_IN0 < limit) { idx = (int)__hip_atomic_fetch_add(head, 1u, __ATOMIC_RELAXED, __HIP_MEMORY_SCOPE_AGENT) + BG_IN0; if (idx >= BG_TOTAL) idx = -1; }
            *flag = idx; }
        __syncthreads();
        const int idx = *flag;
        __syncthreads();
        if (idx < 0) break;
        strip_item(F, idx);
    }
}
#ifndef MK_REPP0
#define MK_REPP0 0u
#endif
__device__ __forceinline__ void transpose_item(const float* W, int N, int k0, int n0, bf16* dst, int mode, LAS float* scr, int lane) {
    const bool nok = (n0 + lane) < N;
    const float* src = W + (size_t)k0 * N + n0 + lane;
#pragma unroll 8
    for (int i = 0; i < 64; ++i) scr[i * 65 + lane] = nok ? __builtin_nontemporal_load(src + (size_t)i * N) : 0.f;
    LDS_WAIT();
    const int c = lane & 7;
#pragma unroll
    for (int j = 0; j < 8; ++j) { const int nl = (lane >> 3) + 8 * j, n = n0 + nl; const LAS float* s = scr + (8 * c) * 65 + nl;
        u32x4 o; o.x = pk2(s[0 * 65], s[1 * 65]); o.y = pk2(s[2 * 65], s[3 * 65]); o.z = pk2(s[4 * 65], s[5 * 65]); o.w = pk2(s[6 * 65], s[7 * 65]);
        if (n < N) *(u32x4*)(dst + (size_t)dest_row(mode, n) * D + k0 + 8 * c) = o; }
    LDS_WAIT();
}
__device__ __forceinline__ void p0a(Frame& F) {
    const int gw = F.vcu * NWAVES + F.wave, NGW = F.G * NWAVES, lane = F.lane;
    for (int rep0 = 0; rep0 < 1 + (int)(MK_REPP0 & 1u); ++rep0) {
        LAS float* red = (LAS float*)F.lds;
        for (int it = F.vcu; it < DEPTH * 96; it += F.G) {
            const int l = it / 96, n0 = (it % 96) * 128;
            float acc[9][2];
#pragma unroll
            for (int r = 0; r < 9; ++r) { acc[r][0] = 0.f; acc[r][1] = 0.f; }
            for (int kb = 0; kb < 4; ++kb) {
                const int k0 = 256 * F.wave + 64 * kb;
                float sv[9];
#pragma unroll
                for (int r = 0; r < 8; ++r) sv[r] = silu_f(F.c[r * D + k0 + lane]);
                sv[8] = silu_f(F.c_ctx[k0 + lane]);
                const float* wp = F.w_ada + ((size_t)l * D + k0) * (6 * D) + n0 + 2 * lane;
#pragma unroll 4
                for (int kk = 0; kk < 64; ++kk) {
                    const f32x2 wv = __builtin_nontemporal_load((const f32x2*)(wp + (size_t)kk * (6 * D)));
#pragma unroll
                    for (int r = 0; r < 9; ++r) { const float s = __builtin_bit_cast(float, __builtin_amdgcn_readlane(__builtin_bit_cast(int, sv[r]), kk)); acc[r][0] += s * wv.x; acc[r][1] += s * wv.y; }
                }
            }
#pragma unroll
            for (int r = 0; r < 9; ++r) { red[(F.wave * 9 + r) * 128 + 2 * lane] = acc[r][0]; red[(F.wave * 9 + r) * 128 + 2 * lane + 1] = acc[r][1]; }
            __syncthreads();
            for (int o = F.tid; o < 9 * 128; o += NTHR) { const int r = o >> 7, col = o & 127; float s = 0.f;
#pragma unroll
                for (int w = 0; w < 8; ++w) s += red[(w * 9 + r) * 128 + col];
                W_MOD(F)[((size_t)l * 9 + r) * (6 * D) + n0 + col] = s + F.b_ada[(size_t)l * 6 * D + n0 + col]; }
            __syncthreads();
        }
    }
    {
        const int gid = (F.vcu * NTHR + F.tid);
        if (gid < 64 * 32) {
            const int pos = gid >> 5, f = gid & 31;
            double inv = 1.0; for (int i = 0; i < f; ++i) inv *= 0.74989420933245582730;
            const double xa = (double)pos * inv;
            const double q = __builtin_rint(xa * 0.63661977236758134308);
            double y = __builtin_fma(-q, 1.57079632679489655800, xa); y = __builtin_fma(-q, 6.12323399573676603587e-17, y);
            const double y2 = y * y;
            double sn = -1.0 / 1307674368000.0; sn = sn * y2 + 1.0 / 6227020800.0; sn = sn * y2 - 1.0 / 39916800.0; sn = sn * y2 + 1.0 / 362880.0; sn = sn * y2 - 1.0 / 5040.0; sn = sn * y2 + 1.0 / 120.0; sn = sn * y2 - 1.0 / 6.0; sn = sn * y2 + 1.0; sn *= y;
            double cs = 1.0 / 20922789888000.0; cs = cs * y2 - 1.0 / 87178291200.0; cs = cs * y2 + 1.0 / 479001600.0; cs = cs * y2 - 1.0 / 3628800.0; cs = cs * y2 + 1.0 / 40320.0; cs = cs * y2 - 1.0 / 720.0; cs = cs * y2 + 1.0 / 24.0; cs = cs * y2 - 0.5; cs = cs * y2 + 1.0;
            const int qi = ((int)q) & 3;
            const double c2 = (qi == 0) ? cs : (qi == 1) ? -sn : (qi == 2) ? -cs : sn;
            const double s2 = (qi == 0) ? sn : (qi == 1) ? cs : (qi == 2) ? -sn : -cs;
            W_ROPE(F)[gid] = (float)c2; W_ROPE(F)[2048 + gid] = (float)s2;
        }
    }
    {
        const int per = (NU - N_IN) * D / 16;
        for (int i = F.vcu * NTHR + F.tid; i < DEPTH * per; i += F.G * NTHR) { const int l = i / per, r = i % per;
            *(u32x4*)((signed char*)(F.ws + WS_WIN) + ((size_t)l * NU + N_IN) * D + (size_t)r * 16) = (u32x4){0u, 0u, 0u, 0u}; }
        for (int i = F.vcu * NTHR + F.tid; i < DEPTH * (NU - N_IN); i += F.G * NTHR) W_SIN(F)[(size_t)(i / (NU - N_IN)) * NU + N_IN + i % (NU - N_IN)] = 1.0f;
    }
    for (int rep1 = 0; rep1 < 1 + (int)((MK_REPP0 >> 1) & 1u); ++rep1) {
        LAS float* scr = (LAS float*)(F.lds + F.wave * 16640);
        constexpr int I_OUT = 32 * 32;
        for (int it = gw; it < DEPTH * I_OUT; it += NGW) {
            const int l = it / I_OUT, r = it % I_OUT;
            transpose_item(F.w_out + (size_t)l * D * D, D, (r >> 5) * 64, (r & 31) * 64, W_WOUT(F) + (size_t)l * D * D, 0, scr, lane);
        }
    }
    __syncthreads();
    for (int it = F.G - 1 - F.vcu; it < IN_ITEMS; it += F.G) strip_item(F, it);
    if (MK_REPP0 & 4u) { for (int it = F.vcu; it < BG_TOTAL; it += F.G) strip_item(F, it); }
    __syncthreads();
}

__device__ __forceinline__ void prenorm_row(Frame& F, int l, int m, const float (&xv)[32], int row) {
    const float r = 1.0f / sqrtf(row_sumsq(xv) * (1.0f / D) + EPS);
    const float* g = F.g_pre_mix + (size_t)l * D; const float* mod = W_MOD(F) + ((size_t)l * 9 + m) * (6 * D);
    float gv[32], shv[32], scv[32], hv[32];
    row_load_f32(g, F.lane, gv); row_load_f32(mod, F.lane, shv); row_load_f32(mod + D, F.lane, scv);
#pragma unroll
    for (int i = 0; i < 32; ++i) hv[i] = xv[i] * r * gv[i] * (1.0f + scv[i]) + shv[i];
    float am = 0.f;
#pragma unroll
    for (int i = 0; i < 32; ++i) am = fmaxf(am, fabsf(hv[i]));
    am = wave_max(am);
    const float scale = am > 0.f ? am * (1.0f / 127.0f) : 1.0f;
    row_store_i8(W_HQ(F) + (size_t)row * D, F.lane, hv, 1.0f / scale);
    if (F.lane == 0) W_HS(F)[row] = scale;
}
__device__ __forceinline__ void prenorm_row_cv(Frame& F, int l, int m, const float (&xv)[32], int row) {
    const bf16* cv = W_CV(F) + ((size_t)l * 9 + m) * 6 * D;
    float c4[32], c5[32], hv[32];
    row_load_bf16(cv + 4 * D, F.lane, c4); row_load_bf16(cv + 5 * D, F.lane, c5);
    const float r = 1.0f / sqrtf(row_sumsq(xv) * (1.0f / D) + EPS);
#pragma unroll
    for (int i = 0; i < 32; ++i) hv[i] = xv[i] * r * c4[i] + c5[i];
    float am = 0.f;
#pragma unroll
    for (int i = 0; i < 32; ++i) am = fmaxf(am, fabsf(hv[i]));
    am = wave_max(am);
    const float scale = am > 0.f ? am * (1.0f / 127.0f) : 1.0f;
    row_store_i8(W_HQ(F) + (size_t)row * D, F.lane, hv, 1.0f / scale);
    if (F.lane == 0) W_HS(F)[row] = scale;
}
__device__ __forceinline__ void p0b(Frame& F) {
    const int gw = F.vcu * NWAVES + F.wave, NGW = F.G * NWAVES;
    for (int i = F.vcu * NTHR + F.tid; i < DEPTH * 9 * (D / 8); i += F.G * NTHR) {
        const int lm = i / (D / 8), k0 = (i % (D / 8)) * 8, l = lm / 9; const float* mod = W_MOD(F) + (size_t)lm * (6 * D);
        bf16* cv = W_CV(F) + (size_t)lm * 6 * D + k0;
        float o[6][8];
#pragma unroll
        for (int e = 0; e < 8; ++e) { const int k = k0 + e;
            o[0][e] = mod[2 * D + k] * F.g_post_mix[(size_t)l * D + k]; o[1][e] = F.g_pre_ffn[(size_t)l * D + k] * (1.0f + mod[4 * D + k]); o[2][e] = mod[3 * D + k];
            o[3][e] = mod[5 * D + k] * F.g_post_ffn[(size_t)l * D + k]; o[4][e] = F.g_pre_mix[(size_t)l * D + k] * (1.0f + mod[D + k]); o[5][e] = mod[k]; }
#pragma unroll
        for (int v = 0; v < 6; ++v) { u32x4 w; w.x = pk2(o[v][0], o[v][1]); w.y = pk2(o[v][2], o[v][3]); w.z = pk2(o[v][4], o[v][5]); w.w = pk2(o[v][6], o[v][7]); *(u32x4*)(cv + (size_t)v * D) = w; }
    }
    for (int row = gw; row < NROW; row += 2 * NGW) {
        const int row2 = (row + NGW < NROW) ? row + NGW : row;
        const float* xp = row < NLAT ? F.x + (size_t)row * D : F.ctx + (size_t)(row - NLAT) * D; const int m = row < NLAT ? row / SEQ : 8;
        const float* xp2 = row2 < NLAT ? F.x + (size_t)row2 * D : F.ctx + (size_t)(row2 - NLAT) * D; const int m2 = row2 < NLAT ? row2 / SEQ : 8;
        float xv[32], xv2[32]; row_load_f32_nt(xp, F.lane, xv); row_load_f32_nt(xp2, F.lane, xv2);
        prenorm_row(F, 0, m, xv, row);
        prenorm_row(F, 0, m2, xv2, row2);
    }
}

#define MFMA16(a, b, c) __builtin_amdgcn_mfma_f32_16x16x32_bf16((a), (b), (c), 0, 0, 0)
__device__ __forceinline__ bf16x8 mk8(u32x2 lo, u32x2 hi) { u32x4 t; t.x = lo.x; t.y = lo.y; t.z = hi.x; t.w = hi.y; return __builtin_bit_cast(bf16x8, t); }
#define GLA_POS(i) (dir ? (nseg - 1 - (64 * cc + (i))) : (64 * cc + (i)))
struct PpIdx { int dir, h, cc, nseg, rowbase; bool lat; };
__device__ __forceinline__ PpIdx pp_idx(int un) { PpIdx I; const int cidx = un % 36, bhd = un / 36; I.dir = bhd & 1; I.h = (bhd >> 1) & 3; const int b = bhd >> 3; I.lat = cidx >= 4; I.cc = I.lat ? cidx - 4 : cidx; I.nseg = I.lat ? SEQ : CTXL; I.rowbase = I.lat ? b * SEQ : NLAT + b * CTXL; return I; }
#define PP_POS(I, i) ((I).dir ? ((I).nseg - 1 - (64 * (I).cc + (i))) : (64 * (I).cc + (i)))
struct PpRegs { u32x4 dec[4]; unsigned vw[16]; unsigned short qraw[16], kraw[16]; float wd[8]; float bd; };
__device__ __forceinline__ void pp_load_v(Frame& F, int un, PpRegs& R) {
    const PpIdx I = pp_idx(un); const int tid = F.tid; const bf16* U = W_U(F);
    { const int c15 = tid & 15, g1 = (tid >> 4) & 1;
#pragma unroll
      for (int it = 0; it < 4; ++it) R.dec[it] = *(const u32x4*)(U + (size_t)(I.rowbase + PP_POS(I, 16 * it + c15)) * NU + U_DEC + I.dir * 16 + 8 * g1); }
    const int vq = tid & 127, jp4 = tid >> 7;
#pragma unroll
    for (int jj = 0; jj < 16; ++jj) R.vw[jj] = *(const unsigned*)(U + (size_t)(I.rowbase + PP_POS(I, 16 * jp4 + jj)) * NU + U_VB + I.h * 256 + 2 * vq);
}
__device__ __forceinline__ void pp_load_w(Frame& F, int l, int un, PpRegs& R) {
    const PpIdx I = pp_idx(un); const int ch = I.h * 128 + 16 * F.wave + (F.tid & 15), g1 = (F.tid >> 4) & 1;
#pragma unroll
    for (int r = 0; r < 8; ++r) R.wd[r] = F.w_dec[(((size_t)l * 2 + I.dir) * DECR + 8 * g1 + r) * 512 + ch];
    R.bd = F.b_dec[((size_t)l * 2 + I.dir) * 512 + ch];
}
__device__ __forceinline__ void pp_load_qk(Frame& F, int un, PpRegs& R) {
    const PpIdx I = pp_idx(un); const int k = F.tid & 127, ip = F.tid >> 7; const bf16* U = W_U(F);
#pragma unroll
    for (int ii = 0; ii < 16; ++ii) { const bf16* rp = U + (size_t)(I.rowbase + PP_POS(I, 16 * ip + ii)) * NU; R.qraw[ii] = rp[U_QB + I.h * 128 + k]; R.kraw[ii] = rp[U_KB + I.h * 128 + k]; }
}
__device__ __forceinline__ void gla_prepass(Frame& F, int l, int un, int unx, PpRegs& R) {
    const int cidx = un % 36, bhd = un / 36, dir = bhd & 1, h = (bhd >> 1) & 3, b = bhd >> 3;
    const int tid = F.tid, lane = F.lane, w = F.wave, c15 = lane & 15, g = lane >> 4;
    LAS unsigned char* L = F.lds;
    LAS bf16* Qt = (LAS bf16*)(L);
    LAS bf16* Kt = (LAS bf16*)(L + 17408);
    LAS bf16* VT = (LAS bf16*)(L + 34816);
    LAS float* PS = (LAS float*)(L + 71680);
    LAS float* ZL = (LAS float*)(L + 73728);
    const bool lat = cidx >= 4; const int cc = lat ? cidx - 4 : cidx, nseg = lat ? SEQ : CTXL, rowbase = lat ? b * SEQ : NLAT + b * CTXL;
    const bool need_out = lat || (l == 0);
    const int k = tid & 127, ip = tid >> 7;
    bf16* GQ = (bf16*)(F.ws + WS_GQ) + (size_t)un * 8192; bf16* GK = (bf16*)(F.ws + WS_GK) + (size_t)un * 8192; bf16* GV = (bf16*)(F.ws + WS_GV) + (size_t)un * 16384; float* GD = (float*)(F.ws + WS_GD) + (size_t)un * 128;
    float rcs[16], rsn[16];
    { const float* COS = W_ROPE(F); const float* SIN = COS + 2048;
#pragma unroll
      for (int ii = 0; ii < 16; ++ii) { const int pos = GLA_POS(16 * ip + ii), pp = (k < 64) ? (pos >> 6) : (pos & 63); rcs[ii] = COS[pp * 32 + (k & 31)]; rsn[ii] = SIN[pp * 32 + (k & 31)]; } }
    {
        const int vq = tid & 127, jp4 = tid >> 7; unsigned vw[16];
#pragma unroll
        for (int jj = 0; jj < 16; ++jj) vw[jj] = R.vw[jj];
        u32x4 a0, a1, b0, b1;
        a0.x = (vw[0] & 0xffffu) | (vw[1] << 16); a0.y = (vw[2] & 0xffffu) | (vw[3] << 16); a0.z = (vw[4] & 0xffffu) | (vw[5] << 16); a0.w = (vw[6] & 0xffffu) | (vw[7] << 16);
        a1.x = (vw[8] & 0xffffu) | (vw[9] << 16); a1.y = (vw[10] & 0xffffu) | (vw[11] << 16); a1.z = (vw[12] & 0xffffu) | (vw[13] << 16); a1.w = (vw[14] & 0xffffu) | (vw[15] << 16);
        b0.x = (vw[0] >> 16) | (vw[1] & 0xffff0000u); b0.y = (vw[2] >> 16) | (vw[3] & 0xffff0000u); b0.z = (vw[4] >> 16) | (vw[5] & 0xffff0000u); b0.w = (vw[6] >> 16) | (vw[7] & 0xffff0000u);
        b1.x = (vw[8] >> 16) | (vw[9] & 0xffff0000u); b1.y = (vw[10] >> 16) | (vw[11] & 0xffff0000u); b1.z = (vw[12] >> 16) | (vw[13] & 0xffff0000u); b1.w = (vw[14] >> 16) | (vw[15] & 0xffff0000u);
        *(LAS u32x4*)(VT + (2 * vq) * 72 + 16 * jp4) = a0; *(LAS u32x4*)(VT + (2 * vq) * 72 + 16 * jp4 + 8) = a1;
        *(LAS u32x4*)(VT + (2 * vq + 1) * 72 + 16 * jp4) = b0; *(LAS u32x4*)(VT + (2 * vq + 1) * 72 + 16 * jp4 + 8) = b1;
    }
    {
        u32x4 bw;
        { float ws_[8];
#pragma unroll
          for (int j = 0; j < 8; ++j) { const float wv = R.wd[j]; const float hj = bflo(pk2(wv, wv)); ws_[j] = (g >= 2) ? wv - hj : wv; }
          bw.x = pk2(ws_[0], ws_[1]); bw.y = pk2(ws_[2], ws_[3]); bw.z = pk2(ws_[4], ws_[5]); bw.w = pk2(ws_[6], ws_[7]); }
        const bf16x8 bop = __builtin_bit_cast(bf16x8, bw); const float bdv = R.bd;
#pragma unroll
        for (int it = 0; it < 4; ++it) {
            const f32x4 z4 = MFMA16(__builtin_bit_cast(bf16x8, R.dec[it]), bop, ((f32x4){bdv, bdv, bdv, bdv}));
#pragma unroll
            for (int rg = 0; rg < 4; ++rg) { const float z = z4[rg];
                const float e = __builtin_amdgcn_exp2f(fabsf(z) * -1.4426950408889634f);
                ZL[(16 * it + 4 * g + rg) * 132 + 16 * w + c15] = (fminf(z, 0.0f) * 1.4426950408889634f - __builtin_amdgcn_logf(1.0f + e)) * (1.0f / 16.0f); }
        }
    }
    asm volatile("" ::: "memory");
    pp_load_v(F, unx, R);
    pp_load_w(F, l, unx, R);
    LBAR();
    float bloc[16]; float run = 0.f;
#pragma unroll
    for (int ii = 0; ii < 16; ++ii) { run += ZL[(16 * ip + ii) * 132 + k]; bloc[ii] = run; }
    PS[ip * 128 + k] = run;
    LBAR();
    {
        float off = 0.f, btot = 0.f;
#pragma unroll
        for (int p = 0; p < 4; ++p) { const float s = PS[p * 128 + k]; btot += s; if (p < ip) off += s; }
        const float etot = __builtin_amdgcn_exp2f(btot);
        if (ip == 0) GD[k] = etot;
        unsigned short kh[16];
        float qpart[16], kpart[16];
        if (lat) {
#pragma unroll
            for (int ii = 0; ii < 16; ++ii) { qpart[ii] = __shfl_xor(bf2f(R.qraw[ii]), 32); kpart[ii] = __shfl_xor(bf2f(R.kraw[ii]), 32); }
            asm volatile("" ::: "memory");
        }
#pragma unroll
        for (int ii = 0; ii < 16; ++ii) {
            const int i = 16 * ip + ii; const float bb = bloc[ii] + off;
            float qv = bf2f(R.qraw[ii]), kv = bf2f(R.kraw[ii]);
            if (lat) {
                const float cs = rcs[ii], sn = rsn[ii];
                const float qo = qpart[ii], ko = kpart[ii];
                qv = qv * cs + ((k & 32) ? qo : -qo) * sn; kv = kv * cs + ((k & 32) ? ko : -ko) * sn;
            }
            const float eb = __builtin_amdgcn_exp2f(bb), kt = kv * __builtin_amdgcn_rcpf(eb);
            Qt[i * 136 + k] = (bf16)f2bf(qv * 0.08838834764831845f * eb);
            Kt[i * 136 + k] = (bf16)f2bf(kt);
            kh[ii] = (unsigned short)f2bf(kt * etot);
        }
        u32x4 w0, w1;
        w0.x = kh[0] | ((unsigned)kh[1] << 16); w0.y = kh[2] | ((unsigned)kh[3] << 16); w0.z = kh[4] | ((unsigned)kh[5] << 16); w0.w = kh[6] | ((unsigned)kh[7] << 16);
        w1.x = kh[8] | ((unsigned)kh[9] << 16); w1.y = kh[10] | ((unsigned)kh[11] << 16); w1.z = kh[12] | ((unsigned)kh[13] << 16); w1.w = kh[14] | ((unsigned)kh[15] << 16);
        *(u32x4*)(GK + k * 64 + 16 * ip) = w0; *(u32x4*)(GK + k * 64 + 16 * ip + 8) = w1;
    }
    asm volatile("" ::: "memory");
    pp_load_qk(F, unx, R);
    {
        const int v = tid >> 1, hf = tid & 1; const LAS bf16* sp = VT + v * 72 + 32 * hf; bf16* dp = GV + v * 64 + 32 * hf;
#pragma unroll
        for (int q = 0; q < 4; ++q) *(u32x4*)(dp + 8 * q) = *(const LAS u32x4*)(sp + 8 * q);
    }
    LBAR();
    if (need_out) {
        {
#pragma unroll
            for (int q = 0; q < 2; ++q) { const int p = tid + 512 * q, i = p >> 4, c8 = (p & 15) * 8; *(u32x4*)(GQ + i * 128 + c8) = *(const LAS u32x4*)(Qt + i * 136 + c8); }
        }
        const int ib = w & 3, vh = w >> 2;
        bf16x8 qf[4];
#pragma unroll
        for (int ks = 0; ks < 4; ++ks) qf[ks] = *(const LAS bf16x8*)(Qt + (16 * ib + c15) * 136 + 32 * ks + 8 * g);
        f32x4 at[4];
#pragma unroll
        for (int jb = 0; jb < 4; ++jb) { at[jb] = (f32x4){0.f, 0.f, 0.f, 0.f};
#pragma unroll
            for (int ks = 0; ks < 4; ++ks) { const bf16x8 a = *(const LAS bf16x8*)(Kt + (16 * jb + c15) * 136 + 32 * ks + 8 * g); at[jb] = MFMA16(a, qf[ks], at[jb]); }
#pragma unroll
            for (int rg = 0; rg < 4; ++rg) if (16 * jb + 4 * g + rg > 16 * ib + c15) at[jb][rg] = 0.f; }
        bf16x8 pf[2];
#pragma unroll
        for (int k2 = 0; k2 < 2; ++k2) { u32x4 t; t.x = pk2(at[2 * k2][0], at[2 * k2][1]); t.y = pk2(at[2 * k2][2], at[2 * k2][3]); t.z = pk2(at[2 * k2 + 1][0], at[2 * k2 + 1][1]); t.w = pk2(at[2 * k2 + 1][2], at[2 * k2 + 1][3]); pf[k2] = __builtin_bit_cast(bf16x8, t); }
        bf16* op = W_OB(F) + ((size_t)dir * NROW + rowbase + GLA_POS(16 * ib + c15)) * (HB * DVB) + h * 256 + 4 * g;
#pragma unroll
        for (int vt = 0; vt < 8; ++vt) { const int vtile = 8 * vh + vt; f32x4 o = (f32x4){0.f, 0.f, 0.f, 0.f};
#pragma unroll
            for (int k2 = 0; k2 < 2; ++k2) { const LAS bf16* vp = VT + (16 * vtile + c15) * 72 + 32 * k2 + 4 * g; o = MFMA16(mk8(*(const LAS u32x2*)vp, *(const LAS u32x2*)(vp + 16)), pf[k2], o); }
            u32x2 ov; ov.x = pk2(o[0], o[1]); ov.y = pk2(o[2], o[3]);
            *(u32x2*)(op + 16 * vtile) = ov; }
    }
    LBAR();
}
struct ChRegs { u32x4 rq[2], rk[2], rv; u32x2 oi[2]; };
__device__ __forceinline__ void gla_chain(Frame& F, int l, int ch, bool dry) {
    const int b = ch >> 5, h = (ch >> 3) & 3, dir = (ch >> 2) & 1, vs = ch & 3;
    const int tid = F.tid, lane = F.lane, w = F.wave, c15 = lane & 15, g = lane >> 4;
    LAS unsigned char* L = F.lds;
    constexpr int BUFB = 45056;
    LAS float* DKall = (LAS float*)(L + 2 * BUFB + 2 * 17408);
    LAS bf16* ST0 = (LAS bf16*)(L + 2 * BUFB);
    const int un0 = (((b * 4 + h) * 2) + dir) * 36;
    const bf16* GQ = (const bf16*)(F.ws + WS_GQ) + (size_t)un0 * 8192; const bf16* GK = (const bf16*)(F.ws + WS_GK) + (size_t)un0 * 8192;
    const bf16* GV = (const bf16*)(F.ws + WS_GV) + (size_t)un0 * 16384 + (size_t)vs * 4096; const float* GD = (const float*)(F.ws + WS_GD) + (size_t)un0 * 128;
    bf16* OBd = W_OB(F) + (size_t)dir * NROW * (HB * DVB) + h * 256 + vs * 64 + 4 * g;
    bf16* OBs = dry ? (bf16*)(F.ws + WS_DUMMY) + (size_t)dir * NROW * (HB * DVB) + h * 256 + vs * 64 + 4 * g : OBd;
    f32x4 sacc[4];
#pragma unroll
    for (int t = 0; t < 4; ++t) sacc[t] = (f32x4){0.f, 0.f, 0.f, 0.f};
    for (int i = tid; i < 64 * 136 / 2; i += NTHR) ((LAS unsigned*)ST0)[i] = 0u;
    for (int i = tid; i < 36 * 128; i += NTHR) DKall[i] = GD[i];
    const int ib = w & 3, vh = w >> 2, vt4 = w & 3, kq = w >> 2;
#define CH_OROW(c) (((c) >= 4 ? b * SEQ : NLAT + b * CTXL) + (dir ? (((c) >= 4 ? SEQ : CTXL) - 1 - (64 * ((c) >= 4 ? (c) - 4 : (c)) + 16 * ib + c15)) : (64 * ((c) >= 4 ? (c) - 4 : (c)) + 16 * ib + c15)))
#define CH_LOAD(R, c) do { const bool no_ = (c) >= 4 || l == 0; \
        _Pragma("unroll") for (int q_ = 0; q_ < 2; ++q_) { const int p_ = tid + 512 * q_; if (no_) R.rq[q_] = *(const u32x4*)(GQ + (size_t)(c) * 8192 + p_ * 8); R.rk[q_] = *(const u32x4*)(GK + (size_t)(c) * 8192 + p_ * 8); } \
        R.rv = *(const u32x4*)(GV + (size_t)(c) * 16384 + tid * 8); \
        if (no_) { const bf16* op_ = OBd + (size_t)CH_OROW(c) * (HB * DVB); R.oi[0] = *(const u32x2*)(op_ + 16 * (2 * vh)); R.oi[1] = *(const u32x2*)(op_ + 16 * (2 * vh + 1)); } } while (0)
#define CH_PUT(R, bs) do { LAS unsigned char* B_ = L + (bs) * BUFB; \
        _Pragma("unroll") for (int q_ = 0; q_ < 2; ++q_) { const int p_ = tid + 512 * q_; *(LAS u32x4*)((LAS bf16*)B_ + (p_ >> 4) * 136 + (p_ & 15) * 8) = R.rq[q_]; *(LAS u32x4*)((LAS bf16*)(B_ + 17408) + (p_ >> 3) * 72 + (p_ & 7) * 8) = R.rk[q_]; } \
        *(LAS u32x4*)((LAS bf16*)(B_ + 35840) + (tid >> 3) * 72 + (tid & 7) * 8) = R.rv; } while (0)
#define CH_STEP(cidx, RC, RN) do { \
        const bool need_out_ = (cidx) >= 4 || l == 0; const int bs_ = (cidx) & 1; \
        LAS unsigned char* B = L + bs_ * BUFB; \
        const LAS bf16* Qt = (const LAS bf16*)B; const LAS bf16* KhT = (const LAS bf16*)(B + 17408); const LAS bf16* VTs = (const LAS bf16*)(B + 35840); const LAS float* Dk = DKall + (cidx) * 128; \
        const LAS bf16* STr = ST0 + bs_ * (64 * 136); LAS bf16* STw = ST0 + (bs_ ^ 1) * (64 * 136); \
        const u32x2 oi0_ = RC.oi[0], oi1_ = RC.oi[1];                       \
        if ((cidx) + 2 < 36) CH_LOAD(RC, (cidx) + 2);                         \
          \
        if (need_out_) { \
            bf16x8 qf[4], sf[2][4]; \
            _Pragma("unroll") for (int ks = 0; ks < 4; ++ks) qf[ks] = *(const LAS bf16x8*)(Qt + (16 * ib + c15) * 136 + 32 * ks + 8 * g); \
            _Pragma("unroll") for (int vt = 0; vt < 2; ++vt) _Pragma("unroll") for (int ks = 0; ks < 4; ++ks) sf[vt][ks] = *(const LAS bf16x8*)(STr + (16 * (2 * vh + vt) + c15) * 136 + 32 * ks + 8 * g); \
            asm volatile("" ::: "memory"); \
            bf16* op = OBs + (size_t)CH_OROW(cidx) * (HB * DVB); \
            _Pragma("unroll") for (int vt = 0; vt < 2; ++vt) { const int vtile = 2 * vh + vt; f32x4 o = (f32x4){0.f, 0.f, 0.f, 0.f}; \
                _Pragma("unroll") for (int ks = 0; ks < 4; ++ks) o = MFMA16(sf[vt][ks], qf[ks], o); \
                const u32x2 oi_ = vt ? oi1_ : oi0_; \
                u32x2 ov; ov.x = pk2(o[0] + bflo(oi_.x), o[1] + bfhi(oi_.x)); ov.y = pk2(o[2] + bflo(oi_.y), o[3] + bfhi(oi_.y)); \
                *(u32x2*)(op + 16 * vtile) = ov; } \
        } \
        { bf16x8 va[2], kb[4][2]; float dk[4]; \
        _Pragma("unroll") for (int k2 = 0; k2 < 2; ++k2) va[k2] = *(const LAS bf16x8*)(VTs + (16 * vt4 + c15) * 72 + 32 * k2 + 8 * g); \
        _Pragma("unroll") for (int t4 = 0; t4 < 4; ++t4) { dk[t4] = Dk[16 * (4 * kq + t4) + c15]; _Pragma("unroll") for (int k2 = 0; k2 < 2; ++k2) kb[t4][k2] = *(const LAS bf16x8*)(KhT + (16 * (4 * kq + t4) + c15) * 72 + 32 * k2 + 8 * g); } \
        asm volatile("" ::: "memory"); \
        _Pragma("unroll") for (int t4 = 0; t4 < 4; ++t4) { const int kt = 4 * kq + t4; \
            sacc[t4] = sacc[t4] * dk[t4]; \
            _Pragma("unroll") for (int k2 = 0; k2 < 2; ++k2) sacc[t4] = MFMA16(va[k2], kb[t4][k2], sacc[t4]); \
            _Pragma("unroll") for (int rg = 0; rg < 4; ++rg) STw[(16 * vt4 + 4 * g + rg) * 136 + 16 * kt + c15] = (bf16)f2bf(sacc[t4][rg]); } } \
        if ((cidx) + 1 < 36) CH_PUT(RN, bs_ ^ 1);                             \
        LBAR(); \
    } while (0)
    ChRegs RA, RB;
    RA.rq[0] = RA.rq[1] = RB.rq[0] = RB.rq[1] = (u32x4){0u, 0u, 0u, 0u}; RA.oi[0] = RA.oi[1] = RB.oi[0] = RB.oi[1] = (u32x2){0u, 0u};
    CH_LOAD(RA, 0); CH_PUT(RA, 0); CH_LOAD(RB, 1);
    LBAR();
    for (int c2 = 0; c2 < 36; c2 += 2) {
        CH_STEP(c2, RA, RB);
        CH_STEP(c2 + 1, RB, RA);
    }
#undef CH_LOAD
#undef CH_PUT
#undef CH_STEP
#undef CH_OROW
}
#undef GLA_POS

__device__ __forceinline__ int clampi(int v, int lo, int hi) { return v < lo ? lo : (v > hi ? hi : v); }
template <int NB, bool LOCAL>
__device__ __forceinline__ void attn_tile(const LAS bf16* Kt, const LAS bf16* Vt, const LAS float* bias_row, const bf16x8 (&qf)[2], int kb0, const int (&dco)[8], int c15, int g, float& m_run, float& l_run, f32x4 (&oacc)[4]) {
    f32x4 sc[NB];
    {
        bf16x8 kf[NB][2]; float bv[NB][4];
#pragma unroll
        for (int nb = 0; nb < NB; ++nb) {
#pragma unroll
            for (int s = 0; s < 2; ++s) kf[nb][s] = *(const LAS bf16x8*)(Kt + (kb0 + 16 * nb + c15) * 72 + 32 * s + 8 * g);
            if (LOCAL) {
#pragma unroll
                for (int rg = 0; rg < 4; ++rg) bv[nb][rg] = bias_row[dco[(4 * nb + rg) & 7]]; } }
        asm volatile("" ::: "memory");
#pragma unroll
        for (int nb = 0; nb < NB; ++nb) { sc[nb] = (f32x4){0.f, 0.f, 0.f, 0.f};
#pragma unroll
            for (int s = 0; s < 2; ++s) sc[nb] = MFMA16(kf[nb][s], qf[s], sc[nb]);
#pragma unroll
            for (int rg = 0; rg < 4; ++rg) sc[nb][rg] = sc[nb][rg] * 0.18033688011112042f + (LOCAL ? bv[nb][rg] : 0.f); }
    }
    float mt = -1e30f;
#pragma unroll
    for (int nb = 0; nb < NB; ++nb)
#pragma unroll
        for (int rg = 0; rg < 4; ++rg) mt = fmaxf(mt, sc[nb][rg]);
    mt = fmaxf(mt, __shfl_xor(mt, 16)); mt = fmaxf(mt, __shfl_xor(mt, 32));
    const float m_new = fmaxf(m_run, mt), alpha = __builtin_amdgcn_exp2f(m_run - m_new);
    m_run = m_new; float ps = 0.f;
#pragma unroll
    for (int nb = 0; nb < NB; ++nb)
#pragma unroll
        for (int rg = 0; rg < 4; ++rg) { const float p = __builtin_amdgcn_exp2f(sc[nb][rg] - m_new); sc[nb][rg] = p; ps += p; }
    l_run = l_run * alpha + ps;
    bf16x8 pf[NB / 2];
#pragma unroll
    for (int k2 = 0; k2 < NB / 2; ++k2) { u32x4 tt; tt.x = pk2(sc[2 * k2][0], sc[2 * k2][1]); tt.y = pk2(sc[2 * k2][2], sc[2 * k2][3]); tt.z = pk2(sc[2 * k2 + 1][0], sc[2 * k2 + 1][1]); tt.w = pk2(sc[2 * k2 + 1][2], sc[2 * k2 + 1][3]); pf[k2] = __builtin_bit_cast(bf16x8, tt); }
    {
        bf16x8 vf[4][NB / 2];
#pragma unroll
        for (int d = 0; d < 4; ++d)
#pragma unroll
            for (int k2 = 0; k2 < NB / 2; ++k2) { const LAS bf16* vp = Vt + (16 * d + c15) * 72 + kb0 + 32 * k2 + 4 * g; vf[d][k2] = mk8(*(const LAS u32x2*)vp, *(const LAS u32x2*)(vp + 16)); }
        asm volatile("" ::: "memory");
#pragma unroll
        for (int d = 0; d < 4; ++d) { oacc[d] = oacc[d] * alpha;
#pragma unroll
            for (int k2 = 0; k2 < NB / 2; ++k2) oacc[d] = MFMA16(vf[d][k2], pf[k2], oacc[d]); }
    }
}
__device__ __forceinline__ void attn_unit(Frame& F, int l, int u) {
    const int tid = F.tid, lane = F.lane, w = F.wave, c15 = lane & 15, g = lane >> 4;
    LAS unsigned char* L = F.lds;
    LAS bf16* Ks = (LAS bf16*)L;
    LAS bf16* VTs = (LAS bf16*)(L + 18432);
    LAS float* rpbs = (LAS float*)(L + 36864);
    const bool isctx = u >= 1024;
    int b, h, r0 = 0, qb = 0;
    if (!isctx) { b = u >> 7; h = (u >> 4) & 7; r0 = (u & 15) * 2; } else { const int cu = u - 1024; b = cu >> 4; h = (cu >> 1) & 7; qb = cu & 1; }
    const int r = r0 + (w >> 2), cq = 16 * (w & 3) + c15;
    const int qrow = isctx ? NLAT + b * CTXL + qb * 128 + 16 * w + c15 : b * SEQ + r * 64 + cq;
    bf16x8 qf[2];
#pragma unroll
    for (int s = 0; s < 2; ++s) qf[s] = *(const bf16x8*)(W_U(F) + (size_t)qrow * NU + U_QA + h * 64 + 32 * s + 8 * g);
    int lo = 0, nloc = 0, rs = 0;
    if (!isctx) { lo = clampi(r0 - 4, 0, 24); nloc = clampi(r0 - 3, 0, 24) + 8 - lo; rs = clampi(r - 4, 0, 24); }
    const int ntiles = nloc + 4, cs0 = clampi(cq - 8, 0, 48), kb0 = clampi(16 * (w & 3) - 8, 0, 32);
    if (!isctx) for (int i = tid; i < 15 * 32; i += NTHR) { const int rr = i >> 5, cc2 = i & 31; rpbs[i] = cc2 < 31 ? F.rpb[((size_t)l * HA + h) * 465 + rr * 31 + cc2] * 1.4426950408889634f : -1e30f; }
    int dco[8];
#pragma unroll
    for (int e8 = 0; e8 < 8; ++e8) { const int ck = kb0 + 16 * (e8 >> 2) + 4 * g + (e8 & 3); dco[e8] = (ck >= cs0 && ck < cs0 + 16) ? clampi(ck - cq + 15, 0, 30) : 31; }
    const int key = tid >> 3, ch8 = (tid & 7) * 8;
#define ATT_ROW(t) ((t) < nloc ? b * SEQ + (lo + (t)) * 64 + key : NLAT + b * CTXL + ((t) - nloc) * 64 + key)
#define ATT_PUT(KR, VR, buf) do { *(LAS u32x4*)(Ks + (buf) * 4608 + key * 72 + ch8) = KR; LAS bf16* vp_ = VTs + (buf) * 4608 + ch8 * 72 + key; \
        vp_[0] = (bf16)(VR.x & 0xffffu); vp_[72] = (bf16)(VR.x >> 16); vp_[144] = (bf16)(VR.y & 0xffffu); vp_[216] = (bf16)(VR.y >> 16); \
        vp_[288] = (bf16)(VR.z & 0xffffu); vp_[360] = (bf16)(VR.z >> 16); vp_[432] = (bf16)(VR.w & 0xffffu); vp_[504] = (bf16)(VR.w >> 16); } while (0)
#define ATT_LD(KR, VR, t) do { if ((t) < ntiles) { const bf16* rp_ = W_U(F) + (size_t)ATT_ROW(t) * NU + h * 64 + ch8; KR = *(const u32x4*)(rp_ + U_KA); VR = *(const u32x4*)(rp_ + U_VA); } } while (0)
#define ATT_STEP(t, KN, VN) do { if ((t) < ntiles) { const int buf = (t) & 1; const bool local = (t) < nloc; const int kr = lo + (t); \
        const bool active = !local || (kr >= rs && kr <= rs + 7); \
        if (active) { \
            if (local) attn_tile<2, true>(Ks + buf * 4608, VTs + buf * 4608, rpbs + (kr - r + 7) * 32, qf, kb0, dco, c15, g, m_run, l_run, oacc); \
            else attn_tile<4, false>(Ks + buf * 4608, VTs + buf * 4608, rpbs, qf, 0, dco, c15, g, m_run, l_run, oacc); \
        } \
        if ((t) + 1 < ntiles) ATT_PUT(KN, VN, buf ^ 1); \
        ATT_LD(KN, VN, (t) + 4); \
        LBAR(); } } while (0)
    u32x4 k0 = (u32x4){0u, 0u, 0u, 0u}, v0 = k0, k1 = k0, v1 = k0, k2 = k0, v2 = k0;
    ATT_LD(k0, v0, 0);
    ATT_PUT(k0, v0, 0);
    ATT_LD(k1, v1, 1); ATT_LD(k2, v2, 2); ATT_LD(k0, v0, 3);
    LBAR();
    float m_run = -1e30f, l_run = 0.f;
    f32x4 oacc[4];
#pragma unroll
    for (int d = 0; d < 4; ++d) oacc[d] = (f32x4){0.f, 0.f, 0.f, 0.f};
    for (int t3 = 0; t3 < ntiles; t3 += 3) {
        ATT_STEP(t3, k1, v1);
        ATT_STEP(t3 + 1, k2, v2);
        ATT_STEP(t3 + 2, k0, v0);
    }
#undef ATT_LD
#undef ATT_STEP
    float lt = l_run; lt += __shfl_xor(lt, 16); lt += __shfl_xor(lt, 32);
    const float inv = 1.0f / lt;
#pragma unroll
    for (int d = 0; d < 4; ++d) { u32x2 ov; ov.x = pk2(oacc[d][0] * inv, oacc[d][1] * inv); ov.y = pk2(oacc[d][2] * inv, oacc[d][3] * inv);
        *(u32x2*)(W_MIX(F) + (size_t)qrow * D + MIX_A + h * 64 + 16 * d + 4 * g) = ov; }
#undef ATT_ROW
#undef ATT_PUT
}

__device__ __forceinline__ void gmlp_unit(Frame& F, int l, int u) {
    const int tid = F.tid, lane = F.lane, w = F.wave, c15 = lane & 15, g = lane >> 4;
    LAS bf16* Wl = (LAS bf16*)F.lds;
    LAS bf16* VTl = (LAS bf16*)(F.lds + 34816);
    int rowbase, gg;
    if (u < 512) { const int b = u >> 6, n = (u >> 2) & 15; gg = u & 3; rowbase = b * SEQ + n * MIXC; } else { const int cu = u - 512, b = cu >> 3, n = (cu >> 2) & 1; gg = cu & 3; rowbase = NLAT + b * CTXL + n * MIXC; }
    {
        const int p = tid >> 2, q0 = (tid & 3) * 32; const float* wp = F.w_sp + (((size_t)l * GC + gg) * MIXC + p) * MIXC + q0;
#pragma unroll
        for (int j = 0; j < 4; ++j) { const f32x4 a = *(const f32x4*)(wp + 8 * j), b2 = *(const f32x4*)(wp + 8 * j + 4); u32x4 o; o.x = pk2(a[0], a[1]); o.y = pk2(a[2], a[3]); o.z = pk2(b2[0], b2[1]); o.w = pk2(b2[2], b2[3]); *(LAS u32x4*)(Wl + p * 136 + q0 + 8 * j) = o; }
    }
    {
        const int pos = tid >> 2, c0 = (tid & 3) * 32; const bf16* vp = W_U(F) + (size_t)(rowbase + pos) * NU + U_VC + gg * CG + c0;
        float xv[32];
#pragma unroll
        for (int j = 0; j < 4; ++j) { const u32x4 a = *(const u32x4*)(vp + 8 * j);
            xv[8 * j + 0] = gelu_tanh(bflo(a.x)); xv[8 * j + 1] = gelu_tanh(bfhi(a.x)); xv[8 * j + 2] = gelu_tanh(bflo(a.y)); xv[8 * j + 3] = gelu_tanh(bfhi(a.y));
            xv[8 * j + 4] = gelu_tanh(bflo(a.z)); xv[8 * j + 5] = gelu_tanh(bfhi(a.z)); xv[8 * j + 6] = gelu_tanh(bflo(a.w)); xv[8 * j + 7] = gelu_tanh(bfhi(a.w)); }
        float s = 0.f;
#pragma unroll
        for (int i = 0; i < 32; ++i) s += xv[i];
        s += __shfl_xor(s, 1); s += __shfl_xor(s, 2);
        const float mu = s * (1.0f / CG); float q = 0.f;
#pragma unroll
        for (int i = 0; i < 32; ++i) { const float d = xv[i] - mu; q += d * d; }
        q += __shfl_xor(q, 1); q += __shfl_xor(q, 2);
        const float rstd = 1.0f / sqrtf(q * (1.0f / CG) + EPS);
        const float* lg = F.ln_v_g + (size_t)l * (GC * CG) + gg * CG + c0; const float* lb = F.ln_v_b + (size_t)l * (GC * CG) + gg * CG + c0;
#pragma unroll
        for (int i = 0; i < 32; ++i) VTl[(c0 + i) * 136 + pos] = (bf16)f2bf((xv[i] - mu) * rstd * lg[i] + lb[i]);
    }
    __syncthreads();
    {
        const int pos = 16 * w + c15, row = rowbase + pos;
        const float bsp = F.b_sp[((size_t)l * GC + gg) * MIXC + pos];
        bf16x8 wf[4];
#pragma unroll
        for (int ks = 0; ks < 4; ++ks) wf[ks] = *(const LAS bf16x8*)(Wl + pos * 136 + 32 * ks + 8 * g);
        u32x2 uu8[8];
#pragma unroll
        for (int cb = 0; cb < 8; ++cb) uu8[cb] = *(const u32x2*)(W_U(F) + (size_t)row * NU + U_UC + gg * CG + 16 * cb + 4 * g);
#pragma unroll
        for (int cb = 0; cb < 8; ++cb) { f32x4 acc = (f32x4){0.f, 0.f, 0.f, 0.f};
#pragma unroll
            for (int ks = 0; ks < 4; ++ks) { const bf16x8 a = *(const LAS bf16x8*)(VTl + (16 * cb + c15) * 136 + 32 * ks + 8 * g); acc = MFMA16(a, wf[ks], acc); }
            const int col = gg * CG + 16 * cb + 4 * g;
            const u32x2 uu = uu8[cb];
            u32x2 ov; ov.x = pk2(gelu_tanh(bflo(uu.x)) * (acc[0] + bsp), gelu_tanh(bfhi(uu.x)) * (acc[1] + bsp)); ov.y = pk2(gelu_tanh(bflo(uu.y)) * (acc[2] + bsp), gelu_tanh(bfhi(uu.y)) * (acc[3] + bsp));
            *(u32x2*)(W_MIX(F) + (size_t)row * D + MIX_C + col) = ov; }
    }
    __syncthreads();
}

#ifndef MK_REPMIX
#define MK_REPMIX 0u
#endif
__device__ __forceinline__ void p_mixers(Frame& F, int l) {
    for (int rep = 0; rep < 1 + (int)(MK_REPMIX & 1u); ++rep) { PpRegs R; int un = F.vcu; if (un < 2304) { pp_load_v(F, un, R); pp_load_w(F, l, un, R); pp_load_qk(F, un, R); } for (; un < 2304; un += F.G) { launder(F); gla_prepass(F, l, un, (un + F.G < 2304) ? un + F.G : un, R); } }
    const int na = (l == 0) ? 1152 : 1024, nc = (l == 0) ? 576 : 512;
    for (int rep = 0; rep < 1 + (int)((MK_REPMIX >> 1) & 1u); ++rep) { for (int u = F.vcu; u < na; u += F.G) attn_unit(F, l, u); }
    __syncthreads();
    for (int rep = 0; rep < 1 + (int)((MK_REPMIX >> 2) & 1u); ++rep) { for (int u = (F.vcu + F.G / 2) % F.G; u < nc; u += F.G) gmlp_unit(F, l, u); }
}
__device__ __forceinline__ void p_chains(Frame& F, int l) {
    for (int rep = 0; rep < 1 + (int)((MK_REPMIX >> 3) & 1u); ++rep) for (int ch = F.vcu; ch < 256; ch += F.G) { gla_chain(F, l, ch, rep + 1 < 1 + (int)((MK_REPMIX >> 3) & 1u)); __syncthreads(); }
}

__device__ __forceinline__ void p_glaout(Frame& F, int l) {
    const int gw = F.vcu * NWAVES + F.wave, NGW = F.G * NWAVES, lane = F.lane, nrows = (l == 0) ? NROW : NLAT;
    for (int row = gw; row < nrows; row += NGW) {
#pragma unroll
        for (int j = 0; j < 2; ++j) { const int idx = 512 * j + 8 * lane;
            const u32x4 a = __builtin_nontemporal_load((const u32x4*)(W_OB(F) + (size_t)row * 1024 + idx)), b2 = __builtin_nontemporal_load((const u32x4*)(W_OB(F) + ((size_t)NROW + row) * 1024 + idx));
            float o[8]; o[0] = bflo(a.x) + bflo(b2.x); o[1] = bfhi(a.x) + bfhi(b2.x); o[2] = bflo(a.y) + bflo(b2.y); o[3] = bfhi(a.y) + bfhi(b2.y); o[4] = bflo(a.z) + bflo(b2.z); o[5] = bfhi(a.z) + bfhi(b2.z); o[6] = bflo(a.w) + bflo(b2.w); o[7] = bfhi(a.w) + bfhi(b2.w);
            float ss = 0.f;
#pragma unroll
            for (int e = 0; e < 8; ++e) ss += o[e] * o[e];
#pragma unroll
            for (int s = 1; s < 32; s <<= 1) ss += __shfl_xor(ss, s);
            const float rn = 1.0f / sqrtf(ss * (1.0f / DVB) + EPS);
            const float* gp = F.g_gla + (size_t)l * 1024 + idx; const f32x4 g0 = *(const f32x4*)gp, g1 = *(const f32x4*)(gp + 4);
            const u32x4 gb = __builtin_nontemporal_load((const u32x4*)(W_U(F) + (size_t)row * NU + U_GB + idx));
            float r8[8];
            r8[0] = o[0] * rn * g0[0] * silu_f(bflo(gb.x)); r8[1] = o[1] * rn * g0[1] * silu_f(bfhi(gb.x)); r8[2] = o[2] * rn * g0[2] * silu_f(bflo(gb.y)); r8[3] = o[3] * rn * g0[3] * silu_f(bfhi(gb.y));
            r8[4] = o[4] * rn * g1[0] * silu_f(bflo(gb.z)); r8[5] = o[5] * rn * g1[1] * silu_f(bfhi(gb.z)); r8[6] = o[6] * rn * g1[2] * silu_f(bflo(gb.w)); r8[7] = o[7] * rn * g1[3] * silu_f(bfhi(gb.w));
            u32x4 ov; ov.x = pk2(r8[0], r8[1]); ov.y = pk2(r8[2], r8[3]); ov.z = pk2(r8[4], r8[5]); ov.w = pk2(r8[6], r8[7]);
            *(u32x4*)(W_MIX(F) + (size_t)row * D + MIX_B + idx) = ov; }
    }
}

struct PmRow { u32x4 y[4]; f32x4 x[8]; };
__device__ __forceinline__ void unpack8(const u32x4 a, float* o) { o[0] = bflo(a.x); o[1] = bfhi(a.x); o[2] = bflo(a.y); o[3] = bfhi(a.y); o[4] = bflo(a.z); o[5] = bfhi(a.z); o[6] = bflo(a.w); o[7] = bfhi(a.w); }
__device__ __forceinline__ void postmix_load_y(Frame& F, int row, PmRow& R) {
    const bf16* yp = W_Y(F) + (size_t)row * D + 8 * F.lane;
#pragma unroll
    for (int j = 0; j < 4; ++j) R.y[j] = __builtin_nontemporal_load((const u32x4*)(yp + 512 * j));
}
template <bool FIRST> __device__ __forceinline__ void postmix_load_x(Frame& F, int row, PmRow& R) {
    const int lane = F.lane;
    if constexpr (FIRST) { const float* xin = (row < NLAT ? F.x + (size_t)row * D : F.ctx + (size_t)(row - NLAT) * D) + 8 * lane;
#pragma unroll
        for (int j = 0; j < 4; ++j) { R.x[2 * j] = __builtin_nontemporal_load((const f32x4*)(xin + 512 * j)); R.x[2 * j + 1] = __builtin_nontemporal_load((const f32x4*)(xin + 512 * j + 4)); } }
    else { const bf16* xb = W_XB(F) + (size_t)row * D + 8 * lane;
#pragma unroll
        for (int j = 0; j < 4; ++j) R.x[j] = __builtin_bit_cast(f32x4, __builtin_nontemporal_load((const u32x4*)(xb + 512 * j))); }
}
template <bool FIRST> __device__ __forceinline__ void postmix_s1(Frame& F, int l, int row, const PmRow& R, const u32x4 (&c0p)[4], float (&xv)[32], bool dry) {
    const int lane = F.lane;
    float ss = 0.f;
#pragma unroll
    for (int j = 0; j < 4; ++j) { float y8[8]; unpack8(R.y[j], y8);
#pragma unroll
        for (int e = 0; e < 8; ++e) ss += y8[e] * y8[e]; }
    const float r1 = 1.0f / sqrtf(wave_sum(ss) * (1.0f / D) + EPS);
    bf16* xdst = dry ? (bf16*)(F.ws + WS_DUMMY) + (size_t)row * D : W_XB(F) + (size_t)row * D;
#pragma unroll
    for (int j = 0; j < 4; ++j) { float y8[8], c8[8], x8[8]; unpack8(R.y[j], y8); unpack8(c0p[j], c8);
        if constexpr (FIRST) { x8[0] = R.x[2 * j][0]; x8[1] = R.x[2 * j][1]; x8[2] = R.x[2 * j][2]; x8[3] = R.x[2 * j][3]; x8[4] = R.x[2 * j + 1][0]; x8[5] = R.x[2 * j + 1][1]; x8[6] = R.x[2 * j + 1][2]; x8[7] = R.x[2 * j + 1][3]; }
        else unpack8(__builtin_bit_cast(u32x4, R.x[j]), x8);
#pragma unroll
        for (int e = 0; e < 8; ++e) xv[8 * j + e] = x8[e] + c8[e] * (y8[e] * r1); }
    row_store_bf16(xdst, lane, xv);
}
__device__ __forceinline__ void postmix_s2(Frame& F, int row, const u32x4 (&c1p)[4], const u32x4 (&c2p)[4], float (&xv)[32]) {
    const int lane = F.lane;
    const float r2 = 1.0f / sqrtf(row_sumsq(xv) * (1.0f / D) + EPS);
#pragma unroll
    for (int j = 0; j < 4; ++j) { float c1[8], c2[8]; unpack8(c1p[j], c1); unpack8(c2p[j], c2);
#pragma unroll
        for (int e = 0; e < 8; ++e) xv[8 * j + e] = xv[8 * j + e] * r2 * c1[e] + c2[e]; }
    float am = 0.f;
#pragma unroll
    for (int i = 0; i < 32; ++i) am = fmaxf(am, fabsf(xv[i]));
    am = wave_max(am);
    const float scale = am > 0.f ? am * (1.0f / 127.0f) : 1.0f;
    row_store_i8(W_HQ(F) + (size_t)row * D, lane, xv, 1.0f / scale);
    if (lane == 0) W_HS(F)[row] = scale;
}
template <bool FIRST> __device__ __forceinline__ void p_postmix_t(Frame& F, int l, bool dry) {
    const int gw = F.vcu * NWAVES + F.wave, NGW = F.G * NWAVES, lane = F.lane, nrows = (l == 0) ? NROW : NLAT;
    LAS float* WR = (LAS float*)F.lds;
    for (int i = F.tid; i < D * 4; i += NTHR) { const int k = i >> 2, e4 = (i & 3) * 4; const f32x4 wv = *(const f32x4*)(F.w_router + ((size_t)l * D + k) * NE + e4);
        WR[(e4 + 0) * D + k] = wv[0]; WR[(e4 + 1) * D + k] = wv[1]; WR[(e4 + 2) * D + k] = wv[2]; WR[(e4 + 3) * D + k] = wv[3]; }
    __syncthreads();
    const int npair = nrows / 2, pbase = npair / NGW, prem = npair % NGW;
    const int p0 = gw * pbase + (gw < prem ? gw : prem), p1 = p0 + pbase + (gw < prem ? 1 : 0);
    PmRow RA, RB;
    if (p0 < p1) { postmix_load_y(F, 2 * p0, RA); postmix_load_x<FIRST>(F, 2 * p0, RA); postmix_load_y(F, 2 * p0 + 1, RB); if constexpr (!FIRST) postmix_load_x<FIRST>(F, 2 * p0 + 1, RB); }
    for (int p = p0; p < p1; ++p) {
        launder(F);
        const int row = 2 * p, row2 = row + 1; const bool has2 = true; const int lane = F.lane;
        float h0[32], h1[32];
        {
            const int m0 = row < NLAT ? row / SEQ : 8;
            u32x4 c0p[4], c1p[4], c2p[4]; const bf16* cva = W_CV(F) + ((size_t)l * 9 + m0) * 6 * D + 8 * lane;
#pragma unroll
            for (int j = 0; j < 4; ++j) c0p[j] = *(const u32x4*)(cva + 512 * j);
            if constexpr (FIRST) postmix_load_x<FIRST>(F, row2, RB);
            postmix_s1<FIRST>(F, l, row, RA, c0p, h0, dry);
            asm volatile("" ::: "memory");
#pragma unroll
            for (int j = 0; j < 4; ++j) { c1p[j] = *(const u32x4*)(cva + D + 512 * j); c2p[j] = *(const u32x4*)(cva + 2 * D + 512 * j); }
            postmix_s1<FIRST>(F, l, row2, RB, c0p, h1, dry);
            postmix_s2(F, row, c1p, c2p, h0);
            postmix_s2(F, row2, c1p, c2p, h1);
        }
        asm volatile("" ::: "memory");
        if (p + 1 < p1) { postmix_load_y(F, row + 2, RA); postmix_load_x<FIRST>(F, row + 2, RA); postmix_load_y(F, row + 3, RB); if constexpr (!FIRST) postmix_load_x<FIRST>(F, row + 3, RB); }
        asm volatile("" ::: "memory");
        float a0[16], a1[16];
#pragma unroll
        for (int e = 0; e < 16; ++e) { a0[e] = 0.f; a1[e] = 0.f; }
#pragma unroll
        for (int j = 0; j < 4; ++j) {
#pragma unroll
            for (int e = 0; e < 16; ++e) { const LAS float* wp = WR + e * D + 512 * j + 8 * lane; const f32x4 wa = *(const LAS f32x4*)wp, wb = *(const LAS f32x4*)(wp + 4);
                a0[e] += h0[8 * j] * wa[0] + h0[8 * j + 1] * wa[1] + h0[8 * j + 2] * wa[2] + h0[8 * j + 3] * wa[3] + h0[8 * j + 4] * wb[0] + h0[8 * j + 5] * wb[1] + h0[8 * j + 6] * wb[2] + h0[8 * j + 7] * wb[3];
                a1[e] += h1[8 * j] * wa[0] + h1[8 * j + 1] * wa[1] + h1[8 * j + 2] * wa[2] + h1[8 * j + 3] * wa[3] + h1[8 * j + 4] * wb[0] + h1[8 * j + 5] * wb[1] + h1[8 * j + 6] * wb[2] + h1[8 * j + 7] * wb[3];
                if ((e & 1) == 1) asm volatile("" ::: "memory"); }
        }
        float mx0 = -1e30f, mx1 = -1e30f;
#pragma unroll
        for (int e = 0; e < 16; ++e) { a0[e] = wave_sum(a0[e]); a1[e] = wave_sum(a1[e]); mx0 = fmaxf(mx0, a0[e]); mx1 = fmaxf(mx1, a1[e]); }
        float s0 = 0.f, s1 = 0.f;
#pragma unroll
        for (int e = 0; e < 16; ++e) { a0[e] = __expf(a0[e] - mx0); a1[e] = __expf(a1[e] - mx1); s0 += a0[e]; s1 += a1[e]; }
        float val = 0.f;
#pragma unroll
        for (int e = 0; e < 16; ++e) { if ((lane & 15) == e) val = (lane < 16) ? a0[e] / s0 : a1[e] / s1; }
        if (lane < 16) W_AFF(F)[(size_t)row * NE + lane] = val;
        else if (lane < 32 && has2) W_AFF(F)[(size_t)row2 * NE + (lane & 15)] = val;
    }
}

__device__ __forceinline__ void p_postmix(Frame& F, int l, bool dry) { if (l == 0) p_postmix_t<true>(F, l, dry); else p_postmix_t<false>(F, l, dry); }

__device__ __forceinline__ int block_excl_scan(int v, LAS int* tmp, int lane, int wave, int& total) {
    int inc = v;
#pragma unroll
    for (int o = 1; o < 64; o <<= 1) { const int t = __shfl_up(inc, o); if (lane >= o) inc += t; }
    if (lane == 63) tmp[wave] = inc;
    __syncthreads();
    int base = 0, tot = 0;
#pragma unroll
    for (int ww = 0; ww < 8; ++ww) { const int t = tmp[ww]; tot += t; if (ww < wave) base += t; }
    __syncthreads();
    total = tot; return base + inc - v;
}
__device__ __forceinline__ void p_topk(Frame& F, int l) {
    const int tid = F.tid, lane = F.lane, wave = F.wave;
    LAS int* hist = (LAS int*)F.lds;
    LAS int* misc = (LAS int*)(F.lds + 1024);
    LAS int* stmp = (LAS int*)(F.lds + 1152);
    LAS int* list = (LAS int*)(F.lds + 2048);
    const int nsets = (l == 0) ? 256 : 128, ME = (l == 0) ? ME0 : ME1;
    for (int s = F.vcu; s < nsets; s += F.G) {
        const bool isctx = s >= 128; const int ss = isctx ? s - 128 : s, b = ss >> 4, e = ss & 15;
        const int n = isctx ? CTXL : SEQ, cap = isctx ? CAPC : CAPL, base = isctx ? NLAT + b * CTXL : b * SEQ, slot0 = isctx ? NB * CAPL + b * CAPC : b * CAPL;
        unsigned bits[4];
#pragma unroll
        for (int c = 0; c < 4; ++c) { const int i = 4 * tid + c; bits[c] = (i < n) ? __builtin_bit_cast(unsigned, W_AFF(F)[(size_t)(base + i) * NE + e]) : 0u; }
        unsigned prefix = 0u; int krem = cap;
        for (int pass = 0; pass < 4; ++pass) {
            const int shift = 24 - 8 * pass;
            if (tid < 256) hist[tid] = 0;
            __syncthreads();
#pragma unroll
            for (int c = 0; c < 4; ++c) { const int i = 4 * tid + c; if (i < n && (pass == 0 || (bits[c] >> (shift + 8)) == prefix)) __hip_atomic_fetch_add(&hist[(bits[c] >> shift) & 255u], 1, __ATOMIC_RELAXED, __HIP_MEMORY_SCOPE_WORKGROUP); }
            __syncthreads();
            if (wave == 0) {
                const int h0 = hist[4 * lane], h1 = hist[4 * lane + 1], h2 = hist[4 * lane + 2], h3 = hist[4 * lane + 3];
                const int tot = h0 + h1 + h2 + h3; int suf = tot;
#pragma unroll
                for (int o = 1; o < 64; o <<= 1) { const int t = __shfl_down(suf, o); if (lane + o < 64) suf += t; }
                const int above = suf - tot;
                if (above < krem && krem <= suf) {
                    int a = above, bin, cnt_above;
                    if (a + h3 >= krem) { bin = 3; cnt_above = a; } else { a += h3;
                        if (a + h2 >= krem) { bin = 2; cnt_above = a; } else { a += h2;
                            if (a + h1 >= krem) { bin = 1; cnt_above = a; } else { a += h1; bin = 0; cnt_above = a; } } }
                    misc[0] = 4 * lane + bin; misc[1] = cnt_above;
                }
            }
            __syncthreads();
            prefix = (prefix << 8) | (unsigned)misc[0]; krem -= misc[1];
            __syncthreads();
        }
        int neq = 0;
#pragma unroll
        for (int c = 0; c < 4; ++c) { const int i = 4 * tid + c; if (i < n && bits[c] == prefix) ++neq; }
        int tot_eq; int eqr = block_excl_scan(neq, stmp, lane, wave, tot_eq);
        bool sel[4]; int nsel = 0;
#pragma unroll
        for (int c = 0; c < 4; ++c) { const int i = 4 * tid + c; bool s2 = false; if (i < n) { if (bits[c] > prefix) s2 = true; else if (bits[c] == prefix) { s2 = eqr < krem; ++eqr; } } sel[c] = s2; nsel += s2 ? 1 : 0; }
        int tot_sel; int slot = block_excl_scan(nsel, stmp, lane, wave, tot_sel);
#pragma unroll
        for (int c = 0; c < 4; ++c) { const int i = 4 * tid + c; if (i < n) { int v = -1; if (sel[c]) { if (slot < cap) { list[slot] = i; v = slot0 + slot; } ++slot; } W_TSLOT(F)[(size_t)(base + i) * NE + e] = v; } }
        __syncthreads();
        for (int sl0 = wave; sl0 < cap; sl0 += 4 * NWAVES) {
            u32x4 cr[4][2]; float cs4[4]; int tk[4];
#pragma unroll
            for (int j = 0; j < 4; ++j) { tk[j] = list[sl0 + j * NWAVES]; const signed char* src = W_HQ(F) + (size_t)(base + tk[j]) * D; cr[j][0] = *(const u32x4*)(src + 16 * lane); cr[j][1] = *(const u32x4*)(src + 1024 + 16 * lane); cs4[j] = W_HS(F)[base + tk[j]]; }
#pragma unroll
            for (int j = 0; j < 4; ++j) { const int sl = sl0 + j * NWAVES; signed char* dst = W_XSQ(F) + ((size_t)e * ME + slot0 + sl) * D; *(u32x4*)(dst + 16 * lane) = cr[j][0]; *(u32x4*)(dst + 1024 + 16 * lane) = cr[j][1];
                if (lane == 0) W_XSS(F)[(size_t)e * ME + slot0 + sl] = cs4[j]; }
        }
        __syncthreads();
    }
}

__device__ __forceinline__ void p_actq(Frame& F, int l) {
    const int gw = F.vcu * NWAVES + F.wave, NGW = F.G * NWAVES, lane = F.lane, nrows = NE * ((l == 0) ? ME0 : ME1);
    for (int row = gw; row < nrows; row += 2 * NGW) {
        const int row2 = (row + NGW < nrows) ? row + NGW : row;
        float v[32], v2[32]; row_load_bf16_nt(W_ACT(F) + (size_t)row * FF, lane, v); row_load_bf16_nt(W_ACT(F) + (size_t)row2 * FF, lane, v2);
        const float t1 = W_TM(F)[(size_t)row * 64 + lane], t2 = W_TM(F)[(size_t)row2 * 64 + lane];
        const float am = wave_max(t1), am2 = wave_max(t2);
        const float scale = am > 0.f ? am * (1.0f / 127.0f) : 1.0f, scale2 = am2 > 0.f ? am2 * (1.0f / 127.0f) : 1.0f;
        row_store_i8(W_ACTQ(F) + (size_t)row * FF, lane, v, 1.0f / scale); row_store_i8(W_ACTQ(F) + (size_t)row2 * FF, lane, v2, 1.0f / scale2);
        if (lane == 0) { W_ACTS(F)[row] = scale; W_ACTS(F)[row2] = scale2; }
    }
}

__device__ __forceinline__ void prenorm_row_cvp(Frame& F, const u32x4 (&c4p)[4], const u32x4 (&c5p)[4], const float (&xv)[32], int row) {
    const float r = 1.0f / sqrtf(row_sumsq(xv) * (1.0f / D) + EPS);
    float hv[32];
#pragma unroll
    for (int j = 0; j < 4; ++j) { float c4[8], c5[8]; unpack8(c4p[j], c4); unpack8(c5p[j], c5);
#pragma unroll
        for (int e = 0; e < 8; ++e) hv[8 * j + e] = xv[8 * j + e] * r * c4[e] + c5[e]; }
    float am = 0.f;
#pragma unroll
    for (int i = 0; i < 32; ++i) am = fmaxf(am, fabsf(hv[i]));
    am = wave_max(am);
    const float scale = am > 0.f ? am * (1.0f / 127.0f) : 1.0f;
    row_store_i8(W_HQ(F) + (size_t)row * D, F.lane, hv, 1.0f / scale);
    if (F.lane == 0) W_HS(F)[row] = scale;
}
#define CMB_ACC(j) do { _Pragma("unroll") for (int q = 0; q < 4; ++q) { const u32x4 a = yr[j][q]; \
        acc[8 * q + 0] += gg[j] * bflo(a.x); acc[8 * q + 1] += gg[j] * bfhi(a.x); acc[8 * q + 2] += gg[j] * bflo(a.y); acc[8 * q + 3] += gg[j] * bfhi(a.y); \
        acc[8 * q + 4] += gg[j] * bflo(a.z); acc[8 * q + 5] += gg[j] * bfhi(a.z); acc[8 * q + 6] += gg[j] * bflo(a.w); acc[8 * q + 7] += gg[j] * bfhi(a.w); } } while (0)
#define CMB_FETCH() do { int ee[4]; ns = 0; \
        _Pragma("unroll") for (int j = 0; j < 4; ++j) { ee[j] = msk ? (int)__builtin_ctzll(msk) : 0; if (msk) { ++ns; msk &= msk - 1; } } \
        _Pragma("unroll") for (int j = 0; j < 4; ++j) if (j < ns) { \
            const int slot = __builtin_amdgcn_readlane(sl_c, ee[j]); gg[j] = __builtin_bit_cast(float, __builtin_amdgcn_readlane(__builtin_bit_cast(int, gt_c), ee[j])); \
            const bf16* yp = W_XS(F) + ((size_t)ee[j] * ME + slot) * D + 8 * lane; \
            _Pragma("unroll") for (int q = 0; q < 4; ++q) yr[j][q] = __builtin_nontemporal_load((const u32x4*)(yp + 512 * q)); } } while (0)
#define CMB_PREFETCH(rw, en) do { sl_c = ((lane < NE) && (en)) ? sl_n : -1; gt_c = gt_n; msk = __ballot(sl_c >= 0); CMB_FETCH(); \
        { const bf16* xb = W_XB(F) + (size_t)(rw) * D + 8 * lane; _Pragma("unroll") for (int q = 0; q < 4; ++q) xbp[q] = __builtin_nontemporal_load((const u32x4*)(xb + 512 * q)); } \
        { const int rn = ((rw) + NGW < r1) ? (rw) + NGW : (rw); sl_n = W_TSLOT(F)[(size_t)rn * NE + (lane & 15)]; gt_n = W_AFF(F)[(size_t)rn * NE + (lane & 15)]; } } while (0)
__device__ __forceinline__ void p_combine(Frame& F, int l, bool dry) {
    const int gw = F.vcu * NWAVES + F.wave, NGW = F.G * NWAVES, nrows = (l == 0) ? NROW : NLAT, ME = (l == 0) ? ME0 : ME1;
    const int r0 = gw, r1 = nrows;
    if (r0 >= r1) return;
    int lane = F.lane;
    int sl_n = W_TSLOT(F)[(size_t)r0 * NE + (lane & 15)]; float gt_n = W_AFF(F)[(size_t)r0 * NE + (lane & 15)];
    int sl_c; float gt_c; unsigned long long msk; int ns;
    u32x4 yr[4][4], xbp[4]; float gg[4];
    CMB_PREFETCH(r0, true);
    for (int row = r0; row < r1; row += NGW) {
        launder(F); lane = F.lane;
        const int m = row < NLAT ? row / SEQ : 8;
        u32x4 c3p[4], c4p[4], c5p[4];
        { const bf16* cv3 = W_CV(F) + (((size_t)l * 9 + m) * 6 + 3) * D + 8 * lane;
#pragma unroll
          for (int q = 0; q < 4; ++q) c3p[q] = *(const u32x4*)(cv3 + 512 * q); }
        if (l + 1 < DEPTH) { const bf16* cvn = W_CV(F) + (((size_t)(l + 1) * 9 + m) * 6 + 4) * D + 8 * lane;
#pragma unroll
            for (int q = 0; q < 4; ++q) { c4p[q] = *(const u32x4*)(cvn + 512 * q); c5p[q] = *(const u32x4*)(cvn + D + 512 * q); } }
        float acc[32];
#pragma unroll
        for (int i = 0; i < 32; ++i) acc[i] = 0.f;
#pragma unroll
        for (int j = 0; j < 4; ++j) if (j < ns) CMB_ACC(j);
        while (msk) {
            CMB_FETCH();
#pragma unroll
            for (int j = 0; j < 4; ++j) if (j < ns) CMB_ACC(j);
        }
        float xv[32];
#pragma unroll
        for (int q = 0; q < 4; ++q) unpack8(xbp[q], &xv[8 * q]);
#pragma unroll
        for (int q = 0; q < 4; ++q) { asm volatile("" : "+v"(c3p[q])); if (l + 1 < DEPTH) { asm volatile("" : "+v"(c4p[q])); asm volatile("" : "+v"(c5p[q])); } }
        asm volatile("" ::: "memory");
        { const bool more = row + NGW < r1; const int rnx = more ? row + NGW : row; CMB_PREFETCH(rnx, more); }
        const float rn1 = 1.0f / sqrtf(row_sumsq(acc) * (1.0f / D) + EPS);
#pragma unroll
        for (int q = 0; q < 4; ++q) { float c8[8]; unpack8(c3p[q], c8);
#pragma unroll
            for (int e = 0; e < 8; ++e) xv[8 * q + e] = xv[8 * q + e] + c8[e] * (acc[8 * q + e] * rn1); }
        if (l + 1 < DEPTH) row_store_bf16(dry ? (bf16*)(F.ws + WS_DUMMY) + (size_t)row * D : W_XB(F) + (size_t)row * D, lane, xv);
        else row_store_f32(dry ? (float*)(F.ws + WS_DUMMY) + (size_t)(row & 8191) * D : F.out + (size_t)row * D, lane, xv);
        if (l + 1 < DEPTH) prenorm_row_cvp(F, c4p, c5p, xv, row);
    }
}
#undef CMB_ACC
#undef CMB_FETCH
#undef CMB_PREFETCH
struct Args { const float* in[24]; float* out; unsigned char* ws; int ph_lo, ph_hi; };
constexpr int NPHASE = 2 + 11 * DEPTH;
__global__ void __launch_bounds__(NTHR, 2) mk_fwd(Args args) {
    extern __shared__ __attribute__((aligned(16))) unsigned char lds_raw[];
    Frame F;
    F.lds = (LAS unsigned char*)lds_raw;
    F.tid = threadIdx.x; F.lane = F.tid & 63; F.wave = __builtin_amdgcn_readfirstlane(F.tid >> 6);
    F.G = gridDim.x; { const int bx = blockIdx.x; F.vcu = (F.G % 8 == 0) ? (bx % 8) * (F.G / 8) + bx / 8 : bx; }
    F.x = args.in[0]; F.c = args.in[1]; F.ctx = args.in[2]; F.c_ctx = args.in[3]; F.w_ada = args.in[4]; F.b_ada = args.in[5]; F.g_pre_mix = args.in[6]; F.g_post_mix = args.in[7];
    F.g_pre_ffn = args.in[8]; F.g_post_ffn = args.in[9]; F.w_in = args.in[10]; F.w_dec = args.in[11]; F.b_dec = args.in[12]; F.rpb = args.in[13]; F.g_gla = args.in[14]; F.ln_v_g = args.in[15];
    F.ln_v_b = args.in[16]; F.w_sp = args.in[17]; F.b_sp = args.in[18]; F.w_out = args.in[19]; F.w_router = args.in[20]; F.w_gate = args.in[21]; F.w_up = args.in[22]; F.w_down = args.in[23];
    F.out = args.out;
    unsigned char* ws = args.ws;
    F.ws = ws;

    const int lo = args.ph_lo, hi = args.ph_hi;
    unsigned* ctl = (unsigned*)(ws + WS_CTL);
    if (F.tid < 16) ((LAS unsigned*)(F.lds + LDS_XB))[F.tid] = 0u;
    __syncthreads();
    XcdBarrier bar; bar.bar = (unsigned*)(ws + WS_CTL) + CW_BAR; bar.x = 0; bar.st = nullptr;
    if (hi - lo > 1) bar = xcd_barrier_post((unsigned*)(ws + WS_CTL) + CW_BAR, (volatile LAS unsigned*)(F.lds + LDS_XB));
#ifndef MK_MASK
#define MK_MASK 0xFFFFFFFFu
#endif
#define PH(b) ((MK_MASK >> (b)) & 1u)
#ifndef MK_REP
#define MK_REP 0u
#endif
#define NREP(b) (1 + (int)((MK_REP >> (b)) & 1u))
#define REPBAR(b, rep) do { if ((rep) + 1 < NREP(b)) xcd_barrier(bar); } while (0)
#define IN(k) (lo <= (k) && (k) < hi)
#define SEAM(k) do { if (IN(k) && IN((k) + 1)) xcd_barrier(bar); } while (0)

    if (PH(0) && IN(0)) { for (int rep = 0; rep < NREP(0); ++rep) { launder(F); p0a(F); REPBAR(0, rep); } } SEAM(0);
    if (PH(1) && IN(1)) { for (int rep = 0; rep < NREP(1); ++rep) { launder(F); p0b(F); REPBAR(1, rep); } } SEAM(1);
    for (int l = 0; l < DEPTH; ++l) {
        const int pb = 2 + 11 * l;
        if (PH(2) && IN(pb + 0)) {
          for (int rep = 0; rep < NREP(2); ++rep) {
            launder(F);
            pg8::Gemm g{(const pg8::bf16_t*)W_HQ(F), (const pg8::bf16_t*)(F.ws + WS_WIN + (size_t)l * NU * D), NROW, NU, D / 2};
            constexpr int GG = 237;
            unsigned* sig = ctl + CW_SIG + 64 * (pb + 0);
            if ((int)blockIdx.x < GG || F.G != 256) {
                pg8::GroupedOrder S; S.init(1, NROW / 256, NU / 256, F.G == 256 ? GG : F.G, (int)blockIdx.x, sig);
                pg8::EpiStoreI8 E{W_U(F), NU, NU / 256, W_HS(F), W_SIN(F) + (size_t)l * NU};
                pg8::gemm_phase<pg8::EpiStoreI8, pg8::GroupedOrder, true, true>(F.lds, g, S, E, F.tid);
            } else bg_loop(F, ctl, sig, BG_TOTAL);
            REPBAR(2, rep); }
        } SEAM(pb + 0);
        if (PH(3) && IN(pb + 1)) { for (int rep = 0; rep < NREP(3); ++rep) { launder(F); p_mixers(F, l); REPBAR(3, rep); } } SEAM(pb + 1);
        if (PH(11) && IN(pb + 2)) { for (int rep = 0; rep < NREP(11); ++rep) { launder(F); p_chains(F, l); REPBAR(11, rep); } } SEAM(pb + 2);
        if (PH(4) && IN(pb + 3)) { for (int rep = 0; rep < NREP(4); ++rep) { launder(F); p_glaout(F, l); REPBAR(4, rep); } } SEAM(pb + 3);
        if (PH(5) && IN(pb + 4)) {
          for (int rep = 0; rep < NREP(5); ++rep) {
            launder(F);
            const int M = (l == 0) ? NROW : NLAT;
            pg8::Gemm g{W_MIX(F), W_WOUT(F) + (size_t)l * D * D, M, D, D};
            const int GG = (l == 0) ? 192 : 256;
            unsigned* sig = ctl + CW_SIG + 64 * (pb + 4);
            if ((int)blockIdx.x < GG || F.G != 256) {
                pg8::GroupedOrder S; S.init(1, M / 256, D / 256, F.G == 256 ? GG : F.G, (int)blockIdx.x, sig);
                pg8::EpiStore E{W_Y(F), D, D / 256};
                pg8::gemm_phase<pg8::EpiStore, pg8::GroupedOrder, true, true>(F.lds, g, S, E, F.tid);
            } else bg_loop(F, ctl, sig, BG_TOTAL);
            REPBAR(5, rep); }
        } SEAM(pb + 4);
        if (PH(6) && IN(pb + 5)) { if (MK_REPMIX & 16u) { launder(F); p_postmix(F, l, true); xcd_barrier(bar); } launder(F); p_postmix(F, l, false); } SEAM(pb + 5);
        if (PH(7) && IN(pb + 6)) { for (int rep = 0; rep < NREP(7); ++rep) { launder(F); p_topk(F, l); launder(F); bg_loop(F, ctl, nullptr, l == 0 ? BG_A : BG_TOTAL); REPBAR(7, rep); } } SEAM(pb + 6);
        if (PH(8) && IN(pb + 7)) {
          for (int rep = 0; rep < NREP(8); ++rep) {
            launder(F);
            const int ME = (l == 0) ? ME0 : ME1;
            pg8::Gemm g{(const pg8::bf16_t*)W_XSQ(F), (const pg8::bf16_t*)((F).ws + WS_W1 + (size_t)l * NE * (2 * FF) * D), NE * ME, NE * 2 * FF, D / 2};
            pg8::GroupedOrder S; S.init(NE, ME / 256, 2 * FF / 256, F.G, (int)blockIdx.x);
            pg8::EpiSwiGLUI8 E{W_ACT(F), FF, 2 * FF / 256, W_XSS(F), W_S1(F) + (size_t)l * NE * (2 * FF), W_TM(F)};
            pg8::gemm_phase<pg8::EpiSwiGLUI8, pg8::GroupedOrder, true, true>(F.lds, g, S, E, F.tid); REPBAR(8, rep); }
        } SEAM(pb + 7);
        if (PH(12) && IN(pb + 8)) { launder(F); p_actq(F, l); } SEAM(pb + 8);
        if (PH(9) && IN(pb + 9)) {
          for (int rep = 0; rep < NREP(9); ++rep) {
            launder(F);
            const int ME = (l == 0) ? ME0 : ME1;
            pg8::Gemm g{(const pg8::bf16_t*)W_ACTQ(F), (const pg8::bf16_t*)((F).ws + WS_W2 + (size_t)l * NE * D * FF), NE * ME, NE * D, FF / 2};
            const int GG = (l == 0) ? 231 : 256;
            unsigned* sig = ctl + CW_SIG + 64 * (pb + 9);
            if ((int)blockIdx.x < GG || F.G != 256) {
                pg8::GroupedOrder S; S.init(NE, ME / 256, D / 256, F.G == 256 ? GG : F.G, (int)blockIdx.x, sig);
                pg8::EpiStoreI8 E{W_XS(F), D, D / 256, W_ACTS(F), W_S2(F) + (size_t)l * NE * D};
                pg8::gemm_phase<pg8::EpiStoreI8, pg8::GroupedOrder, true, true>(F.lds, g, S, E, F.tid);
            } else bg_loop(F, ctl, sig, BG_TOTAL);
            REPBAR(9, rep); }
        } SEAM(pb + 9);
        if (PH(10) && IN(pb + 10)) { if (MK_REPMIX & 32u) { launder(F); p_combine(F, l, true); xcd_barrier(bar); } launder(F); p_combine(F, l, false); if (l == 0) { launder(F); bg_loop(F, ctl, nullptr, BG_B); } } SEAM(pb + 10);
    }
#undef IN
#undef SEAM
}

extern "C" void kernel_launch(void* const* d_in, const int* in_sizes, int n_in, void* d_out, int out_size, void* d_ws, size_t ws_size, hipStream_t stream) {
    static int grid = 0;
    if (grid == 0) {
        if (n_in != 24 || out_size != NLAT * D || ws_size < WS_END2) { fprintf(stderr, "kernel_launch: unexpected shapes (n_in %d out %d ws %zu)\n", n_in, out_size, ws_size); grid = -1; return; }
        int dev = 0, cus = 0, per_cu = 0;
        if (hipGetDevice(&dev) != hipSuccess || hipDeviceGetAttribute(&cus, hipDeviceAttributeMultiprocessorCount, dev) != hipSuccess) { grid = -1; return; }
        if (hipFuncSetAttribute((const void*)mk_fwd, hipFuncAttributeMaxDynamicSharedMemorySize, LDS_BYTES) != hipSuccess) { fprintf(stderr, "kernel_launch: hipFuncSetAttribute failed\n"); grid = -1; return; }
        if (hipOccupancyMaxActiveBlocksPerMultiprocessor(&per_cu, (const void*)mk_fwd, NTHR, LDS_BYTES) != hipSuccess || per_cu < 1) { fprintf(stderr, "kernel_launch: occupancy query says %d\n", per_cu); }
        (void)hipGetLastError();
        grid = cus;
    }
    if (grid < 0) return;
    if (hipMemsetAsync((char*)d_ws + WS_CTL, 0, CTL_ZERO_BYTES, stream) != hipSuccess) return;
    Args a{};
    for (int i = 0; i < 24; ++i) a.in[i] = (const float*)d_in[i];
    a.out = (float*)d_out; a.ws = (unsigned char*)d_ws;
#if MK_N_LAUNCHES == 1
    a.ph_lo = 0; a.ph_hi = NPHASE;
    hipLaunchKernelGGL(mk_fwd, dim3(grid), dim3(NTHR), LDS_BYTES, stream, a);
#else
    for (int p = 0; p < NPHASE; ++p) { a.ph_lo = p; a.ph_hi = p + 1; hipLaunchKernelGGL(mk_fwd, dim3(grid), dim3(NTHR), LDS_BYTES, stream, a); }
#endif
}
```

```cpp
#include <hip/hip_runtime.h>
#include <cstdio>
#include <cstdint>

#ifndef MK_N_LAUNCHES
#define MK_N_LAUNCHES 1
#endif

namespace pg8 {
#define PG8_LAS __attribute__((address_space(3)))
typedef unsigned short bf16_t;
typedef short bf16x8 __attribute__((ext_vector_type(8)));
typedef float f32x4 __attribute__((ext_vector_type(4)));
typedef unsigned u32x4 __attribute__((ext_vector_type(4)));
constexpr int BM = 256, BK = 64, HALF = 128, HTB = HALF * BK * 2  , STAGE_BYTES = 8 * HTB, NXCD = 8, WGM = 8;

__host__ __device__ __forceinline__ int lds_byte(int r, int c) { const int st = (r >> 4) * 2 + (c >> 5), rr = r & 15, cc = c & 31, ob = rr * 64 + cc * 2; return st * 1024 + (ob ^ (((ob >> 9) & 1) << 5)); }
__host__ __device__ __forceinline__ void stage_rc(int b, int& R, int& C) { const int st = b / 1024, sb = b % 1024, swz = sb ^ (((sb >> 9) & 1) << 5); R = (st >> 1) * 16 + swz / 64; C = (st & 1) * 32 + (swz % 64) / 2; }
__host__ __device__ __forceinline__ int perm32(int rho) { const int n = rho >> 4, i = rho & 15; return 8 * (i >> 2) + 4 * n + (i & 3); }

struct Unit { int pm, pn, last; };
struct Gemm { const bf16_t* A; const bf16_t* Bt; int M, N, K; };

typedef __bf16 hwbf16x2_t __attribute__((ext_vector_type(2))); typedef float f32x2_cv __attribute__((ext_vector_type(2)));
__device__ __forceinline__ unsigned cvt_pk_bf16(float lo, float hi) { const f32x2_cv v = {lo, hi}; const hwbf16x2_t b = __builtin_convertvector(v, hwbf16x2_t); return __builtin_bit_cast(unsigned, b); }
typedef float f32x2 __attribute__((ext_vector_type(2)));
typedef int i32x4 __attribute__((ext_vector_type(4)));
__device__ __forceinline__ f32x4 mma16(bf16x8 a, bf16x8 b, f32x4 c) { return __builtin_amdgcn_mfma_f32_16x16x32_bf16(a, b, c, 0, 0, 0); }
__device__ __forceinline__ i32x4 mma16(bf16x8 a, bf16x8 b, i32x4 c) { return __builtin_amdgcn_mfma_i32_16x16x64_i8(__builtin_bit_cast(i32x4, a), __builtin_bit_cast(i32x4, b), c, 0, 0, 0); }
__device__ __forceinline__ void tile_of(int wgid, int nM, int nN, int& pm, int& pn) {
    const int nwg = nM * nN;
    { const int q = nwg / NXCD, r = nwg % NXCD, xcd = wgid % NXCD, off = wgid / NXCD; wgid = (xcd < r ? xcd * (q + 1) : r * (q + 1) + (xcd - r) * q) + off; }
    const int nig = WGM * nN, gid = wgid / nig, fm = gid * WGM, gsz = (nM - fm) < WGM ? (nM - fm) : WGM;
    pm = fm + ((wgid % nig) % gsz); pn = (wgid % nig) / gsz;
}
struct GroupedOrder {
    int mM, mN, per, total, G, c; unsigned* sig;
    __device__ __forceinline__ void init(int E, int mM_, int mN_, int G_, int c_, unsigned* sig_ = nullptr) { mM = mM_; mN = mN_; per = mM * mN; total = E * per; G = G_; c = c_; sig = sig_; }
    __device__ __forceinline__ bool next(int i, Unit& u) const {
        const long L = (long)i * G + c; if (L >= total) return false;
        const int e = (int)(L / per), l = (int)(L % per); int pm, pn; tile_of(l, mM, mN, pm, pn);
        u.pm = e * mM + pm; u.pn = e * mN + pn; u.last = (i == (total + G - 1) / G - 1) ? 1 : 0; return true;
    }
    __device__ __forceinline__ void a_ready(const Unit& u) const { if (sig && u.last && threadIdx.x == 0) __hip_atomic_store(sig, 1u, __ATOMIC_RELAXED, __HIP_MEMORY_SCOPE_AGENT); }
    __device__ __forceinline__ void done(const Unit&) const {}
};
__device__ __forceinline__ float xmax16(float v) { const auto r = __builtin_amdgcn_permlane16_swap(__builtin_bit_cast(unsigned, v), __builtin_bit_cast(unsigned, v), false, false); return fmaxf(__builtin_bit_cast(float, r[0]), __builtin_bit_cast(float, r[1])); }
__device__ __forceinline__ float xmax32(float v) { const auto r = __builtin_amdgcn_permlane32_swap(__builtin_bit_cast(unsigned, v), __builtin_bit_cast(unsigned, v), false, false); return fmaxf(__builtin_bit_cast(float, r[0]), __builtin_bit_cast(float, r[1])); }
__device__ __forceinline__ float xsum16(float v) { const auto r = __builtin_amdgcn_permlane16_swap(__builtin_bit_cast(unsigned, v), __builtin_bit_cast(unsigned, v), false, false); return __builtin_bit_cast(float, r[0]) + __builtin_bit_cast(float, r[1]); }
__device__ __forceinline__ float xsum32(float v) { const auto r = __builtin_amdgcn_permlane32_swap(__builtin_bit_cast(unsigned, v), __builtin_bit_cast(unsigned, v), false, false); return __builtin_bit_cast(float, r[0]) + __builtin_bit_cast(float, r[1]); }
__device__ __forceinline__ float silu_f(float x) { return x * __builtin_amdgcn_rcpf(1.0f + __expf(-x)); }
struct EpiStore {
    static constexpr bool PERM = true, AFTER_DRAIN = false; typedef f32x4 acc_t;
    bf16_t* O; int ldc; int nN;
    __device__ __forceinline__ void operator()(const f32x4 (&acc)[2][2][4][2], const Unit& u, int wr, int wc, int fr, int fq) const {
        const int row0 = u.pm * BM + wr * 64 + fr, col0 = (u.pn % nN) * BM + wc * 32 + 8 * fq;
#pragma unroll
        for (int ai = 0; ai < 2; ++ai)
#pragma unroll
            for (int m = 0; m < 4; ++m) { bf16_t* rowp = O + (size_t)(row0 + ai * HALF + m * 16) * ldc + col0;
#pragma unroll
                for (int bj = 0; bj < 2; ++bj) { const f32x4 v0 = acc[ai][bj][m][0], v1 = acc[ai][bj][m][1];
                    u32x4 w; w.x = cvt_pk_bf16(v0[0], v0[1]); w.y = cvt_pk_bf16(v0[2], v0[3]); w.z = cvt_pk_bf16(v1[0], v1[1]); w.w = cvt_pk_bf16(v1[2], v1[3]);
                    *(u32x4*)(rowp + bj * HALF) = w; } }
    }
};
struct EpiSwiGLU {
    static constexpr bool PERM = true, AFTER_DRAIN = false; typedef f32x4 acc_t;
    bf16_t* O; int ldc; int nN;
    __device__ __forceinline__ void operator()(const f32x4 (&acc)[2][2][4][2], const Unit& u, int wr, int wc, int fr, int fq) const {
        const int row0 = u.pm * BM + wr * 64 + fr, col0 = (u.pn % nN) * HALF + wc * 32 + 8 * fq;
#pragma unroll
        for (int ai = 0; ai < 2; ++ai)
#pragma unroll
            for (int m = 0; m < 4; ++m) { bf16_t* rowp = O + (size_t)(row0 + ai * HALF + m * 16) * ldc + col0;
                f32x4 a0 = acc[ai][0][m][0], a1 = acc[ai][0][m][1]; const f32x4 b0 = acc[ai][1][m][0], b1 = acc[ai][1][m][1];
#pragma unroll
                for (int j = 0; j < 4; ++j) { a0[j] = silu_f(a0[j]) * b0[j]; a1[j] = silu_f(a1[j]) * b1[j]; }
                u32x4 w; w.x = cvt_pk_bf16(a0[0], a0[1]); w.y = cvt_pk_bf16(a0[2], a0[3]); w.z = cvt_pk_bf16(a1[0], a1[1]); w.w = cvt_pk_bf16(a1[2], a1[3]);
                *(u32x4*)rowp = w; }
    }
};
struct EpiStoreI8 {
    static constexpr bool PERM = true, AFTER_DRAIN = false; typedef i32x4 acc_t;
    bf16_t* O; int ldc; int nN; const float* sa; const float* sb;
    __device__ __forceinline__ void operator()(const i32x4 (&acc)[2][2][4][2], const Unit& u, int wr, int wc, int fr, int fq) const {
        const int row0 = u.pm * BM + wr * 64 + fr, col0 = (u.pn % nN) * BM + wc * 32 + 8 * fq; const float* sbp = sb + (size_t)u.pn * BM + wc * 32 + 8 * fq;
        f32x4 bs[2][2];
#pragma unroll
        for (int bj = 0; bj < 2; ++bj) { bs[bj][0] = *(const f32x4*)(sbp + bj * HALF); bs[bj][1] = *(const f32x4*)(sbp + bj * HALF + 4); }
#pragma unroll
        for (int ai = 0; ai < 2; ++ai)
#pragma unroll
            for (int m = 0; m < 4; ++m) { const int row = row0 + ai * HALF + m * 16; const float as = sa[row]; bf16_t* rowp = O + (size_t)row * ldc + col0;
#pragma unroll
                for (int bj = 0; bj < 2; ++bj) { const i32x4 i0 = acc[ai][bj][m][0], i1 = acc[ai][bj][m][1]; f32x4 v0, v1;
#pragma unroll
                    for (int j = 0; j < 4; ++j) { v0[j] = (float)i0[j] * as * bs[bj][0][j]; v1[j] = (float)i1[j] * as * bs[bj][1][j]; }
                    u32x4 w; w.x = cvt_pk_bf16(v0[0], v0[1]); w.y = cvt_pk_bf16(v0[2], v0[3]); w.z = cvt_pk_bf16(v1[0], v1[1]); w.w = cvt_pk_bf16(v1[2], v1[3]);
                    *(u32x4*)(rowp + bj * HALF) = w; } }
    }
};
struct EpiSwiGLUI8 {
    static constexpr bool PERM = true, AFTER_DRAIN = false; typedef i32x4 acc_t;
    bf16_t* O; int ldc; int nN; const float* sa; const float* sb; float* TM;
    __device__ __forceinline__ void operator()(const i32x4 (&acc)[2][2][4][2], const Unit& u, int wr, int wc, int fr, int fq) const {
        const int pnl = u.pn % nN, row0 = u.pm * BM + wr * 64 + fr, col0 = pnl * HALF + wc * 32 + 8 * fq; const float* sbp = sb + (size_t)u.pn * BM + wc * 32 + 8 * fq;
        f32x4 bs[2][2];
#pragma unroll
        for (int bj = 0; bj < 2; ++bj) { bs[bj][0] = *(const f32x4*)(sbp + bj * HALF); bs[bj][1] = *(const f32x4*)(sbp + bj * HALF + 4); }
#pragma unroll
        for (int ai = 0; ai < 2; ++ai)
#pragma unroll
            for (int m = 0; m < 4; ++m) { const int row = row0 + ai * HALF + m * 16; const float as = sa[row]; bf16_t* rowp = O + (size_t)row * ldc + col0;
                const i32x4 g0 = acc[ai][0][m][0], g1 = acc[ai][0][m][1], u0 = acc[ai][1][m][0], u1 = acc[ai][1][m][1]; f32x4 a0, a1; float mx = 0.f;
#pragma unroll
                for (int j = 0; j < 4; ++j) { a0[j] = silu_f((float)g0[j] * as * bs[0][0][j]) * ((float)u0[j] * as * bs[1][0][j]); a1[j] = silu_f((float)g1[j] * as * bs[0][1][j]) * ((float)u1[j] * as * bs[1][1][j]);
                    mx = fmaxf(mx, fmaxf(fabsf(a0[j]), fabsf(a1[j]))); }
                u32x4 w; w.x = cvt_pk_bf16(a0[0], a0[1]); w.y = cvt_pk_bf16(a0[2], a0[3]); w.z = cvt_pk_bf16(a1[0], a1[1]); w.w = cvt_pk_bf16(a1[2], a1[3]);
                *(u32x4*)rowp = w;
                mx = fmaxf(mx, __shfl_xor(mx, 16)); mx = fmaxf(mx, __shfl_xor(mx, 32));
                if (fq == 0) TM[(size_t)row * 64 + pnl * 4 + wc] = mx; }
    }
};
template <class Epi, class Sched, bool ALIGN_EPI = false, bool SP2 = false>
__device__ __forceinline__ void gemm_phase(PG8_LAS unsigned char* lds, const Gemm g, const Sched& S, const Epi& E, int tid_in) {
    int tid_l = tid_in; asm volatile("" : "+v"(tid_l)); const int tid = tid_l, wid = __builtin_amdgcn_readfirstlane(tid >> 6), lane = tid & 63, wr = wid >> 2, wc = wid & 3, fr = lane & 15, fq = lane >> 4;
    const int K = g.K, nt = K / BK;
    unsigned voffA[2], voffB[2];
#pragma unroll
    for (int i = 0; i < 2; ++i) { int R, C; stage_rc(tid * 16 + i * 8192, R, C); const int Rb = Epi::PERM ? ((R & ~31) + perm32(R & 31)) : R;
        voffA[i] = (unsigned)(R * K + C) * 2u; voffB[i] = (unsigned)(Rb * K + C) * 2u; }
    const size_t kstep = (size_t)(BK * 2);
    const size_t hstep = (size_t)HALF * K * 2;
    const size_t tstep = 2 * hstep;
    const unsigned ldsw = (unsigned)wid * 1024u;
    const int aoff = lds_byte(wr * 64 + fr, fq * 8), boff = lds_byte(wc * 32 + fr, fq * 8);
#define PG8_SA(b, h) (((b) * 2 + (h)) * HTB)
#define PG8_SB(b, h) ((4 + (b) * 2 + (h)) * HTB)
#define PG8_STAGE(bufoff, gbase, voff) do { _Pragma("unroll") for (int _i = 0; _i < 2; ++_i) \
        __builtin_amdgcn_global_load_lds((const unsigned*)((const char*)(gbase) + (voff)[_i]), (PG8_LAS unsigned*)(lds + (bufoff) + ldsw + _i * 8192), 16, 0, 0); } while (0)
#define PG8_LDA(dst, b, h) do { _Pragma("unroll") for (int m = 0; m < 4; ++m) _Pragma("unroll") for (int k = 0; k < 2; ++k) dst[m][k] = *(const PG8_LAS bf16x8*)(lds + PG8_SA(b, h) + aoff + m * 2048 + k * 1024); } while (0)
#define PG8_LDB(dst, b, h) do { _Pragma("unroll") for (int n = 0; n < 2; ++n) _Pragma("unroll") for (int k = 0; k < 2; ++k) dst[n][k] = *(const PG8_LAS bf16x8*)(lds + PG8_SB(b, h) + boff + n * 2048 + k * 1024); } while (0)
#define PG8_MMA(ai, bj, At, Bt) do { __builtin_amdgcn_s_setprio(1); _Pragma("unroll") for (int m = 0; m < 4; ++m) _Pragma("unroll") for (int n = 0; n < 2; ++n) _Pragma("unroll") for (int k = 0; k < 2; ++k) \
        acc[ai][bj][m][n] = mma16(Bt[n][k], At[m][k], acc[ai][bj][m][n]); __builtin_amdgcn_s_setprio(0); } while (0)
#define PG8_WAIT_V(n) asm volatile("s_waitcnt vmcnt(" #n ")" ::: "memory")
#define PG8_WAIT_L(n) asm volatile("s_waitcnt lgkmcnt(" #n ")" ::: "memory")
#define PG8_BAR __builtin_amdgcn_s_barrier()
#define PG8_SCHED __builtin_amdgcn_sched_barrier(0)
    Unit cur, nxt; int ui = 0;
    if (!S.next(0, cur)) return;
    typename Epi::acc_t acc[2][2][4][2];
#pragma unroll
    for (int a = 0; a < 2; ++a)
#pragma unroll
        for (int b = 0; b < 2; ++b)
#pragma unroll
            for (int m = 0; m < 4; ++m)
#pragma unroll
                for (int n = 0; n < 2; ++n) acc[a][b][m][n] = (typename Epi::acc_t){0, 0, 0, 0};
    bf16x8 At[4][2], B0[2][2], B1[2][2];
    const char* cA = (const char*)g.A + (size_t)cur.pm * tstep; const char* cB = (const char*)g.Bt + (size_t)cur.pn * tstep;
    S.a_ready(cur);
    if constexpr (SP2) {
        PG8_STAGE(PG8_SB(0, 0), cB, voffB); PG8_STAGE(PG8_SB(0, 1), cB + hstep, voffB); PG8_STAGE(PG8_SA(0, 0), cA, voffA); PG8_STAGE(PG8_SA(0, 1), cA + hstep, voffA);
        if (wr == 1) PG8_BAR;
        PG8_WAIT_V(2); PG8_BAR;
        PG8_STAGE(PG8_SB(1, 0), cB + kstep, voffB); PG8_STAGE(PG8_SA(1, 0), cA + kstep, voffA); PG8_STAGE(PG8_SB(1, 1), cB + hstep + kstep, voffB);
        PG8_WAIT_V(6); PG8_BAR;
    } else {
        PG8_STAGE(PG8_SB(0, 0), cB, voffB); PG8_STAGE(PG8_SA(0, 0), cA, voffA); PG8_STAGE(PG8_SB(0, 1), cB + hstep, voffB); PG8_STAGE(PG8_SA(0, 1), cA + hstep, voffA);
        if (wr == 1) PG8_BAR;
        PG8_WAIT_V(4); PG8_BAR;
        PG8_STAGE(PG8_SB(1, 0), cB + kstep, voffB); PG8_STAGE(PG8_SA(1, 0), cA + kstep, voffA); PG8_STAGE(PG8_SB(1, 1), cB + hstep + kstep, voffB);
        PG8_WAIT_V(6); PG8_BAR;
    }
    for (;;) {
        const bool has_next = S.next(ui + 1, nxt);
        const char* nA = has_next ? (const char*)g.A + (size_t)nxt.pm * tstep : cA; const char* nB = has_next ? (const char*)g.Bt + (size_t)nxt.pn * tstep : cB;
        for (int t = 0; t < nt; t += 2) {
            const bool last = (t == nt - 2);
            const char* a1 = cA + (size_t)(t + 1) * kstep;
            const char* a2 = last ? nA : cA + (size_t)(t + 2) * kstep; const char* b2 = last ? nB : cB + (size_t)(t + 2) * kstep;
            const char* a3 = a2 + kstep; const char* b3 = b2 + kstep;
            if (last && has_next) S.a_ready(nxt);
            if constexpr (SP2) {
            PG8_LDB(B0, 0, 0); PG8_LDB(B1, 0, 1); PG8_SCHED; PG8_LDA(At, 0, 0); PG8_STAGE(PG8_SA(1, 1), a1 + hstep, voffA);
            PG8_WAIT_V(8); PG8_WAIT_L(0); PG8_BAR; PG8_MMA(0, 0, At, B0); PG8_MMA(0, 1, At, B1); PG8_BAR; PG8_SCHED;
            PG8_LDA(At, 0, 1); PG8_STAGE(PG8_SB(0, 0), b2, voffB); PG8_STAGE(PG8_SB(0, 1), b2 + hstep, voffB); PG8_STAGE(PG8_SA(0, 0), a2, voffA);
            PG8_WAIT_V(8); PG8_WAIT_L(0); PG8_BAR; PG8_MMA(1, 0, At, B0); PG8_MMA(1, 1, At, B1); PG8_BAR; PG8_SCHED;
            PG8_LDB(B0, 1, 0); PG8_LDB(B1, 1, 1); PG8_SCHED; PG8_LDA(At, 1, 0); PG8_STAGE(PG8_SA(0, 1), a2 + hstep, voffA);
            PG8_WAIT_V(8); PG8_WAIT_L(0); PG8_BAR; PG8_MMA(0, 0, At, B0); PG8_MMA(0, 1, At, B1); PG8_BAR; PG8_SCHED;
            PG8_LDA(At, 1, 1); PG8_STAGE(PG8_SB(1, 0), b3, voffB); PG8_STAGE(PG8_SB(1, 1), b3 + hstep, voffB); PG8_STAGE(PG8_SA(1, 0), a3, voffA);
            PG8_WAIT_V(8); PG8_WAIT_L(0); PG8_BAR; PG8_MMA(1, 0, At, B0); PG8_MMA(1, 1, At, B1); PG8_BAR; PG8_SCHED;
            } else {
            PG8_LDB(B0, 0, 0); PG8_SCHED; PG8_LDA(At, 0, 0); PG8_STAGE(PG8_SA(1, 1), a1 + hstep, voffA);
            PG8_WAIT_L(8); PG8_BAR; PG8_WAIT_L(0); PG8_MMA(0, 0, At, B0); PG8_BAR; PG8_SCHED;
            PG8_LDB(B1, 0, 1); PG8_STAGE(PG8_SB(0, 0), b2, voffB);
            PG8_BAR; PG8_WAIT_L(0); PG8_MMA(0, 1, At, B1); PG8_BAR;
            PG8_LDA(At, 0, 1); PG8_STAGE(PG8_SA(0, 0), a2, voffA);
            PG8_BAR; PG8_WAIT_L(0); PG8_MMA(1, 0, At, B0); PG8_BAR; PG8_SCHED;
            PG8_STAGE(PG8_SB(0, 1), b2 + hstep, voffB);
            PG8_WAIT_V(6); PG8_BAR; PG8_MMA(1, 1, At, B1); PG8_BAR;
            PG8_LDB(B0, 1, 0); PG8_SCHED; PG8_LDA(At, 1, 0); PG8_STAGE(PG8_SA(0, 1), a2 + hstep, voffA);
            PG8_WAIT_L(8); PG8_BAR; PG8_WAIT_L(0); PG8_MMA(0, 0, At, B0); PG8_BAR; PG8_SCHED;
            PG8_LDB(B1, 1, 1); PG8_STAGE(PG8_SB(1, 0), b3, voffB);
            PG8_BAR; PG8_WAIT_L(0); PG8_MMA(0, 1, At, B1); PG8_BAR;
            PG8_LDA(At, 1, 1); PG8_STAGE(PG8_SA(1, 0), a3, voffA);
            PG8_BAR; PG8_WAIT_L(0); PG8_MMA(1, 0, At, B0); PG8_BAR; PG8_SCHED;
            PG8_STAGE(PG8_SB(1, 1), b3 + hstep, voffB);
            PG8_WAIT_V(6); PG8_BAR; PG8_MMA(1, 1, At, B1); PG8_BAR;
            }
        }
        if constexpr (ALIGN_EPI) { if (wr == 0) PG8_BAR; }
        if constexpr (!Epi::AFTER_DRAIN) { E(acc, cur, wr, wc, fr, fq); S.done(cur); }
        if (!has_next) break;
#pragma unroll
        for (int a = 0; a < 2; ++a)
#pragma unroll
            for (int b = 0; b < 2; ++b)
#pragma unroll
                for (int m = 0; m < 4; ++m)
#pragma unroll
                    for (int n = 0; n < 2; ++n) acc[a][b][m][n] = (typename Epi::acc_t){0, 0, 0, 0};
        cur = nxt; cA = nA; cB = nB; ++ui;
        if constexpr (ALIGN_EPI) { if (wr == 1) PG8_BAR; }
    }
    PG8_WAIT_V(0);
    if constexpr (!ALIGN_EPI) { if (wr == 0) PG8_BAR; }
    PG8_BAR;
    if constexpr (Epi::AFTER_DRAIN) { E.fused(acc, cur, wr, wc, fr, fq, lds, wid, lane); S.done(cur); }
#undef PG8_SA
#undef PG8_SB
#undef PG8_STAGE
#undef PG8_LDA
#undef PG8_LDB
#undef PG8_MMA
#undef PG8_WAIT_V
#undef PG8_WAIT_L
#undef PG8_BAR
#undef PG8_SCHED
}
}
#define LAS __attribute__((address_space(3)))
typedef unsigned short bf16;
typedef short bf16x8 __attribute__((ext_vector_type(8)));
typedef short bf16x4 __attribute__((ext_vector_type(4)));
typedef float f32x4 __attribute__((ext_vector_type(4)));
typedef float f32x2 __attribute__((ext_vector_type(2)));
typedef unsigned u32x4 __attribute__((ext_vector_type(4)));
typedef unsigned u32x2 __attribute__((ext_vector_type(2)));

constexpr int D = 2048, NB = 8, SEQ = 2048, CTXL = 256, DEPTH = 2, GRIDW = 64;
constexpr int NLAT = NB * SEQ, NCTX = NB * CTXL, NROW = NLAT + NCTX;
constexpr int HA = 8, DHA = 64, HB = 4, DKB = 128, DVB = 256, DECR = 16, GC = 4, CG = 128, MIXC = 128;
constexpr int NE = 16, FF = 2048, CAPL = 256, CAPC = 32;
constexpr int N_IN = 5664, NU = 5888;
constexpr int U_QA = 0, U_KA = 512, U_VA = 1024, U_KB = 1536, U_VB = 2048, U_QB = 3072, U_GB = 3584, U_UC = 4608, U_VC = 5120, U_DEC = 5632;
constexpr int MIX_A = 0, MIX_B = 512, MIX_C = 1536;
constexpr float EPS = 1e-6f;
constexpr int ME0 = NB * CAPL + NB * CAPC, ME1 = NB * CAPL;

constexpr size_t MiB = 1u << 20;
constexpr size_t WS_CTL = 0, CTL_ZERO_BYTES = 65536;
constexpr size_t WS_MOD = 1 * MiB;
constexpr size_t WS_ROPE = 2 * MiB;
constexpr size_t WS_CV = WS_ROPE + 65536;
constexpr size_t WS_AFF = 3 * MiB;
constexpr size_t WS_TSLOT = 5 * MiB;
constexpr size_t WS_GD = 6656 * 1024;
constexpr size_t WS_WIN = 8 * MiB;
constexpr size_t WS_SIN = WS_WIN + 24 * MiB;
constexpr size_t WS_WOUT = 54 * MiB;
constexpr size_t WS_W1 = 70 * MiB;
constexpr size_t WS_S1 = WS_W1 + 256 * MiB;
constexpr size_t WS_W2 = 582 * MiB;
constexpr size_t WS_S2 = WS_W2 + 128 * MiB;
constexpr size_t WS_H = 838 * MiB;
constexpr size_t WS_HS = WS_H + 36 * MiB;
constexpr size_t WS_XC = 910 * MiB;
constexpr size_t WS_R1 = 926 * MiB;
constexpr size_t WS_R2 = 1133 * MiB;
constexpr size_t WS_XSS = WS_R2 + 72 * MiB;
constexpr size_t WS_TM = WS_R1 + 144 * MiB;
constexpr size_t WS_ACTS = WS_TM + 9 * MiB;
constexpr size_t WS_ACTQ = 1349 * MiB;
constexpr size_t WS_GQ = WS_R2, WS_GK = WS_R2 + 36 * MiB, WS_GV = WS_R2 + 72 * MiB;
constexpr size_t WS_MIX = 1277 * MiB;
constexpr size_t WS_OB = 1349 * MiB;
constexpr size_t WS_END = 1421 * MiB;
constexpr size_t WS_DUMMY = WS_END;
constexpr size_t WS_XB = WS_END + 72 * MiB;
constexpr size_t WS_END2 = WS_XB + 72 * MiB;
static_assert((size_t)DEPTH * NU * D * 2 <= 46 * MiB && (size_t)NROW * NU * 2 <= 207 * MiB && (size_t)NE * ME0 * D * 2 <= 144 * MiB && (size_t)NROW * D * 2 <= 72 * MiB, "ws map");
constexpr int CW_TMO = 0, CW_BAR = 4096, CW_BG = 8192, CW_SIG = 8256;

constexpr int LDS_BYTES = 147456, NWAVES = 8, NTHR = 512;
constexpr int LDS_XB = 147456 - 64;

using pg8::silu_f; using pg8::xmax16; using pg8::xmax32; using pg8::xsum16; using pg8::xsum32;
typedef __bf16 hwbf16x2 __attribute__((ext_vector_type(2)));
__device__ __forceinline__ unsigned pk2(float lo, float hi) { const f32x2 v = {lo, hi}; const hwbf16x2 b = __builtin_convertvector(v, hwbf16x2); return __builtin_bit_cast(unsigned, b); }
__device__ __forceinline__ unsigned f2bf(float f) { return pk2(f, 0.f) & 0xffffu; }
__device__ __forceinline__ float bf2f(unsigned b) { return __builtin_bit_cast(float, b << 16); }
__device__ __forceinline__ float bflo(unsigned w) { return __builtin_bit_cast(float, w << 16); }
__device__ __forceinline__ float bfhi(unsigned w) { return __builtin_bit_cast(float, w & 0xffff0000u); }
template <int CTRL, int ROWMASK> __device__ __forceinline__ float dpp_f(float old, float v) { return __builtin_bit_cast(float, __builtin_amdgcn_update_dpp(__builtin_bit_cast(int, old), __builtin_bit_cast(int, v), CTRL, ROWMASK, 0xf, false)); }
__device__ __forceinline__ float wave_sum(float v) {
    v += dpp_f<0xB1, 0xf>(0.f, v); v += dpp_f<0x4E, 0xf>(0.f, v); v += dpp_f<0x141, 0xf>(0.f, v); v += dpp_f<0x140, 0xf>(0.f, v);
    v += dpp_f<0x142, 0xa>(0.f, v); v += dpp_f<0x143, 0xc>(0.f, v);
    return __builtin_bit_cast(float, __builtin_amdgcn_readlane(__builtin_bit_cast(int, v), 63));
}
__device__ __forceinline__ float gelu_tanh(float x) { const float u = 0.7978845608028654f * (x + 0.044715f * x * x * x); const float e = __expf(2.0f * u); return 0.5f * x * (2.0f - 2.0f * __builtin_amdgcn_rcpf(1.0f + e)); }
__device__ __forceinline__ float log_sigmoid(float z) { return fminf(z, 0.0f) - __logf(1.0f + __expf(-fabsf(z))); }
#define LDS_WAIT() asm volatile("s_waitcnt lgkmcnt(0)" ::: "memory")

__device__ __forceinline__ void row_load_f32(const float* p, int lane, float (&v)[32]) {
#pragma unroll
    for (int j = 0; j < 4; ++j) { const f32x4 a = *(const f32x4*)(p + 512 * j + 8 * lane), b = *(const f32x4*)(p + 512 * j + 8 * lane + 4);
        v[8 * j + 0] = a[0]; v[8 * j + 1] = a[1]; v[8 * j + 2] = a[2]; v[8 * j + 3] = a[3]; v[8 * j + 4] = b[0]; v[8 * j + 5] = b[1]; v[8 * j + 6] = b[2]; v[8 * j + 7] = b[3]; }
}
__device__ __forceinline__ void row_load_f32_nt(const float* p, int lane, float (&v)[32]) {
#pragma unroll
    for (int j = 0; j < 4; ++j) { const f32x4 a = __builtin_nontemporal_load((const f32x4*)(p + 512 * j + 8 * lane)), b = __builtin_nontemporal_load((const f32x4*)(p + 512 * j + 8 * lane + 4));
        v[8 * j + 0] = a[0]; v[8 * j + 1] = a[1]; v[8 * j + 2] = a[2]; v[8 * j + 3] = a[3]; v[8 * j + 4] = b[0]; v[8 * j + 5] = b[1]; v[8 * j + 6] = b[2]; v[8 * j + 7] = b[3]; }
}
__device__ __forceinline__ void row_load_bf16_nt(const bf16* p, int lane, float (&v)[32]) {
#pragma unroll
    for (int j = 0; j < 4; ++j) { const u32x4 a = __builtin_nontemporal_load((const u32x4*)(p + 512 * j + 8 * lane));
        v[8 * j + 0] = bflo(a.x); v[8 * j + 1] = bfhi(a.x); v[8 * j + 2] = bflo(a.y); v[8 * j + 3] = bfhi(a.y); v[8 * j + 4] = bflo(a.z); v[8 * j + 5] = bfhi(a.z); v[8 * j + 6] = bflo(a.w); v[8 * j + 7] = bfhi(a.w); }
}
__device__ __forceinline__ void row_store_f32(float* p, int lane, const float (&v)[32]) {
#pragma unroll
    for (int j = 0; j < 4; ++j) { __builtin_nontemporal_store((f32x4){v[8 * j], v[8 * j + 1], v[8 * j + 2], v[8 * j + 3]}, (f32x4*)(p + 512 * j + 8 * lane)); __builtin_nontemporal_store((f32x4){v[8 * j + 4], v[8 * j + 5], v[8 * j + 6], v[8 * j + 7]}, (f32x4*)(p + 512 * j + 8 * lane + 4)); }
}
__device__ __forceinline__ void row_load_bf16(const bf16* p, int lane, float (&v)[32]) {
#pragma unroll
    for (int j = 0; j < 4; ++j) { const u32x4 a = *(const u32x4*)(p + 512 * j + 8 * lane);
        v[8 * j + 0] = bflo(a.x); v[8 * j + 1] = bfhi(a.x); v[8 * j + 2] = bflo(a.y); v[8 * j + 3] = bfhi(a.y); v[8 * j + 4] = bflo(a.z); v[8 * j + 5] = bfhi(a.z); v[8 * j + 6] = bflo(a.w); v[8 * j + 7] = bfhi(a.w); }
}
__device__ __forceinline__ void row_store_bf16(bf16* p, int lane, const float (&v)[32]) {
#pragma unroll
    for (int j = 0; j < 4; ++j) { u32x4 a; a.x = pk2(v[8 * j], v[8 * j + 1]); a.y = pk2(v[8 * j + 2], v[8 * j + 3]); a.z = pk2(v[8 * j + 4], v[8 * j + 5]); a.w = pk2(v[8 * j + 6], v[8 * j + 7]); __builtin_nontemporal_store(a, (u32x4*)(p + 512 * j + 8 * lane)); }
}
__device__ __forceinline__ float row_sumsq(const float (&v)[32]) { float s = 0.f;
#pragma unroll
    for (int i = 0; i < 32; ++i) s += v[i] * v[i];
    return wave_sum(s); }

#define XB_TMO      128
#define XB_XCNT(j)  (256  + 64 * (j))
#define XB_XSUB(j)  (1280 + 64 * (j))
#define XB_XGEN(j)  (2304 + 64 * (j))
#define XB_TOP      3328
#define XB_TOPGEN   3392
#define XCD_BAR_WORDS 3456
#define XB_SPIN_CAP (1u << 18)
#define LAS __attribute__((address_space(3)))

__device__ __forceinline__ unsigned xb_ld(unsigned* p)              { return __hip_atomic_load(p, __ATOMIC_RELAXED, __HIP_MEMORY_SCOPE_AGENT); }
__device__ __forceinline__ unsigned xb_add(unsigned* p, unsigned v) { return __hip_atomic_fetch_add(p, v, __ATOMIC_RELAXED, __HIP_MEMORY_SCOPE_AGENT); }
__device__ __forceinline__ unsigned xb_xcc_id() { return (unsigned)__builtin_amdgcn_s_getreg((3 << 11) | 20) & 0xFu; }
#define XB_SPIN(cond, bar) do { unsigned _sp = 0; while (cond) { __builtin_amdgcn_s_sleep(1); \
    if ((++_sp & 255u) == 0u) { if (xb_ld(&(bar)[XB_TMO])) break; if (_sp > XB_SPIN_CAP) { atomicAdd(&(bar)[XB_TMO], 1u); break; } } } } while (0)

struct XcdBarrier {
    unsigned* bar; unsigned x;
    volatile LAS unsigned* st;
};

__device__ __forceinline__ XcdBarrier xcd_barrier_post(unsigned* bar, volatile LAS unsigned* st) {
    XcdBarrier b; b.bar = bar; b.x = xb_xcc_id(); b.st = st;
    if (threadIdx.x == 0) (void)xb_add(&bar[XB_XCNT(b.x)], 1u);
    return b;
}
__device__ __forceinline__ void xcd_barrier_complete(unsigned* bar, unsigned x, unsigned& nloc, unsigned& nx) {
    const unsigned G = gridDim.x * gridDim.y * gridDim.z;
    unsigned sum, cnt, mine, sp = 0u;
    for (;;) {
        sum = 0u; cnt = 0u; mine = 0u;
#pragma unroll
        for (unsigned j = 0; j < 16; ++j) { const unsigned c = xb_ld(&bar[XB_XCNT(j)]); sum += c; cnt += (c > 0u) ? 1u : 0u; mine = (j == x) ? c : mine; }
        if (sum == G) break;
        __builtin_amdgcn_s_sleep(1);
        if ((++sp & 255u) == 0u) { if (xb_ld(&bar[XB_TMO])) break; if (sp > XB_SPIN_CAP) { atomicAdd(&bar[XB_TMO], 1u); break; } }
    }
    nloc = mine > 0u ? mine : 1u; nx = cnt > 0u ? cnt : 1u;
}

__device__ __forceinline__ void xcd_barrier(const XcdBarrier& b) {
    asm volatile("s_waitcnt vmcnt(0)" ::: "memory");
    __syncthreads();
    if (threadIdx.x == 0) {
        unsigned* bar = b.bar;
        __builtin_amdgcn_s_waitcnt(0);
        unsigned nloc = b.st[0], nx = b.st[1];
        if (nloc == 0u) { xcd_barrier_complete(bar, b.x, nloc, nx); b.st[0] = nloc; b.st[1] = nx; }
        const unsigned old = xb_add(&bar[XB_XSUB(b.x)], 1u);
        const unsigned gen = old / nloc;
        if (old + 1u == (gen + 1u) * nloc) {
            __builtin_amdgcn_fence(__ATOMIC_RELEASE, "agent");
            asm volatile("s_waitcnt vmcnt(0)" ::: "memory");
            const unsigned og = xb_add(&bar[XB_TOP], 1u);
            const unsigned tg = og / nx;
            if (og + 1u == (tg + 1u) * nx) xb_add(&bar[XB_TOPGEN], 1u);
            else XB_SPIN(xb_ld(&bar[XB_TOPGEN]) == tg, bar);
            __builtin_amdgcn_fence(__ATOMIC_ACQUIRE, "agent");
            xb_add(&bar[XB_XGEN(b.x)], 1u);
            asm volatile("s_waitcnt vmcnt(0)" ::: "memory");
        } else {
            XB_SPIN(xb_ld(&bar[XB_XGEN(b.x)]) == gen, bar);
            __builtin_amdgcn_fence(__ATOMIC_ACQUIRE, "agent");
            asm volatile("s_waitcnt vmcnt(0)" ::: "memory");
        }
    }
    __syncthreads();
}

struct Frame {
    LAS unsigned char* lds;
    int tid, lane, wave, vcu, G;
    const float *x, *c, *ctx, *c_ctx, *w_ada, *b_ada, *g_pre_mix, *g_post_mix, *g_pre_ffn, *g_post_ffn, *w_in, *w_dec, *b_dec, *rpb, *g_gla, *ln_v_g, *ln_v_b, *w_sp, *b_sp, *w_out, *w_router, *w_gate, *w_up, *w_down;
    float* out; unsigned char* ws;
};

#define W_MOD(F) ((float*)((F).ws + WS_MOD))
#define W_ROPE(F) ((float*)((F).ws + WS_ROPE))
#define W_CV(F) ((bf16*)((F).ws + WS_CV))
#define W_AFF(F) ((float*)((F).ws + WS_AFF))
#define W_XC(F) ((float*)((F).ws + WS_XC))
#define W_XB(F) ((bf16*)((F).ws + WS_XB))
#define W_TSLOT(F) ((int*)((F).ws + WS_TSLOT))
#define W_WIN(F) ((bf16*)((F).ws + WS_WIN))
#define W_WOUT(F) ((bf16*)((F).ws + WS_WOUT))
#define W_W1(F) ((bf16*)((F).ws + WS_W1))
#define W_W2(F) ((bf16*)((F).ws + WS_W2))
#define W_H(F) ((bf16*)((F).ws + WS_H))
#define W_U(F) ((bf16*)((F).ws + WS_R1))
#define W_Y(F) ((bf16*)((F).ws + WS_R1))
#define W_ACT(F) ((bf16*)((F).ws + WS_R1))
#define W_XS(F) ((bf16*)((F).ws + WS_R2))
#define W_MIX(F) ((bf16*)((F).ws + WS_MIX))
#define W_OB(F) ((bf16*)((F).ws + WS_OB))
#define W_SIN(F) ((float*)((F).ws + WS_SIN))
#define W_S1(F) ((float*)((F).ws + WS_S1))
#define W_S2(F) ((float*)((F).ws + WS_S2))
#define W_HQ(F) ((signed char*)((F).ws + WS_H))
#define W_HS(F) ((float*)((F).ws + WS_HS))
#define W_XSQ(F) ((signed char*)((F).ws + WS_R2))
#define W_XSS(F) ((float*)((F).ws + WS_XSS))
#define W_TM(F) ((float*)((F).ws + WS_TM))
#define W_ACTS(F) ((float*)((F).ws + WS_ACTS))
#define W_ACTQ(F) ((signed char*)((F).ws + WS_ACTQ))
__device__ __forceinline__ void launder(Frame& F) {
    int wv = F.wave; asm volatile("" : "+s"(wv)); F.wave = wv;
    unsigned ones = ~0u; asm volatile("" : "+s"(ones));
    int t = wv * 64 + (int)__builtin_amdgcn_mbcnt_hi(ones, __builtin_amdgcn_mbcnt_lo(ones, 0u)); asm volatile("" : "+v"(t)); F.tid = t; F.lane = t & 63;
    int v = F.vcu; asm volatile("" : "+s"(v)); F.vcu = v;
    __attribute__((address_space(1))) unsigned char* w = (__attribute__((address_space(1))) unsigned char*)F.ws; asm volatile("" : "+s"(w)); F.ws = (unsigned char*)w;
}

__device__ __forceinline__ float wave_max(float v) {
    v = fmaxf(v, dpp_f<0xB1, 0xf>(v, v)); v = fmaxf(v, dpp_f<0x4E, 0xf>(v, v)); v = fmaxf(v, dpp_f<0x141, 0xf>(v, v)); v = fmaxf(v, dpp_f<0x140, 0xf>(v, v));
    v = fmaxf(v, dpp_f<0x142, 0xa>(v, v)); v = fmaxf(v, dpp_f<0x143, 0xc>(v, v));
    return __builtin_bit_cast(float, __builtin_amdgcn_readlane(__builtin_bit_cast(int, v), 63));
}
__device__ __forceinline__ unsigned pack4_i8(float a, float b, float c, float d) { return ((unsigned)(int)a & 0xffu) | (((unsigned)(int)b & 0xffu) << 8) | (((unsigned)(int)c & 0xffu) << 16) | (((unsigned)(int)d & 0xffu) << 24); }
__device__ __forceinline__ unsigned q4_i8(float a, float b, float c, float d, float inv) {
    const unsigned x0 = __builtin_bit_cast(unsigned, fmaf(a, inv, 12582912.f)), x1 = __builtin_bit_cast(unsigned, fmaf(b, inv, 12582912.f)), x2 = __builtin_bit_cast(unsigned, fmaf(c, inv, 12582912.f)), x3 = __builtin_bit_cast(unsigned, fmaf(d, inv, 12582912.f));
    return __builtin_amdgcn_perm(x1, x0, 0x0c0c0400u) | __builtin_amdgcn_perm(x3, x2, 0x04000c0cu);
}
__device__ __forceinline__ void row_store_i8(signed char* p, int lane, const float (&v)[32], float inv) {
#pragma unroll
    for (int j = 0; j < 4; ++j) { u32x2 o; o.x = q4_i8(v[8 * j], v[8 * j + 1], v[8 * j + 2], v[8 * j + 3], inv); o.y = q4_i8(v[8 * j + 4], v[8 * j + 5], v[8 * j + 6], v[8 * j + 7], inv);
        __builtin_nontemporal_store(o, (u32x2*)(p + 512 * j + 8 * lane)); }
}

#define LBAR() do { asm volatile("s_waitcnt lgkmcnt(0)" ::: "memory"); __builtin_amdgcn_s_barrier(); asm volatile("" ::: "memory"); } while (0)
__device__ __forceinline__ int dest_row(int mode, int n) {
    if (mode == 1) return n < 3072 ? n : (n < 3104 ? U_DEC + (n - 3072) : n - 32);
    if (mode == 2) return ((n >> 7) << 8) + (n & 127);
    if (mode == 3) return ((n >> 7) << 8) + 128 + (n & 127);
    return n;
}
constexpr int IN_ITEMS = (N_IN + 63) / 64;
constexpr int BG_IN0 = IN_ITEMS, BG_A = BG_IN0 + NE * 3 * 32, BG_B = BG_A + IN_ITEMS, BG_TOTAL = BG_B + NE * 3 * 32;
__device__ __forceinline__ unsigned pkbf(float lo, float hi) { unsigned r; asm volatile("v_cvt_pk_bf16_f32 %0, %1, %2" : "=v"(r) : "v"(lo), "v"(hi)); return r; }
__device__ __forceinline__ void strip_item(Frame& F, int id) {
    const int lane = F.lane, n16 = lane & 15, kq = lane >> 4;
    LAS float* cm = (LAS float*)(F.lds); LAS unsigned* qb = (LAS unsigned*)(F.lds + 2048);
    const int l = id >= BG_A ? 1 : 0, idl = l ? id - BG_A : id; const bool isin = idl < IN_ITEMS; const int itm = isin ? idl : idl - IN_ITEMS;
    const int mi = itm >> 5, n0 = isin ? itm * 64 : (itm & 31) * 64, e = mi / 3, which = isin ? 3 : mi % 3; const size_t le = (size_t)l * NE + e;
    const float* W = isin ? F.w_in + (size_t)l * D * N_IN : (which == 0 ? F.w_gate + le * D * FF : (which == 1 ? F.w_up + le * D * FF : F.w_down + le * FF * D));
    const int mode = isin ? 1 : (which == 0 ? 2 : (which == 1 ? 3 : 0)), pitch = isin ? N_IN : D, N = isin ? N_IN : D;
    signed char* dq = isin ? (signed char*)(F.ws + WS_WIN) + (size_t)l * NU * D : (which == 2 ? (signed char*)(F.ws + WS_W2) + le * D * FF : (signed char*)(F.ws + WS_W1) + le * (2 * FF) * D);
    float* ds = isin ? W_SIN(F) + (size_t)l * NU : (which == 2 ? W_S2(F) + le * D : W_S1(F) + le * (2 * FF));
    const bool colok = (n0 + 4 * n16) < N;
    const float* src = W + (size_t)(256 * F.wave + 4 * kq) * pitch + n0 + 4 * n16;
    unsigned pk[16][4][2];
#pragma unroll
    for (int hb = 0; hb < 4; ++hb) {
        f32x4 t[4][4];
#pragma unroll
        for (int j = 0; j < 4; ++j)
#pragma unroll
            for (int e4 = 0; e4 < 4; ++e4) t[j][e4] = colok ? __builtin_nontemporal_load((const f32x4*)(src + (size_t)(16 * (4 * hb + j) + e4) * pitch)) : (f32x4){0.f, 0.f, 0.f, 0.f};
#pragma unroll
        for (int j = 0; j < 4; ++j) {
#pragma unroll
            for (int e4 = 0; e4 < 4; ++e4) { pk[4 * hb + j][e4][0] = pkbf(t[j][e4][0], t[j][e4][1]); pk[4 * hb + j][e4][1] = pkbf(t[j][e4][2], t[j][e4][3]); }
            asm volatile("" : "+v"(pk[4 * hb + j][0][0]), "+v"(pk[4 * hb + j][0][1]), "+v"(pk[4 * hb + j][1][0]), "+v"(pk[4 * hb + j][1][1]), "+v"(pk[4 * hb + j][2][0]), "+v"(pk[4 * hb + j][2][1]), "+v"(pk[4 * hb + j][3][0]), "+v"(pk[4 * hb + j][3][1]) :: "memory");
        }
    }
    typedef unsigned short u16x2 __attribute__((ext_vector_type(2)));
    u16x2 m01 = {0, 0}, m23 = {0, 0};
#pragma unroll
    for (int j = 0; j < 16; ++j)
#pragma unroll
        for (int e4 = 0; e4 < 4; ++e4) { m01 = __builtin_elementwise_max(m01, __builtin_bit_cast(u16x2, pk[j][e4][0] & 0x7fff7fffu)); m23 = __builtin_elementwise_max(m23, __builtin_bit_cast(u16x2, pk[j][e4][1] & 0x7fff7fffu)); }
    float mx[4] = {bf2f(m01[0]), bf2f(m01[1]), bf2f(m23[0]), bf2f(m23[1])};
#pragma unroll
    for (int c = 0; c < 4; ++c) { mx[c] = fmaxf(mx[c], __shfl_xor(mx[c], 16)); mx[c] = fmaxf(mx[c], __shfl_xor(mx[c], 32)); }
    if (lane < 16) *(LAS f32x4*)(cm + F.wave * 64 + 4 * lane) = (f32x4){mx[0], mx[1], mx[2], mx[3]};
#pragma unroll
    for (int j = 0; j < 16; ++j)
        asm volatile("" : "+v"(pk[j][0][0]), "+v"(pk[j][0][1]), "+v"(pk[j][1][0]), "+v"(pk[j][1][1]), "+v"(pk[j][2][0]), "+v"(pk[j][2][1]), "+v"(pk[j][3][0]), "+v"(pk[j][3][1]));
    LBAR();
    f32x4 cmx = (f32x4){0.f, 0.f, 0.f, 0.f};
#pragma unroll
    for (int w = 0; w < 8; ++w) { const f32x4 c4 = *(const LAS f32x4*)(cm + w * 64 + 4 * n16); cmx = __builtin_elementwise_max(cmx, c4); }
    float sc[4], iv[4];
#pragma unroll
    for (int c = 0; c < 4; ++c) { sc[c] = cmx[c] > 0.f ? cmx[c] * (1.0f / 127.0f) : 1.0f; iv[c] = 1.0f / sc[c]; }
    if (F.tid < 16 && colok) {
#pragma unroll
        for (int c = 0; c < 4; ++c) ds[dest_row(mode, n0 + 4 * F.tid + c)] = sc[c]; }
    const int sw = (n16 >> 1);
#pragma unroll
    for (int j = 0; j < 16; ++j) {
        unsigned o[4];
#pragma unroll
        for (int c = 0; c < 4; ++c) { unsigned x[4];
#pragma unroll
            for (int e4 = 0; e4 < 4; ++e4) { const unsigned wv = pk[j][e4][c >> 1]; const float xf = (c & 1) ? bfhi(wv) : bflo(wv); x[e4] = __builtin_bit_cast(unsigned, fmaf(xf, iv[c], 12582912.f)); }
            o[c] = __builtin_amdgcn_perm(x[1], x[0], 0x0c0c0400u) | __builtin_amdgcn_perm(x[3], x[2], 0x04000c0cu); }
        const int idx4 = (16 * F.wave + j) ^ sw;
#pragma unroll
        for (int c = 0; c < 4; ++c) qb[(4 * n16 + c) * 516 + 4 * idx4 + kq] = o[c];
    }
    LBAR();
#pragma unroll
    for (int q16 = 0; q16 < 16; ++q16) { const int p = F.tid + 512 * q16, n = p >> 7, c16 = p & 127;
        if (n0 + n < N) __builtin_nontemporal_store(*(const LAS u32x4*)(qb + n * 516 + 4 * (c16 ^ (n >> 3))), (u32x4*)(dq + (size_t)dest_row(mode, n0 + n) * D + 16 * c16)); }
    LBAR();
}
__device__ __forceinline__ void bg_loop(Frame& F, unsigned* ctl, const unsigned* sig, int limit) {
    LAS int* flag = (LAS int*)(F.lds + 140000);
    unsigned* head = ctl + CW_BG;
    __syncthreads();
    for (;;) {
        if (F.tid == 0) { int idx = -1;
            const bool stop = sig && __hip_atomic_load(sig, __ATOMIC_RELAXED, __HIP_MEMORY_SCOPE_AGENT) != 0u;
            if (!stop && (int)__hip_atomic_load(head, __ATOMIC_RELAXED, __HIP_MEMORY_SCOPE_AGENT) + BG_IN0 < limit) { idx = (int)__hip_atomic_fetch_add(head, 1u, __ATOMIC_RELAXED, __HIP_MEMORY_SCOPE_AGENT) + BG_IN0; if (idx >= BG_TOTAL) idx = -1; }
            *flag = idx; }
        __syncthreads();
        const int idx = *flag;
        __syncthreads();
        if (idx < 0) break;
        strip_item(F, idx);
    }
}
#ifndef MK_REPP0
#define MK_REPP0 0u
#endif
__device__ __forceinline__ void transpose_item(const float* W, int N, int k0, int n0, bf16* dst, int mode, LAS float* scr, int lane) {
    const bool nok = (n0 + lane) < N;
    const float* src = W + (size_t)k0 * N + n0 + lane;
#pragma unroll 8
    for (int i = 0; i < 64; ++i) scr[i * 65 + lane] = nok ? __builtin_nontemporal_load(src + (size_t)i * N) : 0.f;
    LDS_WAIT();
    const int c = lane & 7;
#pragma unroll
    for (int j = 0; j < 8; ++j) { const int nl = (lane >> 3) + 8 * j, n = n0 + nl; const LAS float* s = scr + (8 * c) * 65 + nl;
        u32x4 o; o.x = pk2(s[0 * 65], s[1 * 65]); o.y = pk2(s[2 * 65], s[3 * 65]); o.z = pk2(s[4 * 65], s[5 * 65]); o.w = pk2(s[6 * 65], s[7 * 65]);
        if (n < N) *(u32x4*)(dst + (size_t)dest_row(mode, n) * D + k0 + 8 * c) = o; }
    LDS_WAIT();
}
__device__ __forceinline__ void p0a(Frame& F) {
    const int gw = F.vcu * NWAVES + F.wave, NGW = F.G * NWAVES, lane = F.lane;
    for (int rep0 = 0; rep0 < 1 + (int)(MK_REPP0 & 1u); ++rep0) {
        LAS float* red = (LAS float*)F.lds;
        for (int it = F.vcu; it < DEPTH * 96; it += F.G) {
            const int l = it / 96, n0 = (it % 96) * 128;
            float acc[9][2];
#pragma unroll
            for (int r = 0; r < 9; ++r) { acc[r][0] = 0.f; acc[r][1] = 0.f; }
            for (int kb = 0; kb < 4; ++kb) {
                const int k0 = 256 * F.wave + 64 * kb;
                float sv[9];
#pragma unroll
                for (int r = 0; r < 8; ++r) sv[r] = silu_f(F.c[r * D + k0 + lane]);
                sv[8] = silu_f(F.c_ctx[k0 + lane]);
                const float* wp = F.w_ada + ((size_t)l * D + k0) * (6 * D) + n0 + 2 * lane;
#pragma unroll 4
                for (int kk = 0; kk < 64; ++kk) {
                    const f32x2 wv = __builtin_nontemporal_load((const f32x2*)(wp + (size_t)kk * (6 * D)));
#pragma unroll
                    for (int r = 0; r < 9; ++r) { const float s = __builtin_bit_cast(float, __builtin_amdgcn_readlane(__builtin_bit_cast(int, sv[r]), kk)); acc[r][0] += s * wv.x; acc[r][1] += s * wv.y; }
                }
            }
#pragma unroll
            for (int r = 0; r < 9; ++r) { red[(F.wave * 9 + r) * 128 + 2 * lane] = acc[r][0]; red[(F.wave * 9 + r) * 128 + 2 * lane + 1] = acc[r][1]; }
            __syncthreads();
            for (int o = F.tid; o < 9 * 128; o += NTHR) { const int r = o >> 7, col = o & 127; float s = 0.f;
#pragma unroll
                for (int w = 0; w < 8; ++w) s += red[(w * 9 + r) * 128 + col];
                W_MOD(F)[((size_t)l * 9 + r) * (6 * D) + n0 + col] = s + F.b_ada[(size_t)l * 6 * D + n0 + col]; }
            __syncthreads();
        }
    }
    {
        const int gid = (F.vcu * NTHR + F.tid);
        if (gid < 64 * 32) {
            const int pos = gid >> 5, f = gid & 31;
            double inv = 1.0; for (int i = 0; i < f; ++i) inv *= 0.74989420933245582730;
            const double xa = (double)pos * inv;
            const double q = __builtin_rint(xa * 0.63661977236758134308);
            double y = __builtin_fma(-q, 1.57079632679489655800, xa); y = __builtin_fma(-q, 6.12323399573676603587e-17, y);
            const double y2 = y * y;
            double sn = -1.0 / 1307674368000.0; sn = sn * y2 + 1.0 / 6227020800.0; sn = sn * y2 - 1.0 / 39916800.0; sn = sn * y2 + 1.0 / 362880.0; sn = sn * y2 - 1.0 / 5040.0; sn = sn * y2 + 1.0 / 120.0; sn = sn * y2 - 1.0 / 6.0; sn = sn * y2 + 1.0; sn *= y;
            double cs = 1.0 / 20922789888000.0; cs = cs * y2 - 1.0 / 87178291200.0; cs = cs * y2 + 1.0 / 479001600.0; cs = cs * y2 - 1.0 / 3628800.0; cs = cs * y2 + 1.0 / 40320.0; cs = cs * y2 - 1.0 / 720.0; cs = cs * y2 + 1.0 / 24.0; cs = cs * y2 - 0.5; cs = cs * y2 + 1.0;
            const int qi = ((int)q) & 3;
            const double c2 = (qi == 0) ? cs : (qi == 1) ? -sn : (qi == 2) ? -cs : sn;
            const double s2 = (qi == 0) ? sn : (qi == 1) ? cs : (qi == 2) ? -sn : -cs;
            W_ROPE(F)[gid] = (float)c2; W_ROPE(F)[2048 + gid] = (float)s2;
        }
    }
    {
        const int per = (NU - N_IN) * D / 16;
        for (int i = F.vcu * NTHR + F.tid; i < DEPTH * per; i += F.G * NTHR) { const int l = i / per, r = i % per;
            *(u32x4*)((signed char*)(F.ws + WS_WIN) + ((size_t)l * NU + N_IN) * D + (size_t)r * 16) = (u32x4){0u, 0u, 0u, 0u}; }
        for (int i = F.vcu * NTHR + F.tid; i < DEPTH * (NU - N_IN); i += F.G * NTHR) W_SIN(F)[(size_t)(i / (NU - N_IN)) * NU + N_IN + i % (NU - N_IN)] = 1.0f;
    }
    for (int rep1 = 0; rep1 < 1 + (int)((MK_REPP0 >> 1) & 1u); ++rep1) {
        LAS float* scr = (LAS float*)(F.lds + F.wave * 16640);
        constexpr int I_OUT = 32 * 32;
        for (int it = gw; it < DEPTH * I_OUT; it += NGW) {
            const int l = it / I_OUT, r = it % I_OUT;
            transpose_item(F.w_out + (size_t)l * D * D, D, (r >> 5) * 64, (r & 31) * 64, W_WOUT(F) + (size_t)l * D * D, 0, scr, lane);
        }
    }
    __syncthreads();
    for (int it = F.G - 1 - F.vcu; it < IN_ITEMS; it += F.G) strip_item(F, it);
    if (MK_REPP0 & 4u) { for (int it = F.vcu; it < BG_TOTAL; it += F.G) strip_item(F, it); }
    __syncthreads();
}

__device__ __forceinline__ void prenorm_row(Frame& F, int l, int m, const float (&xv)[32], int row) {
    const float r = 1.0f / sqrtf(row_sumsq(xv) * (1.0f / D) + EPS);
    const float* g = F.g_pre_mix + (size_t)l * D; const float* mod = W_MOD(F) + ((size_t)l * 9 + m) * (6 * D);
    float gv[32], shv[32], scv[32], hv[32];
    row_load_f32(g, F.lane, gv); row_load_f32(mod, F.lane, shv); row_load_f32(mod + D, F.lane, scv);
#pragma unroll
    for (int i = 0; i < 32; ++i) hv[i] = xv[i] * r * gv[i] * (1.0f + scv[i]) + shv[i];
    float am = 0.f;
#pragma unroll
    for (int i = 0; i < 32; ++i) am = fmaxf(am, fabsf(hv[i]));
    am = wave_max(am);
    const float scale = am > 0.f ? am * (1.0f / 127.0f) : 1.0f;
    row_store_i8(W_HQ(F) + (size_t)row * D, F.lane, hv, 1.0f / scale);
    if (F.lane == 0) W_HS(F)[row] = scale;
}
__device__ __forceinline__ void prenorm_row_cv(Frame& F, int l, int m, const float (&xv)[32], int row) {
    const bf16* cv = W_CV(F) + ((size_t)l * 9 + m) * 6 * D;
    float c4[32], c5[32], hv[32];
    row_load_bf16(cv + 4 * D, F.lane, c4); row_load_bf16(cv + 5 * D, F.lane, c5);
    const float r = 1.0f / sqrtf(row_sumsq(xv) * (1.0f / D) + EPS);
#pragma unroll
    for (int i = 0; i < 32; ++i) hv[i] = xv[i] * r * c4[i] + c5[i];
    float am = 0.f;
#pragma unroll
    for (int i = 0; i < 32; ++i) am = fmaxf(am, fabsf(hv[i]));
    am = wave_max(am);
    const float scale = am > 0.f ? am * (1.0f / 127.0f) : 1.0f;
    row_store_i8(W_HQ(F) + (size_t)row * D, F.lane, hv, 1.0f / scale);
    if (F.lane == 0) W_HS(F)[row] = scale;
}
__device__ __forceinline__ void p0b(Frame& F) {
    const int gw = F.vcu * NWAVES + F.wave, NGW = F.G * NWAVES;
    for (int i = F.vcu * NTHR + F.tid; i < DEPTH * 9 * (D / 8); i += F.G * NTHR) {
        const int lm = i / (D / 8), k0 = (i % (D / 8)) * 8, l = lm / 9; const float* mod = W_MOD(F) + (size_t)lm * (6 * D);
        bf16* cv = W_CV(F) + (size_t)lm * 6 * D + k0;
        float o[6][8];
#pragma unroll
        for (int e = 0; e < 8; ++e) { const int k = k0 + e;
            o[0][e] = mod[2 * D + k] * F.g_post_mix[(size_t)l * D + k]; o[1][e] = F.g_pre_ffn[(size_t)l * D + k] * (1.0f + mod[4 * D + k]); o[2][e] = mod[3 * D + k];
            o[3][e] = mod[5 * D + k] * F.g_post_ffn[(size_t)l * D + k]; o[4][e] = F.g_pre_mix[(size_t)l * D + k] * (1.0f + mod[D + k]); o[5][e] = mod[k]; }
#pragma unroll
        for (int v = 0; v < 6; ++v) { u32x4 w; w.x = pk2(o[v][0], o[v][1]); w.y = pk2(o[v][2], o[v][3]); w.z = pk2(o[v][4], o[v][5]); w.w = pk2(o[v][6], o[v][7]); *(u32x4*)(cv + (size_t)v * D) = w; }
    }
    for (int row = gw; row < NROW; row += 2 * NGW) {
        const int row2 = (row + NGW < NROW) ? row + NGW : row;
        const float* xp = row < NLAT ? F.x + (size_t)row * D : F.ctx + (size_t)(row - NLAT) * D; const int m = row < NLAT ? row / SEQ : 8;
        const float* xp2 = row2 < NLAT ? F.x + (size_t)row2 * D : F.ctx + (size_t)(row2 - NLAT) * D; const int m2 = row2 < NLAT ? row2 / SEQ : 8;
        float xv[32], xv2[32]; row_load_f32_nt(xp, F.lane, xv); row_load_f32_nt(xp2, F.lane, xv2);
        prenorm_row(F, 0, m, xv, row);
        prenorm_row(F, 0, m2, xv2, row2);
    }
}

#define MFMA16(a, b, c) __builtin_amdgcn_mfma_f32_16x16x32_bf16((a), (b), (c), 0, 0, 0)
__device__ __forceinline__ bf16x8 mk8(u32x2 lo, u32x2 hi) { u32x4 t; t.x = lo.x; t.y = lo.y; t.z = hi.x; t.w = hi.y; return __builtin_bit_cast(bf16x8, t); }
#define GLA_POS(i) (dir ? (nseg - 1 - (64 * cc + (i))) : (64 * cc + (i)))
struct PpIdx { int dir, h, cc, nseg, rowbase; bool lat; };
__device__ __forceinline__ PpIdx pp_idx(int un) { PpIdx I; const int cidx = un % 36, bhd = un / 36; I.dir = bhd & 1; I.h = (bhd >> 1) & 3; const int b = bhd >> 3; I.lat = cidx >= 4; I.cc = I.lat ? cidx - 4 : cidx; I.nseg = I.lat ? SEQ : CTXL; I.rowbase = I.lat ? b * SEQ : NLAT + b * CTXL; return I; }
#define PP_POS(I, i) ((I).dir ? ((I).nseg - 1 - (64 * (I).cc + (i))) : (64 * (I).cc + (i)))
struct PpRegs { u32x4 dec[4]; unsigned vw[16]; unsigned short qraw[16], kraw[16]; float wd[8]; float bd; };
__device__ __forceinline__ void pp_load_v(Frame& F, int un, PpRegs& R) {
    const PpIdx I = pp_idx(un); const int tid = F.tid; const bf16* U = W_U(F);
    { const int c15 = tid & 15, g1 = (tid >> 4) & 1;
#pragma unroll
      for (int it = 0; it < 4; ++it) R.dec[it] = *(const u32x4*)(U + (size_t)(I.rowbase + PP_POS(I, 16 * it + c15)) * NU + U_DEC + I.dir * 16 + 8 * g1); }
    const int vq = tid & 127, jp4 = tid >> 7;
#pragma unroll
    for (int jj = 0; jj < 16; ++jj) R.vw[jj] = *(const unsigned*)(U + (size_t)(I.rowbase + PP_POS(I, 16 * jp4 + jj)) * NU + U_VB + I.h * 256 + 2 * vq);
}
__device__ __forceinline__ void pp_load_w(Frame& F, int l, int un, PpRegs& R) {
    const PpIdx I = pp_idx(un); const int ch = I.h * 128 + 16 * F.wave + (F.tid & 15), g1 = (F.tid >> 4) & 1;
#pragma unroll
    for (int r = 0; r < 8; ++r) R.wd[r] = F.w_dec[(((size_t)l * 2 + I.dir) * DECR + 8 * g1 + r) * 512 + ch];
    R.bd = F.b_dec[((size_t)l * 2 + I.dir) * 512 + ch];
}
__device__ __forceinline__ void pp_load_qk(Frame& F, int un, PpRegs& R) {
    const PpIdx I = pp_idx(un); const int k = F.tid & 127, ip = F.tid >> 7; const bf16* U = W_U(F);
#pragma unroll
    for (int ii = 0; ii < 16; ++ii) { const bf16* rp = U + (size_t)(I.rowbase + PP_POS(I, 16 * ip + ii)) * NU; R.qraw[ii] = rp[U_QB + I.h * 128 + k]; R.kraw[ii] = rp[U_KB + I.h * 128 + k]; }
}
__device__ __forceinline__ void gla_prepass(Frame& F, int l, int un, int unx, PpRegs& R) {
    const int cidx = un % 36, bhd = un / 36, dir = bhd & 1, h = (bhd >> 1) & 3, b = bhd >> 3;
    const int tid = F.tid, lane = F.lane, w = F.wave, c15 = lane & 15, g = lane >> 4;
    LAS unsigned char* L = F.lds;
    LAS bf16* Qt = (LAS bf16*)(L);
    LAS bf16* Kt = (LAS bf16*)(L + 17408);
    LAS bf16* VT = (LAS bf16*)(L + 34816);
    LAS float* PS = (LAS float*)(L + 71680);
    LAS float* ZL = (LAS float*)(L + 73728);
    const bool lat = cidx >= 4; const int cc = lat ? cidx - 4 : cidx, nseg = lat ? SEQ : CTXL, rowbase = lat ? b * SEQ : NLAT + b * CTXL;
    const bool need_out = lat || (l == 0);
    const int k = tid & 127, ip = tid >> 7;
    bf16* GQ = (bf16*)(F.ws + WS_GQ) + (size_t)un * 8192; bf16* GK = (bf16*)(F.ws + WS_GK) + (size_t)un * 8192; bf16* GV = (bf16*)(F.ws + WS_GV) + (size_t)un * 16384; float* GD = (float*)(F.ws + WS_GD) + (size_t)un * 128;
    float rcs[16], rsn[16];
    { const float* COS = W_ROPE(F); const float* SIN = COS + 2048;
#pragma unroll
      for (int ii = 0; ii < 16; ++ii) { const int pos = GLA_POS(16 * ip + ii), pp = (k < 64) ? (pos >> 6) : (pos & 63); rcs[ii] = COS[pp * 32 + (k & 31)]; rsn[ii] = SIN[pp * 32 + (k & 31)]; } }
    {
        const int vq = tid & 127, jp4 = tid >> 7; unsigned vw[16];
#pragma unroll
        for (int jj = 0; jj < 16; ++jj) vw[jj] = R.vw[jj];
        u32x4 a0, a1, b0, b1;
        a0.x = (vw[0] & 0xffffu) | (vw[1] << 16); a0.y = (vw[2] & 0xffffu) | (vw[3] << 16); a0.z = (vw[4] & 0xffffu) | (vw[5] << 16); a0.w = (vw[6] & 0xffffu) | (vw[7] << 16);
        a1.x = (vw[8] & 0xffffu) | (vw[9] << 16); a1.y = (vw[10] & 0xffffu) | (vw[11] << 16); a1.z = (vw[12] & 0xffffu) | (vw[13] << 16); a1.w = (vw[14] & 0xffffu) | (vw[15] << 16);
        b0.x = (vw[0] >> 16) | (vw[1] & 0xffff0000u); b0.y = (vw[2] >> 16) | (vw[3] & 0xffff0000u); b0.z = (vw[4] >> 16) | (vw[5] & 0xffff0000u); b0.w = (vw[6] >> 16) | (vw[7] & 0xffff0000u);
        b1.x = (vw[8] >> 16) | (vw[9] & 0xffff0000u); b1.y = (vw[10] >> 16) | (vw[11] & 0xffff0000u); b1.z = (vw[12] >> 16) | (vw[13] & 0xffff0000u); b1.w = (vw[14] >> 16) | (vw[15] & 0xffff0000u);
        *(LAS u32x4*)(VT + (2 * vq) * 72 + 16 * jp4) = a0; *(LAS u32x4*)(VT + (2 * vq) * 72 + 16 * jp4 + 8) = a1;
        *(LAS u32x4*)(VT + (2 * vq + 1) * 72 + 16 * jp4) = b0; *(LAS u32x4*)(VT + (2 * vq + 1) * 72 + 16 * jp4 + 8) = b1;
    }
    {
        u32x4 bw;
        { float ws_[8];
#pragma unroll
          for (int j = 0; j < 8; ++j) { const float wv = R.wd[j]; const float hj = bflo(pk2(wv, wv)); ws_[j] = (g >= 2) ? wv - hj : wv; }
          bw.x = pk2(ws_[0], ws_[1]); bw.y = pk2(ws_[2], ws_[3]); bw.z = pk2(ws_[4], ws_[5]); bw.w = pk2(ws_[6], ws_[7]); }
        const bf16x8 bop = __builtin_bit_cast(bf16x8, bw); const float bdv = R.bd;
#pragma unroll
        for (int it = 0; it < 4; ++it) {
            const f32x4 z4 = MFMA16(__builtin_bit_cast(bf16x8, R.dec[it]), bop, ((f32x4){bdv, bdv, bdv, bdv}));
#pragma unroll
            for (int rg = 0; rg < 4; ++rg) { const float z = z4[rg];
                const float e = __builtin_amdgcn_exp2f(fabsf(z) * -1.4426950408889634f);
                ZL[(16 * it + 4 * g + rg) * 132 + 16 * w + c15] = (fminf(z, 0.0f) * 1.4426950408889634f - __builtin_amdgcn_logf(1.0f + e)) * (1.0f / 16.0f); }
        }
    }
    asm volatile("" ::: "memory");
    pp_load_v(F, unx, R);
    pp_load_w(F, l, unx, R);
    LBAR();
    float bloc[16]; float run = 0.f;
#pragma unroll
    for (int ii = 0; ii < 16; ++ii) { run += ZL[(16 * ip + ii) * 132 + k]; bloc[ii] = run; }
    PS[ip * 128 + k] = run;
    LBAR();
    {
        float off = 0.f, btot = 0.f;
#pragma unroll
        for (int p = 0; p < 4; ++p) { const float s = PS[p * 128 + k]; btot += s; if (p < ip) off += s; }
        const float etot = __builtin_amdgcn_exp2f(btot);
        if (ip == 0) GD[k] = etot;
        unsigned short kh[16];
        float qpart[16], kpart[16];
        if (lat) {
#pragma unroll
            for (int ii = 0; ii < 16; ++ii) { qpart[ii] = __shfl_xor(bf2f(R.qraw[ii]), 32); kpart[ii] = __shfl_xor(bf2f(R.kraw[ii]), 32); }
            asm volatile("" ::: "memory");
        }
#pragma unroll
        for (int ii = 0; ii < 16; ++ii) {
            const int i = 16 * ip + ii; const float bb = bloc[ii] + off;
            float qv = bf2f(R.qraw[ii]), kv = bf2f(R.kraw[ii]);
            if (lat) {
                const float cs = rcs[ii], sn = rsn[ii];
                const float qo = qpart[ii], ko = kpart[ii];
                qv = qv * cs + ((k & 32) ? qo : -qo) * sn; kv = kv * cs + ((k & 32) ? ko : -ko) * sn;
            }
            const float eb = __builtin_amdgcn_exp2f(bb), kt = kv * __builtin_amdgcn_rcpf(eb);
            Qt[i * 136 + k] = (bf16)f2bf(qv * 0.08838834764831845f * eb);
            Kt[i * 136 + k] = (bf16)f2bf(kt);
            kh[ii] = (unsigned short)f2bf(kt * etot);
        }
        u32x4 w0, w1;
        w0.x = kh[0] | ((unsigned)kh[1] << 16); w0.y = kh[2] | ((unsigned)kh[3] << 16); w0.z = kh[4] | ((unsigned)kh[5] << 16); w0.w = kh[6] | ((unsigned)kh[7] << 16);
        w1.x = kh[8] | ((unsigned)kh[9] << 16); w1.y = kh[10] | ((unsigned)kh[11] << 16); w1.z = kh[12] | ((unsigned)kh[13] << 16); w1.w = kh[14] | ((unsigned)kh[15] << 16);
        *(u32x4*)(GK + k * 64 + 16 * ip) = w0; *(u32x4*)(GK + k * 64 + 16 * ip + 8) = w1;
    }
    asm volatile("" ::: "memory");
    pp_load_qk(F, unx, R);
    {
        const int v = tid >> 1, hf = tid & 1; const LAS bf16* sp = VT + v * 72 + 32 * hf; bf16* dp = GV + v * 64 + 32 * hf;
#pragma unroll
        for (int q = 0; q < 4; ++q) *(u32x4*)(dp + 8 * q) = *(const LAS u32x4*)(sp + 8 * q);
    }
    LBAR();
    if (need_out) {
        {
#pragma unroll
            for (int q = 0; q < 2; ++q) { const int p = tid + 512 * q, i = p >> 4, c8 = (p & 15) * 8; *(u32x4*)(GQ + i * 128 + c8) = *(const LAS u32x4*)(Qt + i * 136 + c8); }
        }
        const int ib = w & 3, vh = w >> 2;
        bf16x8 qf[4];
#pragma unroll
        for (int ks = 0; ks < 4; ++ks) qf[ks] = *(const LAS bf16x8*)(Qt + (16 * ib + c15) * 136 + 32 * ks + 8 * g);
        f32x4 at[4];
#pragma unroll
        for (int jb = 0; jb < 4; ++jb) { at[jb] = (f32x4){0.f, 0.f, 0.f, 0.f};
#pragma unroll
            for (int ks = 0; ks < 4; ++ks) { const bf16x8 a = *(const LAS bf16x8*)(Kt + (16 * jb + c15) * 136 + 32 * ks + 8 * g); at[jb] = MFMA16(a, qf[ks], at[jb]); }
#pragma unroll
            for (int rg = 0; rg < 4; ++rg) if (16 * jb + 4 * g + rg > 16 * ib + c15) at[jb][rg] = 0.f; }
        bf16x8 pf[2];
#pragma unroll
        for (int k2 = 0; k2 < 2; ++k2) { u32x4 t; t.x = pk2(at[2 * k2][0], at[2 * k2][1]); t.y = pk2(at[2 * k2][2], at[2 * k2][3]); t.z = pk2(at[2 * k2 + 1][0], at[2 * k2 + 1][1]); t.w = pk2(at[2 * k2 + 1][2], at[2 * k2 + 1][3]); pf[k2] = __builtin_bit_cast(bf16x8, t); }
        bf16* op = W_OB(F) + ((size_t)dir * NROW + rowbase + GLA_POS(16 * ib + c15)) * (HB * DVB) + h * 256 + 4 * g;
#pragma unroll
        for (int vt = 0; vt < 8; ++vt) { const int vtile = 8 * vh + vt; f32x4 o = (f32x4){0.f, 0.f, 0.f, 0.f};
#pragma unroll
            for (int k2 = 0; k2 < 2; ++k2) { const LAS bf16* vp = VT + (16 * vtile + c15) * 72 + 32 * k2 + 4 * g; o = MFMA16(mk8(*(const LAS u32x2*)vp, *(const LAS u32x2*)(vp + 16)), pf[k2], o); }
            u32x2 ov; ov.x = pk2(o[0], o[1]); ov.y = pk2(o[2], o[3]);
            *(u32x2*)(op + 16 * vtile) = ov; }
    }
    LBAR();
}
struct ChRegs { u32x4 rq[2], rk[2], rv; u32x2 oi[2]; };
__device__ __forceinline__ void gla_chain(Frame& F, int l, int ch, bool dry) {
    const int b = ch >> 5, h = (ch >> 3) & 3, dir = (ch >> 2) & 1, vs = ch & 3;
    const int tid = F.tid, lane = F.lane, w = F.wave, c15 = lane & 15, g = lane >> 4;
    LAS unsigned char* L = F.lds;
    constexpr int BUFB = 45056;
    LAS float* DKall = (LAS float*)(L + 2 * BUFB + 2 * 17408);
    LAS unsigned char* PART = L + 2 * BUFB;
    const int un0 = (((b * 4 + h) * 2) + dir) * 36;
    const bf16* GQ = (const bf16*)(F.ws + WS_GQ) + (size_t)un0 * 8192; const bf16* GK = (const bf16*)(F.ws + WS_GK) + (size_t)un0 * 8192;
    const bf16* GV = (const bf16*)(F.ws + WS_GV) + (size_t)un0 * 16384 + (size_t)vs * 4096; const float* GD = (const float*)(F.ws + WS_GD) + (size_t)un0 * 128;
    const int vt4 = w & 3, kq = w >> 2;
    bf16* OBd = W_OB(F) + (size_t)dir * NROW * (HB * DVB) + h * 256 + vs * 64 + 16 * vt4 + 4 * g;
    bf16* OBs = dry ? (bf16*)(F.ws + WS_DUMMY) + (size_t)dir * NROW * (HB * DVB) + h * 256 + vs * 64 + 16 * vt4 + 4 * g : OBd;
    f32x4 sacc[4];
#pragma unroll
    for (int t = 0; t < 4; ++t) sacc[t] = (f32x4){0.f, 0.f, 0.f, 0.f};
    for (int i = tid; i < 36 * 128; i += NTHR) DKall[i] = GD[i];
#define CH_OROW(c, it) (((c) >= 4 ? b * SEQ : NLAT + b * CTXL) + (dir ? (((c) >= 4 ? SEQ : CTXL) - 1 - (64 * ((c) >= 4 ? (c) - 4 : (c)) + 16 * (it) + c15)) : (64 * ((c) >= 4 ? (c) - 4 : (c)) + 16 * (it) + c15)))
#define CH_LOAD(R, c) do { const bool no_ = (c) >= 4 || l == 0; \
        _Pragma("unroll") for (int q_ = 0; q_ < 2; ++q_) { const int p_ = tid + 512 * q_; if (no_) R.rq[q_] = *(const u32x4*)(GQ + (size_t)(c) * 8192 + p_ * 8); R.rk[q_] = *(const u32x4*)(GK + (size_t)(c) * 8192 + p_ * 8); } \
        R.rv = *(const u32x4*)(GV + (size_t)(c) * 16384 + tid * 8); \
        if (no_) { R.oi[0] = *(const u32x2*)(OBd + (size_t)CH_OROW(c, 2 * kq) * (HB * DVB)); R.oi[1] = *(const u32x2*)(OBd + (size_t)CH_OROW(c, 2 * kq + 1) * (HB * DVB)); } } while (0)
#define CH_PUT(R, bs) do { LAS unsigned char* B_ = L + (bs) * BUFB; \
        _Pragma("unroll") for (int q_ = 0; q_ < 2; ++q_) { const int p_ = tid + 512 * q_; *(LAS u32x4*)((LAS bf16*)B_ + (p_ >> 4) * 136 + (p_ & 15) * 8) = R.rq[q_]; *(LAS u32x4*)((LAS bf16*)(B_ + 17408) + (p_ >> 3) * 72 + (p_ & 7) * 8) = R.rk[q_]; } \
        *(LAS u32x4*)((LAS bf16*)(B_ + 35840) + (tid >> 3) * 72 + (tid & 7) * 8) = R.rv; } while (0)
#define CH_FIN(cp, par) do { \
        const f32x4 pp0_ = *(const LAS f32x4*)(PART + (par) * 16384 + ((w ^ 4) * 2 + 0) * 1024 + lane * 16), pp1_ = *(const LAS f32x4*)(PART + (par) * 16384 + ((w ^ 4) * 2 + 1) * 1024 + lane * 16); \
        { const f32x4 o = pown[0] + pp0_; u32x2 ov; ov.x = pk2(o[0] + bflo(poi[0].x), o[1] + bfhi(poi[0].x)); ov.y = pk2(o[2] + bflo(poi[0].y), o[3] + bfhi(poi[0].y)); *(u32x2*)(OBs + (size_t)CH_OROW(cp, 2 * kq) * (HB * DVB)) = ov; } \
        { const f32x4 o = pown[1] + pp1_; u32x2 ov; ov.x = pk2(o[0] + bflo(poi[1].x), o[1] + bfhi(poi[1].x)); ov.y = pk2(o[2] + bflo(poi[1].y), o[3] + bfhi(poi[1].y)); *(u32x2*)(OBs + (size_t)CH_OROW(cp, 2 * kq + 1) * (HB * DVB)) = ov; } } while (0)
#define CH_STEP(cidx, RC, RN) do { \
        const bool need_out_ = (cidx) >= 4 || l == 0; const int bs_ = (cidx) & 1; \
        LAS unsigned char* B = L + bs_ * BUFB; \
        const LAS bf16* Qt = (const LAS bf16*)B; const LAS bf16* KhT = (const LAS bf16*)(B + 17408); const LAS bf16* VTs = (const LAS bf16*)(B + 35840); const LAS float* Dk = DKall + (cidx) * 128; \
        if (pend) CH_FIN((cidx) - 1, bs_ ^ 1);                                \
        const u32x2 oi0_ = RC.oi[0], oi1_ = RC.oi[1];                       \
        if ((cidx) + 2 < 36) CH_LOAD(RC, (cidx) + 2);                         \
        if (need_out_) {                                                      \
            bf16x8 sop[2], qop[4][2]; \
            _Pragma("unroll") for (int k2 = 0; k2 < 2; ++k2) { u32x4 t_; t_.x = pk2(sacc[2 * k2][0], sacc[2 * k2][1]); t_.y = pk2(sacc[2 * k2][2], sacc[2 * k2][3]); t_.z = pk2(sacc[2 * k2 + 1][0], sacc[2 * k2 + 1][1]); t_.w = pk2(sacc[2 * k2 + 1][2], sacc[2 * k2 + 1][3]); sop[k2] = __builtin_bit_cast(bf16x8, t_); } \
            _Pragma("unroll") for (int x4 = 0; x4 < 4; ++x4) { const int it_ = (x4 < 2) ? 2 * kq + x4 : 2 * (1 - kq) + (x4 - 2);     \
                _Pragma("unroll") for (int k2 = 0; k2 < 2; ++k2) { const LAS bf16* qp_ = Qt + (16 * it_ + c15) * 136 + 16 * (4 * kq + 2 * k2) + 4 * g; qop[x4][k2] = mk8(*(const LAS u32x2*)qp_, *(const LAS u32x2*)(qp_ + 16)); } } \
            asm volatile("" ::: "memory"); \
            f32x4 pa_[4]; \
            _Pragma("unroll") for (int x4 = 0; x4 < 4; ++x4) { pa_[x4] = MFMA16(sop[0], qop[x4][0], ((f32x4){0.f, 0.f, 0.f, 0.f})); pa_[x4] = MFMA16(sop[1], qop[x4][1], pa_[x4]); } \
            pown[0] = pa_[0]; pown[1] = pa_[1]; \
            *(LAS f32x4*)(PART + bs_ * 16384 + (w * 2 + 0) * 1024 + lane * 16) = pa_[2]; *(LAS f32x4*)(PART + bs_ * 16384 + (w * 2 + 1) * 1024 + lane * 16) = pa_[3]; \
        } \
        poi[0] = oi0_; poi[1] = oi1_; pend = need_out_; \
        { bf16x8 va[2], kb[4][2]; f32x4 dk[4]; \
        _Pragma("unroll") for (int k2 = 0; k2 < 2; ++k2) va[k2] = *(const LAS bf16x8*)(VTs + (16 * vt4 + c15) * 72 + 32 * k2 + 8 * g); \
        _Pragma("unroll") for (int t4 = 0; t4 < 4; ++t4) { dk[t4] = *(const LAS f32x4*)(Dk + 16 * (4 * kq + t4) + 4 * g); _Pragma("unroll") for (int k2 = 0; k2 < 2; ++k2) kb[t4][k2] = *(const LAS bf16x8*)(KhT + (16 * (4 * kq + t4) + c15) * 72 + 32 * k2 + 8 * g); } \
        asm volatile("" ::: "memory"); \
        _Pragma("unroll") for (int t4 = 0; t4 < 4; ++t4) { \
            sacc[t4] = sacc[t4] * dk[t4]; \
            _Pragma("unroll") for (int k2 = 0; k2 < 2; ++k2) sacc[t4] = MFMA16(kb[t4][k2], va[k2], sacc[t4]); } } \
        if ((cidx) + 1 < 36) CH_PUT(RN, bs_ ^ 1);                             \
        LBAR(); \
    } while (0)
    ChRegs RA, RB;
    RA.rq[0] = RA.rq[1] = RB.rq[0] = RB.rq[1] = (u32x4){0u, 0u, 0u, 0u}; RA.oi[0] = RA.oi[1] = RB.oi[0] = RB.oi[1] = (u32x2){0u, 0u};
    f32x4 pown[2]; u32x2 poi[2]; bool pend = false;
    pown[0] = pown[1] = (f32x4){0.f, 0.f, 0.f, 0.f}; poi[0] = poi[1] = (u32x2){0u, 0u};
    CH_LOAD(RA, 0); CH_PUT(RA, 0); CH_LOAD(RB, 1);
    LBAR();
    for (int c2 = 0; c2 < 36; c2 += 2) {
        CH_STEP(c2, RA, RB);
        CH_STEP(c2 + 1, RB, RA);
    }
    if (pend) CH_FIN(35, 1);
#undef CH_LOAD
#undef CH_PUT
#undef CH_FIN
#undef CH_STEP
#undef CH_OROW
}
#undef GLA_POS

__device__ __forceinline__ int clampi(int v, int lo, int hi) { return v < lo ? lo : (v > hi ? hi : v); }
template <int NB, bool LOCAL>
__device__ __forceinline__ void attn_tile(const LAS bf16* Kt, const LAS bf16* Vt, const LAS float* bias_row, const bf16x8 (&qf)[2], int kb0, const int (&dco)[8], int c15, int g, float& m_run, float& l_run, f32x4 (&oacc)[4]) {
    f32x4 sc[NB];
    {
        bf16x8 kf[NB][2]; float bv[NB][4];
#pragma unroll
        for (int nb = 0; nb < NB; ++nb) {
#pragma unroll
            for (int s = 0; s < 2; ++s) kf[nb][s] = *(const LAS bf16x8*)(Kt + (kb0 + 16 * nb + c15) * 72 + 32 * s + 8 * g);
            if (LOCAL) {
#pragma unroll
                for (int rg = 0; rg < 4; ++rg) bv[nb][rg] = bias_row[dco[(4 * nb + rg) & 7]]; } }
        asm volatile("" ::: "memory");
#pragma unroll
        for (int nb = 0; nb < NB; ++nb) { sc[nb] = (f32x4){0.f, 0.f, 0.f, 0.f};
#pragma unroll
            for (int s = 0; s < 2; ++s) sc[nb] = MFMA16(kf[nb][s], qf[s], sc[nb]);
#pragma unroll
            for (int rg = 0; rg < 4; ++rg) sc[nb][rg] = sc[nb][rg] * 0.18033688011112042f + (LOCAL ? bv[nb][rg] : 0.f); }
    }
    float mt = -1e30f;
#pragma unroll
    for (int nb = 0; nb < NB; ++nb)
#pragma unroll
        for (int rg = 0; rg < 4; ++rg) mt = fmaxf(mt, sc[nb][rg]);
    mt = fmaxf(mt, __shfl_xor(mt, 16)); mt = fmaxf(mt, __shfl_xor(mt, 32));
    const float m_new = fmaxf(m_run, mt), alpha = __builtin_amdgcn_exp2f(m_run - m_new);
    m_run = m_new; float ps = 0.f;
#pragma unroll
    for (int nb = 0; nb < NB; ++nb)
#pragma unroll
        for (int rg = 0; rg < 4; ++rg) { const float p = __builtin_amdgcn_exp2f(sc[nb][rg] - m_new); sc[nb][rg] = p; ps += p; }
    l_run = l_run * alpha + ps;
    bf16x8 pf[NB / 2];
#pragma unroll
    for (int k2 = 0; k2 < NB / 2; ++k2) { u32x4 tt; tt.x = pk2(sc[2 * k2][0], sc[2 * k2][1]); tt.y = pk2(sc[2 * k2][2], sc[2 * k2][3]); tt.z = pk2(sc[2 * k2 + 1][0], sc[2 * k2 + 1][1]); tt.w = pk2(sc[2 * k2 + 1][2], sc[2 * k2 + 1][3]); pf[k2] = __builtin_bit_cast(bf16x8, tt); }
    {
        bf16x8 vf[4][NB / 2];
#pragma unroll
        for (int d = 0; d < 4; ++d)
#pragma unroll
            for (int k2 = 0; k2 < NB / 2; ++k2) { const LAS bf16* vp = Vt + (16 * d + c15) * 72 + kb0 + 32 * k2 + 4 * g; vf[d][k2] = mk8(*(const LAS u32x2*)vp, *(const LAS u32x2*)(vp + 16)); }
        asm volatile("" ::: "memory");
#pragma unroll
        for (int d = 0; d < 4; ++d) { oacc[d] = oacc[d] * alpha;
#pragma unroll
            for (int k2 = 0; k2 < NB / 2; ++k2) oacc[d] = MFMA16(vf[d][k2], pf[k2], oacc[d]); }
    }
}
__device__ __forceinline__ void attn_unit(Frame& F, int l, int u) {
    const int tid = F.tid, lane = F.lane, w = F.wave, c15 = lane & 15, g = lane >> 4;
    LAS unsigned char* L = F.lds;
    LAS bf16* Ks = (LAS bf16*)L;
    LAS bf16* VTs = (LAS bf16*)(L + 18432);
    LAS float* rpbs = (LAS float*)(L + 36864);
    const bool isctx = u >= 1024;
    int b, h, r0 = 0, qb = 0;
    if (!isctx) { b = u >> 7; h = (u >> 4) & 7; r0 = (u & 15) * 2; } else { const int cu = u - 1024; b = cu >> 4; h = (cu >> 1) & 7; qb = cu & 1; }
    const int r = r0 + (w >> 2), cq = 16 * (w & 3) + c15;
    const int qrow = isctx ? NLAT + b * CTXL + qb * 128 + 16 * w + c15 : b * SEQ + r * 64 + cq;
    bf16x8 qf[2];
#pragma unroll
    for (int s = 0; s < 2; ++s) qf[s] = *(const bf16x8*)(W_U(F) + (size_t)qrow * NU + U_QA + h * 64 + 32 * s + 8 * g);
    int lo = 0, nloc = 0, rs = 0;
    if (!isctx) { lo = clampi(r0 - 4, 0, 24); nloc = clampi(r0 - 3, 0, 24) + 8 - lo; rs = clampi(r - 4, 0, 24); }
    const int ntiles = nloc + 4, cs0 = clampi(cq - 8, 0, 48), kb0 = clampi(16 * (w & 3) - 8, 0, 32);
    if (!isctx) for (int i = tid; i < 15 * 32; i += NTHR) { const int rr = i >> 5, cc2 = i & 31; rpbs[i] = cc2 < 31 ? F.rpb[((size_t)l * HA + h) * 465 + rr * 31 + cc2] * 1.4426950408889634f : -1e30f; }
    int dco[8];
#pragma unroll
    for (int e8 = 0; e8 < 8; ++e8) { const int ck = kb0 + 16 * (e8 >> 2) + 4 * g + (e8 & 3); dco[e8] = (ck >= cs0 && ck < cs0 + 16) ? clampi(ck - cq + 15, 0, 30) : 31; }
    const int key = tid >> 3, ch8 = (tid & 7) * 8;
#define ATT_ROW(t) ((t) < nloc ? b * SEQ + (lo + (t)) * 64 + key : NLAT + b * CTXL + ((t) - nloc) * 64 + key)
#define ATT_PUT(KR, VR, buf) do { *(LAS u32x4*)(Ks + (buf) * 4608 + key * 72 + ch8) = KR; LAS bf16* vp_ = VTs + (buf) * 4608 + ch8 * 72 + key; \
        vp_[0] = (bf16)(VR.x & 0xffffu); vp_[72] = (bf16)(VR.x >> 16); vp_[144] = (bf16)(VR.y & 0xffffu); vp_[216] = (bf16)(VR.y >> 16); \
        vp_[288] = (bf16)(VR.z & 0xffffu); vp_[360] = (bf16)(VR.z >> 16); vp_[432] = (bf16)(VR.w & 0xffffu); vp_[504] = (bf16)(VR.w >> 16); } while (0)
#define ATT_LD(KR, VR, t) do { if ((t) < ntiles) { const bf16* rp_ = W_U(F) + (size_t)ATT_ROW(t) * NU + h * 64 + ch8; KR = *(const u32x4*)(rp_ + U_KA); VR = *(const u32x4*)(rp_ + U_VA); } } while (0)
#define ATT_STEP(t, KN, VN) do { if ((t) < ntiles) { const int buf = (t) & 1; const bool local = (t) < nloc; const int kr = lo + (t); \
        const bool active = !local || (kr >= rs && kr <= rs + 7); \
        if (active) { \
            if (local) attn_tile<2, true>(Ks + buf * 4608, VTs + buf * 4608, rpbs + (kr - r + 7) * 32, qf, kb0, dco, c15, g, m_run, l_run, oacc); \
            else attn_tile<4, false>(Ks + buf * 4608, VTs + buf * 4608, rpbs, qf, 0, dco, c15, g, m_run, l_run, oacc); \
        } \
        if ((t) + 1 < ntiles) ATT_PUT(KN, VN, buf ^ 1); \
        ATT_LD(KN, VN, (t) + 4); \
        LBAR(); } } while (0)
    u32x4 k0 = (u32x4){0u, 0u, 0u, 0u}, v0 = k0, k1 = k0, v1 = k0, k2 = k0, v2 = k0;
    ATT_LD(k0, v0, 0);
    ATT_PUT(k0, v0, 0);
    ATT_LD(k1, v1, 1); ATT_LD(k2, v2, 2); ATT_LD(k0, v0, 3);
    LBAR();
    float m_run = -1e30f, l_run = 0.f;
    f32x4 oacc[4];
#pragma unroll
    for (int d = 0; d < 4; ++d) oacc[d] = (f32x4){0.f, 0.f, 0.f, 0.f};
    for (int t3 = 0; t3 < ntiles; t3 += 3) {
        ATT_STEP(t3, k1, v1);
        ATT_STEP(t3 + 1, k2, v2);
        ATT_STEP(t3 + 2, k0, v0);
    }
#undef ATT_LD
#undef ATT_STEP
    float lt = l_run; lt += __shfl_xor(lt, 16); lt += __shfl_xor(lt, 32);
    const float inv = 1.0f / lt;
#pragma unroll
    for (int d = 0; d < 4; ++d) { u32x2 ov; ov.x = pk2(oacc[d][0] * inv, oacc[d][1] * inv); ov.y = pk2(oacc[d][2] * inv, oacc[d][3] * inv);
        *(u32x2*)(W_MIX(F) + (size_t)qrow * D + MIX_A + h * 64 + 16 * d + 4 * g) = ov; }
#undef ATT_ROW
#undef ATT_PUT
}

__device__ __forceinline__ void gmlp_unit(Frame& F, int l, int u) {
    const int tid = F.tid, lane = F.lane, w = F.wave, c15 = lane & 15, g = lane >> 4;
    LAS bf16* Wl = (LAS bf16*)F.lds;
    LAS bf16* VTl = (LAS bf16*)(F.lds + 34816);
    int rowbase, gg;
    if (u < 512) { const int b = u >> 6, n = (u >> 2) & 15; gg = u & 3; rowbase = b * SEQ + n * MIXC; } else { const int cu = u - 512, b = cu >> 3, n = (cu >> 2) & 1; gg = cu & 3; rowbase = NLAT + b * CTXL + n * MIXC; }
    {
        const int p = tid >> 2, q0 = (tid & 3) * 32; const float* wp = F.w_sp + (((size_t)l * GC + gg) * MIXC + p) * MIXC + q0;
#pragma unroll
        for (int j = 0; j < 4; ++j) { const f32x4 a = *(const f32x4*)(wp + 8 * j), b2 = *(const f32x4*)(wp + 8 * j + 4); u32x4 o; o.x = pk2(a[0], a[1]); o.y = pk2(a[2], a[3]); o.z = pk2(b2[0], b2[1]); o.w = pk2(b2[2], b2[3]); *(LAS u32x4*)(Wl + p * 136 + q0 + 8 * j) = o; }
    }
    {
        const int pos = tid >> 2, c0 = (tid & 3) * 32; const bf16* vp = W_U(F) + (size_t)(rowbase + pos) * NU + U_VC + gg * CG + c0;
        float xv[32];
#pragma unroll
        for (int j = 0; j < 4; ++j) { const u32x4 a = *(const u32x4*)(vp + 8 * j);
            xv[8 * j + 0] = gelu_tanh(bflo(a.x)); xv[8 * j + 1] = gelu_tanh(bfhi(a.x)); xv[8 * j + 2] = gelu_tanh(bflo(a.y)); xv[8 * j + 3] = gelu_tanh(bfhi(a.y));
            xv[8 * j + 4] = gelu_tanh(bflo(a.z)); xv[8 * j + 5] = gelu_tanh(bfhi(a.z)); xv[8 * j + 6] = gelu_tanh(bflo(a.w)); xv[8 * j + 7] = gelu_tanh(bfhi(a.w)); }
        float s = 0.f;
#pragma unroll
        for (int i = 0; i < 32; ++i) s += xv[i];
        s += __shfl_xor(s, 1); s += __shfl_xor(s, 2);
        const float mu = s * (1.0f / CG); float q = 0.f;
#pragma unroll
        for (int i = 0; i < 32; ++i) { const float d = xv[i] - mu; q += d * d; }
        q += __shfl_xor(q, 1); q += __shfl_xor(q, 2);
        const float rstd = 1.0f / sqrtf(q * (1.0f / CG) + EPS);
        const float* lg = F.ln_v_g + (size_t)l * (GC * CG) + gg * CG + c0; const float* lb = F.ln_v_b + (size_t)l * (GC * CG) + gg * CG + c0;
#pragma unroll
        for (int i = 0; i < 32; ++i) VTl[(c0 + i) * 136 + pos] = (bf16)f2bf((xv[i] - mu) * rstd * lg[i] + lb[i]);
    }
    __syncthreads();
    {
        const int pos = 16 * w + c15, row = rowbase + pos;
        const float bsp = F.b_sp[((size_t)l * GC + gg) * MIXC + pos];
        bf16x8 wf[4];
#pragma unroll
        for (int ks = 0; ks < 4; ++ks) wf[ks] = *(const LAS bf16x8*)(Wl + pos * 136 + 32 * ks + 8 * g);
        u32x2 uu8[8];
#pragma unroll
        for (int cb = 0; cb < 8; ++cb) uu8[cb] = *(const u32x2*)(W_U(F) + (size_t)row * NU + U_UC + gg * CG + 16 * cb + 4 * g);
#pragma unroll
        for (int cb = 0; cb < 8; ++cb) { f32x4 acc = (f32x4){0.f, 0.f, 0.f, 0.f};
#pragma unroll
            for (int ks = 0; ks < 4; ++ks) { const bf16x8 a = *(const LAS bf16x8*)(VTl + (16 * cb + c15) * 136 + 32 * ks + 8 * g); acc = MFMA16(a, wf[ks], acc); }
            const int col = gg * CG + 16 * cb + 4 * g;
            const u32x2 uu = uu8[cb];
            u32x2 ov; ov.x = pk2(gelu_tanh(bflo(uu.x)) * (acc[0] + bsp), gelu_tanh(bfhi(uu.x)) * (acc[1] + bsp)); ov.y = pk2(gelu_tanh(bflo(uu.y)) * (acc[2] + bsp), gelu_tanh(bfhi(uu.y)) * (acc[3] + bsp));
            *(u32x2*)(W_MIX(F) + (size_t)row * D + MIX_C + col) = ov; }
    }
    __syncthreads();
}

#ifndef MK_REPMIX
#define MK_REPMIX 0u
#endif
__device__ __forceinline__ void p_mixers(Frame& F, int l) {
    for (int rep = 0; rep < 1 + (int)(MK_REPMIX & 1u); ++rep) { PpRegs R; int un = F.vcu; if (un < 2304) { pp_load_v(F, un, R); pp_load_w(F, l, un, R); pp_load_qk(F, un, R); } for (; un < 2304; un += F.G) { launder(F); gla_prepass(F, l, un, (un + F.G < 2304) ? un + F.G : un, R); } }
    const int na = (l == 0) ? 1152 : 1024, nc = (l == 0) ? 576 : 512;
    for (int rep = 0; rep < 1 + (int)((MK_REPMIX >> 1) & 1u); ++rep) { for (int u = F.vcu; u < na; u += F.G) attn_unit(F, l, u); }
    __syncthreads();
    for (int rep = 0; rep < 1 + (int)((MK_REPMIX >> 2) & 1u); ++rep) { for (int u = (F.vcu + F.G / 2) % F.G; u < nc; u += F.G) gmlp_unit(F, l, u); }
}
__device__ __forceinline__ void p_chains(Frame& F, int l) {
    for (int rep = 0; rep < 1 + (int)((MK_REPMIX >> 3) & 1u); ++rep) for (int ch = F.vcu; ch < 256; ch += F.G) { gla_chain(F, l, ch, rep + 1 < 1 + (int)((MK_REPMIX >> 3) & 1u)); __syncthreads(); }
}

__device__ __forceinline__ void p_glaout(Frame& F, int l) {
    const int gw = F.vcu * NWAVES + F.wave, NGW = F.G * NWAVES, lane = F.lane, nrows = (l == 0) ? NROW : NLAT;
    for (int row = gw; row < nrows; row += NGW) {
#pragma unroll
        for (int j = 0; j < 2; ++j) { const int idx = 512 * j + 8 * lane;
            const u32x4 a = __builtin_nontemporal_load((const u32x4*)(W_OB(F) + (size_t)row * 1024 + idx)), b2 = __builtin_nontemporal_load((const u32x4*)(W_OB(F) + ((size_t)NROW + row) * 1024 + idx));
            float o[8]; o[0] = bflo(a.x) + bflo(b2.x); o[1] = bfhi(a.x) + bfhi(b2.x); o[2] = bflo(a.y) + bflo(b2.y); o[3] = bfhi(a.y) + bfhi(b2.y); o[4] = bflo(a.z) + bflo(b2.z); o[5] = bfhi(a.z) + bfhi(b2.z); o[6] = bflo(a.w) + bflo(b2.w); o[7] = bfhi(a.w) + bfhi(b2.w);
            float ss = 0.f;
#pragma unroll
            for (int e = 0; e < 8; ++e) ss += o[e] * o[e];
#pragma unroll
            for (int s = 1; s < 32; s <<= 1) ss += __shfl_xor(ss, s);
            const float rn = 1.0f / sqrtf(ss * (1.0f / DVB) + EPS);
            const float* gp = F.g_gla + (size_t)l * 1024 + idx; const f32x4 g0 = *(const f32x4*)gp, g1 = *(const f32x4*)(gp + 4);
            const u32x4 gb = __builtin_nontemporal_load((const u32x4*)(W_U(F) + (size_t)row * NU + U_GB + idx));
            float r8[8];
            r8[0] = o[0] * rn * g0[0] * silu_f(bflo(gb.x)); r8[1] = o[1] * rn * g0[1] * silu_f(bfhi(gb.x)); r8[2] = o[2] * rn * g0[2] * silu_f(bflo(gb.y)); r8[3] = o[3] * rn * g0[3] * silu_f(bfhi(gb.y));
            r8[4] = o[4] * rn * g1[0] * silu_f(bflo(gb.z)); r8[5] = o[5] * rn * g1[1] * silu_f(bfhi(gb.z)); r8[6] = o[6] * rn * g1[2] * silu_f(bflo(gb.w)); r8[7] = o[7] * rn * g1[3] * silu_f(bfhi(gb.w));
            u32x4 ov; ov.x = pk2(r8[0], r8[1]); ov.y = pk2(r8[2], r8[3]); ov.z = pk2(r8[4], r8[5]); ov.w = pk2(r8[6], r8[7]);
            *(u32x4*)(W_MIX(F) + (size_t)row * D + MIX_B + idx) = ov; }
    }
}

struct PmRow { u32x4 y[4]; f32x4 x[8]; };
__device__ __forceinline__ void unpack8(const u32x4 a, float* o) { o[0] = bflo(a.x); o[1] = bfhi(a.x); o[2] = bflo(a.y); o[3] = bfhi(a.y); o[4] = bflo(a.z); o[5] = bfhi(a.z); o[6] = bflo(a.w); o[7] = bfhi(a.w); }
__device__ __forceinline__ void postmix_load_y(Frame& F, int row, PmRow& R) {
    const bf16* yp = W_Y(F) + (size_t)row * D + 8 * F.lane;
#pragma unroll
    for (int j = 0; j < 4; ++j) R.y[j] = __builtin_nontemporal_load((const u32x4*)(yp + 512 * j));
}
template <bool FIRST> __device__ __forceinline__ void postmix_load_x(Frame& F, int row, PmRow& R) {
    const int lane = F.lane;
    if constexpr (FIRST) { const float* xin = (row < NLAT ? F.x + (size_t)row * D : F.ctx + (size_t)(row - NLAT) * D) + 8 * lane;
#pragma unroll
        for (int j = 0; j < 4; ++j) { R.x[2 * j] = __builtin_nontemporal_load((const f32x4*)(xin + 512 * j)); R.x[2 * j + 1] = __builtin_nontemporal_load((const f32x4*)(xin + 512 * j + 4)); } }
    else { const bf16* xb = W_XB(F) + (size_t)row * D + 8 * lane;
#pragma unroll
        for (int j = 0; j < 4; ++j) R.x[j] = __builtin_bit_cast(f32x4, __builtin_nontemporal_load((const u32x4*)(xb + 512 * j))); }
}
template <bool FIRST> __device__ __forceinline__ void postmix_s1(Frame& F, int l, int row, const PmRow& R, const u32x4 (&c0p)[4], float (&xv)[32], bool dry) {
    const int lane = F.lane;
    float ss = 0.f;
#pragma unroll
    for (int j = 0; j < 4; ++j) { float y8[8]; unpack8(R.y[j], y8);
#pragma unroll
        for (int e = 0; e < 8; ++e) ss += y8[e] * y8[e]; }
    const float r1 = 1.0f / sqrtf(wave_sum(ss) * (1.0f / D) + EPS);
    bf16* xdst = dry ? (bf16*)(F.ws + WS_DUMMY) + (size_t)row * D : W_XB(F) + (size_t)row * D;
#pragma unroll
    for (int j = 0; j < 4; ++j) { float y8[8], c8[8], x8[8]; unpack8(R.y[j], y8); unpack8(c0p[j], c8);
        if constexpr (FIRST) { x8[0] = R.x[2 * j][0]; x8[1] = R.x[2 * j][1]; x8[2] = R.x[2 * j][2]; x8[3] = R.x[2 * j][3]; x8[4] = R.x[2 * j + 1][0]; x8[5] = R.x[2 * j + 1][1]; x8[6] = R.x[2 * j + 1][2]; x8[7] = R.x[2 * j + 1][3]; }
        else unpack8(__builtin_bit_cast(u32x4, R.x[j]), x8);
#pragma unroll
        for (int e = 0; e < 8; ++e) xv[8 * j + e] = x8[e] + c8[e] * (y8[e] * r1); }
    row_store_bf16(xdst, lane, xv);
}
__device__ __forceinline__ void postmix_s2(Frame& F, int row, const u32x4 (&c1p)[4], const u32x4 (&c2p)[4], float (&xv)[32]) {
    const int lane = F.lane;
    const float r2 = 1.0f / sqrtf(row_sumsq(xv) * (1.0f / D) + EPS);
#pragma unroll
    for (int j = 0; j < 4; ++j) { float c1[8], c2[8]; unpack8(c1p[j], c1); unpack8(c2p[j], c2);
#pragma unroll
        for (int e = 0; e < 8; ++e) xv[8 * j + e] = xv[8 * j + e] * r2 * c1[e] + c2[e]; }
    float am = 0.f;
#pragma unroll
    for (int i = 0; i < 32; ++i) am = fmaxf(am, fabsf(xv[i]));
    am = wave_max(am);
    const float scale = am > 0.f ? am * (1.0f / 127.0f) : 1.0f;
    row_store_i8(W_HQ(F) + (size_t)row * D, lane, xv, 1.0f / scale);
    if (lane == 0) W_HS(F)[row] = scale;
}
template <bool FIRST> __device__ __forceinline__ void p_postmix_t(Frame& F, int l, bool dry) {
    const int gw = F.vcu * NWAVES + F.wave, NGW = F.G * NWAVES, lane = F.lane, nrows = (l == 0) ? NROW : NLAT;
    LAS float* WR = (LAS float*)F.lds;
    for (int i = F.tid; i < D * 4; i += NTHR) { const int k = i >> 2, e4 = (i & 3) * 4; const f32x4 wv = *(const f32x4*)(F.w_router + ((size_t)l * D + k) * NE + e4);
        WR[(e4 + 0) * D + k] = wv[0]; WR[(e4 + 1) * D + k] = wv[1]; WR[(e4 + 2) * D + k] = wv[2]; WR[(e4 + 3) * D + k] = wv[3]; }
    __syncthreads();
    const int npair = nrows / 2, pbase = npair / NGW, prem = npair % NGW;
    const int p0 = gw * pbase + (gw < prem ? gw : prem), p1 = p0 + pbase + (gw < prem ? 1 : 0);
    PmRow RA, RB;
    if (p0 < p1) { postmix_load_y(F, 2 * p0, RA); postmix_load_x<FIRST>(F, 2 * p0, RA); postmix_load_y(F, 2 * p0 + 1, RB); if constexpr (!FIRST) postmix_load_x<FIRST>(F, 2 * p0 + 1, RB); }
    for (int p = p0; p < p1; ++p) {
        launder(F);
        const int row = 2 * p, row2 = row + 1; const bool has2 = true; const int lane = F.lane;
        float h0[32], h1[32];
        {
            const int m0 = row < NLAT ? row / SEQ : 8;
            u32x4 c0p[4], c1p[4], c2p[4]; const bf16* cva = W_CV(F) + ((size_t)l * 9 + m0) * 6 * D + 8 * lane;
#pragma unroll
            for (int j = 0; j < 4; ++j) c0p[j] = *(const u32x4*)(cva + 512 * j);
            if constexpr (FIRST) postmix_load_x<FIRST>(F, row2, RB);
            postmix_s1<FIRST>(F, l, row, RA, c0p, h0, dry);
            asm volatile("" ::: "memory");
#pragma unroll
            for (int j = 0; j < 4; ++j) { c1p[j] = *(const u32x4*)(cva + D + 512 * j); c2p[j] = *(const u32x4*)(cva + 2 * D + 512 * j); }
            postmix_s1<FIRST>(F, l, row2, RB, c0p, h1, dry);
            postmix_s2(F, row, c1p, c2p, h0);
            postmix_s2(F, row2, c1p, c2p, h1);
        }
        asm volatile("" ::: "memory");
        if (p + 1 < p1) { postmix_load_y(F, row + 2, RA); postmix_load_x<FIRST>(F, row + 2, RA); postmix_load_y(F, row + 3, RB); if constexpr (!FIRST) postmix_load_x<FIRST>(F, row + 3, RB); }
        asm volatile("" ::: "memory");
        float a0[16], a1[16];
#pragma unroll
        for (int e = 0; e < 16; ++e) { a0[e] = 0.f; a1[e] = 0.f; }
#pragma unroll
        for (int j = 0; j < 4; ++j) {
#pragma unroll
            for (int e = 0; e < 16; ++e) { const LAS float* wp = WR + e * D + 512 * j + 8 * lane; const f32x4 wa = *(const LAS f32x4*)wp, wb = *(const LAS f32x4*)(wp + 4);
                a0[e] += h0[8 * j] * wa[0] + h0[8 * j + 1] * wa[1] + h0[8 * j + 2] * wa[2] + h0[8 * j + 3] * wa[3] + h0[8 * j + 4] * wb[0] + h0[8 * j + 5] * wb[1] + h0[8 * j + 6] * wb[2] + h0[8 * j + 7] * wb[3];
                a1[e] += h1[8 * j] * wa[0] + h1[8 * j + 1] * wa[1] + h1[8 * j + 2] * wa[2] + h1[8 * j + 3] * wa[3] + h1[8 * j + 4] * wb[0] + h1[8 * j + 5] * wb[1] + h1[8 * j + 6] * wb[2] + h1[8 * j + 7] * wb[3];
                if ((e & 1) == 1) asm volatile("" ::: "memory"); }
        }
        float mx0 = -1e30f, mx1 = -1e30f;
#pragma unroll
        for (int e = 0; e < 16; ++e) { a0[e] = wave_sum(a0[e]); a1[e] = wave_sum(a1[e]); mx0 = fmaxf(mx0, a0[e]); mx1 = fmaxf(mx1, a1[e]); }
        float s0 = 0.f, s1 = 0.f;
#pragma unroll
        for (int e = 0; e < 16; ++e) { a0[e] = __expf(a0[e] - mx0); a1[e] = __expf(a1[e] - mx1); s0 += a0[e]; s1 += a1[e]; }
        float val = 0.f;
#pragma unroll
        for (int e = 0; e < 16; ++e) { if ((lane & 15) == e) val = (lane < 16) ? a0[e] / s0 : a1[e] / s1; }
        if (lane < 16) W_AFF(F)[(size_t)row * NE + lane] = val;
        else if (lane < 32 && has2) W_AFF(F)[(size_t)row2 * NE + (lane & 15)] = val;
    }
}

__device__ __forceinline__ void p_postmix(Frame& F, int l, bool dry) { if (l == 0) p_postmix_t<true>(F, l, dry); else p_postmix_t<false>(F, l, dry); }

__device__ __forceinline__ int block_excl_scan(int v, LAS int* tmp, int lane, int wave, int& total) {
    int inc = v;
#pragma unroll
    for (int o = 1; o < 64; o <<= 1) { const int t = __shfl_up(inc, o); if (lane >= o) inc += t; }
    if (lane == 63) tmp[wave] = inc;
    __syncthreads();
    int base = 0, tot = 0;
#pragma unroll
    for (int ww = 0; ww < 8; ++ww) { const int t = tmp[ww]; tot += t; if (ww < wave) base += t; }
    __syncthreads();
    total = tot; return base + inc - v;
}
__device__ __forceinline__ void p_topk(Frame& F, int l) {
    const int tid = F.tid, lane = F.lane, wave = F.wave;
    LAS int* hist = (LAS int*)F.lds;
    LAS int* misc = (LAS int*)(F.lds + 1024);
    LAS int* stmp = (LAS int*)(F.lds + 1152);
    LAS int* list = (LAS int*)(F.lds + 2048);
    const int nsets = (l == 0) ? 256 : 128, ME = (l == 0) ? ME0 : ME1;
    for (int s = F.vcu; s < nsets; s += F.G) {
        const bool isctx = s >= 128; const int ss = isctx ? s - 128 : s, b = ss >> 4, e = ss & 15;
        const int n = isctx ? CTXL : SEQ, cap = isctx ? CAPC : CAPL, base = isctx ? NLAT + b * CTXL : b * SEQ, slot0 = isctx ? NB * CAPL + b * CAPC : b * CAPL;
        unsigned bits[4];
#pragma unroll
        for (int c = 0; c < 4; ++c) { const int i = 4 * tid + c; bits[c] = (i < n) ? __builtin_bit_cast(unsigned, W_AFF(F)[(size_t)(base + i) * NE + e]) : 0u; }
        unsigned prefix = 0u; int krem = cap;
        for (int pass = 0; pass < 4; ++pass) {
            const int shift = 24 - 8 * pass;
            if (tid < 256) hist[tid] = 0;
            __syncthreads();
#pragma unroll
            for (int c = 0; c < 4; ++c) { const int i = 4 * tid + c; if (i < n && (pass == 0 || (bits[c] >> (shift + 8)) == prefix)) __hip_atomic_fetch_add(&hist[(bits[c] >> shift) & 255u], 1, __ATOMIC_RELAXED, __HIP_MEMORY_SCOPE_WORKGROUP); }
            __syncthreads();
            if (wave == 0) {
                const int h0 = hist[4 * lane], h1 = hist[4 * lane + 1], h2 = hist[4 * lane + 2], h3 = hist[4 * lane + 3];
                const int tot = h0 + h1 + h2 + h3; int suf = tot;
#pragma unroll
                for (int o = 1; o < 64; o <<= 1) { const int t = __shfl_down(suf, o); if (lane + o < 64) suf += t; }
                const int above = suf - tot;
                if (above < krem && krem <= suf) {
                    int a = above, bin, cnt_above;
                    if (a + h3 >= krem) { bin = 3; cnt_above = a; } else { a += h3;
                        if (a + h2 >= krem) { bin = 2; cnt_above = a; } else { a += h2;
                            if (a + h1 >= krem) { bin = 1; cnt_above = a; } else { a += h1; bin = 0; cnt_above = a; } } }
                    misc[0] = 4 * lane + bin; misc[1] = cnt_above;
                }
            }
            __syncthreads();
            prefix = (prefix << 8) | (unsigned)misc[0]; krem -= misc[1];
            __syncthreads();
        }
        int neq = 0;
#pragma unroll
        for (int c = 0; c < 4; ++c) { const int i = 4 * tid + c; if (i < n && bits[c] == prefix) ++neq; }
        int tot_eq; int eqr = block_excl_scan(neq, stmp, lane, wave, tot_eq);
        bool sel[4]; int nsel = 0;
#pragma unroll
        for (int c = 0; c < 4; ++c) { const int i = 4 * tid + c; bool s2 = false; if (i < n) { if (bits[c] > prefix) s2 = true; else if (bits[c] == prefix) { s2 = eqr < krem; ++eqr; } } sel[c] = s2; nsel += s2 ? 1 : 0; }
        int tot_sel; int slot = block_excl_scan(nsel, stmp, lane, wave, tot_sel);
#pragma unroll
        for (int c = 0; c < 4; ++c) { const int i = 4 * tid + c; if (i < n) { int v = -1; if (sel[c]) { if (slot < cap) { list[slot] = i; v = slot0 + slot; } ++slot; } W_TSLOT(F)[(size_t)(base + i) * NE + e] = v; } }
        __syncthreads();
        for (int sl0 = wave; sl0 < cap; sl0 += 4 * NWAVES) {
            u32x4 cr[4][2]; float cs4[4]; int tk[4];
#pragma unroll
            for (int j = 0; j < 4; ++j) { tk[j] = list[sl0 + j * NWAVES]; const signed char* src = W_HQ(F) + (size_t)(base + tk[j]) * D; cr[j][0] = *(const u32x4*)(src + 16 * lane); cr[j][1] = *(const u32x4*)(src + 1024 + 16 * lane); cs4[j] = W_HS(F)[base + tk[j]]; }
#pragma unroll
            for (int j = 0; j < 4; ++j) { const int sl = sl0 + j * NWAVES; signed char* dst = W_XSQ(F) + ((size_t)e * ME + slot0 + sl) * D; *(u32x4*)(dst + 16 * lane) = cr[j][0]; *(u32x4*)(dst + 1024 + 16 * lane) = cr[j][1];
                if (lane == 0) W_XSS(F)[(size_t)e * ME + slot0 + sl] = cs4[j]; }
        }
        __syncthreads();
    }
}

__device__ __forceinline__ void p_actq(Frame& F, int l) {
    const int gw = F.vcu * NWAVES + F.wave, NGW = F.G * NWAVES, lane = F.lane, nrows = NE * ((l == 0) ? ME0 : ME1);
    for (int row = gw; row < nrows; row += 2 * NGW) {
        const int row2 = (row + NGW < nrows) ? row + NGW : row;
        float v[32], v2[32]; row_load_bf16_nt(W_ACT(F) + (size_t)row * FF, lane, v); row_load_bf16_nt(W_ACT(F) + (size_t)row2 * FF, lane, v2);
        const float t1 = W_TM(F)[(size_t)row * 64 + lane], t2 = W_TM(F)[(size_t)row2 * 64 + lane];
        const float am = wave_max(t1), am2 = wave_max(t2);
        const float scale = am > 0.f ? am * (1.0f / 127.0f) : 1.0f, scale2 = am2 > 0.f ? am2 * (1.0f / 127.0f) : 1.0f;
        row_store_i8(W_ACTQ(F) + (size_t)row * FF, lane, v, 1.0f / scale); row_store_i8(W_ACTQ(F) + (size_t)row2 * FF, lane, v2, 1.0f / scale2);
        if (lane == 0) { W_ACTS(F)[row] = scale; W_ACTS(F)[row2] = scale2; }
    }
}

__device__ __forceinline__ void p_combine(Frame& F, int l, bool dry) {
    const int gw = F.vcu * NWAVES + F.wave, NGW = F.G * NWAVES, lane = F.lane, nrows = (l == 0) ? NROW : NLAT, ME = (l == 0) ? ME0 : ME1;
    for (int row = gw; row < nrows; row += NGW) {
        const int m = row < NLAT ? row / SEQ : 8;
        float acc[32];
#pragma unroll
        for (int i = 0; i < 32; ++i) acc[i] = 0.f;
        {
            const int sl16 = (lane < NE) ? W_TSLOT(F)[(size_t)row * NE + lane] : -1; const float gt16 = (lane < NE) ? W_AFF(F)[(size_t)row * NE + lane] : 0.f;
            unsigned long long msk = __ballot(sl16 >= 0);
            while (msk) {
                int ee[4]; int ns = 0;
#pragma unroll
                for (int j = 0; j < 4; ++j) { ee[j] = msk ? (int)__builtin_ctzll(msk) : 0; if (msk) { ++ns; msk &= msk - 1; } }
                u32x4 yr[4][4]; float gg[4];
#pragma unroll
                for (int j = 0; j < 4; ++j) if (j < ns) {
                    const int slot = __builtin_amdgcn_readlane(sl16, ee[j]); gg[j] = __builtin_bit_cast(float, __builtin_amdgcn_readlane(__builtin_bit_cast(int, gt16), ee[j]));
                    const bf16* yp = W_XS(F) + ((size_t)ee[j] * ME + slot) * D + 8 * lane;
#pragma unroll
                    for (int q = 0; q < 4; ++q) yr[j][q] = __builtin_nontemporal_load((const u32x4*)(yp + 512 * q)); }
#pragma unroll
                for (int j = 0; j < 4; ++j) if (j < ns) {
#pragma unroll
                    for (int q = 0; q < 4; ++q) { const u32x4 a = yr[j][q];
                        acc[8 * q + 0] += gg[j] * bflo(a.x); acc[8 * q + 1] += gg[j] * bfhi(a.x); acc[8 * q + 2] += gg[j] * bflo(a.y); acc[8 * q + 3] += gg[j] * bfhi(a.y);
                        acc[8 * q + 4] += gg[j] * bflo(a.z); acc[8 * q + 5] += gg[j] * bfhi(a.z); acc[8 * q + 6] += gg[j] * bflo(a.w); acc[8 * q + 7] += gg[j] * bfhi(a.w); } }
            }
        }
        const float r1 = 1.0f / sqrtf(row_sumsq(acc) * (1.0f / D) + EPS);
        float xv[32], c3[32];
        row_load_bf16_nt(W_XB(F) + (size_t)row * D, lane, xv); row_load_bf16(W_CV(F) + (((size_t)l * 9 + m) * 6 + 3) * D, lane, c3);
#pragma unroll
        for (int i = 0; i < 32; ++i) xv[i] = xv[i] + c3[i] * (acc[i] * r1);
        if (l + 1 < DEPTH) row_store_bf16(dry ? (bf16*)(F.ws + WS_DUMMY) + (size_t)row * D : W_XB(F) + (size_t)row * D, lane, xv);
        else row_store_f32(dry ? (float*)(F.ws + WS_DUMMY) + (size_t)(row & 8191) * D : F.out + (size_t)row * D, lane, xv);
        if (l + 1 < DEPTH) prenorm_row_cv(F, l + 1, m, xv, row);
    }
}
struct Args { const float* in[24]; float* out; unsigned char* ws; int ph_lo, ph_hi; };
constexpr int NPHASE = 2 + 11 * DEPTH;
__global__ void __launch_bounds__(NTHR, 2) mk_fwd(Args args) {
    extern __shared__ __attribute__((aligned(16))) unsigned char lds_raw[];
    Frame F;
    F.lds = (LAS unsigned char*)lds_raw;
    F.tid = threadIdx.x; F.lane = F.tid & 63; F.wave = __builtin_amdgcn_readfirstlane(F.tid >> 6);
    F.G = gridDim.x; { const int bx = blockIdx.x; F.vcu = (F.G % 8 == 0) ? (bx % 8) * (F.G / 8) + bx / 8 : bx; }
    F.x = args.in[0]; F.c = args.in[1]; F.ctx = args.in[2]; F.c_ctx = args.in[3]; F.w_ada = args.in[4]; F.b_ada = args.in[5]; F.g_pre_mix = args.in[6]; F.g_post_mix = args.in[7];
    F.g_pre_ffn = args.in[8]; F.g_post_ffn = args.in[9]; F.w_in = args.in[10]; F.w_dec = args.in[11]; F.b_dec = args.in[12]; F.rpb = args.in[13]; F.g_gla = args.in[14]; F.ln_v_g = args.in[15];
    F.ln_v_b = args.in[16]; F.w_sp = args.in[17]; F.b_sp = args.in[18]; F.w_out = args.in[19]; F.w_router = args.in[20]; F.w_gate = args.in[21]; F.w_up = args.in[22]; F.w_down = args.in[23];
    F.out = args.out;
    unsigned char* ws = args.ws;
    F.ws = ws;

    const int lo = args.ph_lo, hi = args.ph_hi;
    unsigned* ctl = (unsigned*)(ws + WS_CTL);
    if (F.tid < 16) ((LAS unsigned*)(F.lds + LDS_XB))[F.tid] = 0u;
    __syncthreads();
    XcdBarrier bar; bar.bar = (unsigned*)(ws + WS_CTL) + CW_BAR; bar.x = 0; bar.st = nullptr;
    if (hi - lo > 1) bar = xcd_barrier_post((unsigned*)(ws + WS_CTL) + CW_BAR, (volatile LAS unsigned*)(F.lds + LDS_XB));
#ifndef MK_MASK
#define MK_MASK 0xFFFFFFFFu
#endif
#define PH(b) ((MK_MASK >> (b)) & 1u)
#ifndef MK_REP
#define MK_REP 0u
#endif
#define NREP(b) (1 + (int)((MK_REP >> (b)) & 1u))
#define REPBAR(b, rep) do { if ((rep) + 1 < NREP(b)) xcd_barrier(bar); } while (0)
#define IN(k) (lo <= (k) && (k) < hi)
#define SEAM(k) do { if (IN(k) && IN((k) + 1)) xcd_barrier(bar); } while (0)

    if (PH(0) && IN(0)) { for (int rep = 0; rep < NREP(0); ++rep) { launder(F); p0a(F); REPBAR(0, rep); } } SEAM(0);
    if (PH(1) && IN(1)) { for (int rep = 0; rep < NREP(1); ++rep) { launder(F); p0b(F); REPBAR(1, rep); } } SEAM(1);
    for (int l = 0; l < DEPTH; ++l) {
        const int pb = 2 + 11 * l;
        if (PH(2) && IN(pb + 0)) {
          for (int rep = 0; rep < NREP(2); ++rep) {
            launder(F);
            pg8::Gemm g{(const pg8::bf16_t*)W_HQ(F), (const pg8::bf16_t*)(F.ws + WS_WIN + (size_t)l * NU * D), NROW, NU, D / 2};
            constexpr int GG = 237;
            unsigned* sig = ctl + CW_SIG + 64 * (pb + 0);
            if ((int)blockIdx.x < GG || F.G != 256) {
                pg8::GroupedOrder S; S.init(1, NROW / 256, NU / 256, F.G == 256 ? GG : F.G, (int)blockIdx.x, sig);
                pg8::EpiStoreI8 E{W_U(F), NU, NU / 256, W_HS(F), W_SIN(F) + (size_t)l * NU};
                pg8::gemm_phase<pg8::EpiStoreI8, pg8::GroupedOrder, true, true>(F.lds, g, S, E, F.tid);
            } else bg_loop(F, ctl, sig, BG_TOTAL);
            REPBAR(2, rep); }
        } SEAM(pb + 0);
        if (PH(3) && IN(pb + 1)) { for (int rep = 0; rep < NREP(3); ++rep) { launder(F); p_mixers(F, l); REPBAR(3, rep); } } SEAM(pb + 1);
        if (PH(11) && IN(pb + 2)) { for (int rep = 0; rep < NREP(11); ++rep) { launder(F); p_chains(F, l); REPBAR(11, rep); } } SEAM(pb + 2);
        if (PH(4) && IN(pb + 3)) { for (int rep = 0; rep < NREP(4); ++rep) { launder(F); p_glaout(F, l); REPBAR(4, rep); } } SEAM(pb + 3);
        if (PH(5) && IN(pb + 4)) {
          for (int rep = 0; rep < NREP(5); ++rep) {
            launder(F);
            const int M = (l == 0) ? NROW : NLAT;
            pg8::Gemm g{W_MIX(F), W_WOUT(F) + (size_t)l * D * D, M, D, D};
            const int GG = (l == 0) ? 192 : 256;
            unsigned* sig = ctl + CW_SIG + 64 * (pb + 4);
            if ((int)blockIdx.x < GG || F.G != 256) {
                pg8::GroupedOrder S; S.init(1, M / 256, D / 256, F.G == 256 ? GG : F.G, (int)blockIdx.x, sig);
                pg8::EpiStore E{W_Y(F), D, D / 256};
                pg8::gemm_phase<pg8::EpiStore, pg8::GroupedOrder, true, true>(F.lds, g, S, E, F.tid);
            } else bg_loop(F, ctl, sig, BG_TOTAL);
            REPBAR(5, rep); }
        } SEAM(pb + 4);
        if (PH(6) && IN(pb + 5)) { if (MK_REPMIX & 16u) { launder(F); p_postmix(F, l, true); xcd_barrier(bar); } launder(F); p_postmix(F, l, false); } SEAM(pb + 5);
        if (PH(7) && IN(pb + 6)) { for (int rep = 0; rep < NREP(7); ++rep) { launder(F); p_topk(F, l); launder(F); bg_loop(F, ctl, nullptr, l == 0 ? BG_A : BG_TOTAL); REPBAR(7, rep); } } SEAM(pb + 6);
        if (PH(8) && IN(pb + 7)) {
          for (int rep = 0; rep < NREP(8); ++rep) {
            launder(F);
            const int ME = (l == 0) ? ME0 : ME1;
            pg8::Gemm g{(const pg8::bf16_t*)W_XSQ(F), (const pg8::bf16_t*)((F).ws + WS_W1 + (size_t)l * NE * (2 * FF) * D), NE * ME, NE * 2 * FF, D / 2};
            pg8::GroupedOrder S; S.init(NE, ME / 256, 2 * FF / 256, F.G, (int)blockIdx.x);
            pg8::EpiSwiGLUI8 E{W_ACT(F), FF, 2 * FF / 256, W_XSS(F), W_S1(F) + (size_t)l * NE * (2 * FF), W_TM(F)};
            pg8::gemm_phase<pg8::EpiSwiGLUI8, pg8::GroupedOrder, true, true>(F.lds, g, S, E, F.tid); REPBAR(8, rep); }
        } SEAM(pb + 7);
        if (PH(12) && IN(pb + 8)) { launder(F); p_actq(F, l); } SEAM(pb + 8);
        if (PH(9) && IN(pb + 9)) {
          for (int rep = 0; rep < NREP(9); ++rep) {
            launder(F);
            const int ME = (l == 0) ? ME0 : ME1;
            pg8::Gemm g{(const pg8::bf16_t*)W_ACTQ(F), (const pg8::bf16_t*)((F).ws + WS_W2 + (size_t)l * NE * D * FF), NE * ME, NE * D, FF / 2};
            const int GG = (l == 0) ? 231 : 256;
            unsigned* sig = ctl + CW_SIG + 64 * (pb + 9);
            if ((int)blockIdx.x < GG || F.G != 256) {
                pg8::GroupedOrder S; S.init(NE, ME / 256, D / 256, F.G == 256 ? GG : F.G, (int)blockIdx.x, sig);
                pg8::EpiStoreI8 E{W_XS(F), D, D / 256, W_ACTS(F), W_S2(F) + (size_t)l * NE * D};
                pg8::gemm_phase<pg8::EpiStoreI8, pg8::GroupedOrder, true, true>(F.lds, g, S, E, F.tid);
            } else bg_loop(F, ctl, sig, BG_TOTAL);
            REPBAR(9, rep); }
        } SEAM(pb + 9);
        if (PH(10) && IN(pb + 10)) { if (MK_REPMIX & 32u) { launder(F); p_combine(F, l, true); xcd_barrier(bar); } launder(F); p_combine(F, l, false); if (l == 0) { launder(F); bg_loop(F, ctl, nullptr, BG_B); } } SEAM(pb + 10);
    }
#undef IN
#undef SEAM
}

extern "C" void kernel_launch(void* const* d_in, const int* in_sizes, int n_in, void* d_out, int out_size, void* d_ws, size_t ws_size, hipStream_t stream) {
    static int grid = 0;
    if (grid == 0) {
        if (n_in != 24 || out_size != NLAT * D || ws_size < WS_END2) { fprintf(stderr, "kernel_launch: unexpected shapes (n_in %d out %d ws %zu)\n", n_in, out_size, ws_size); grid = -1; return; }
        int dev = 0, cus = 0, per_cu = 0;
        if (hipGetDevice(&dev) != hipSuccess || hipDeviceGetAttribute(&cus, hipDeviceAttributeMultiprocessorCount, dev) != hipSuccess) { grid = -1; return; }
        if (hipFuncSetAttribute((const void*)mk_fwd, hipFuncAttributeMaxDynamicSharedMemorySize, LDS_BYTES) != hipSuccess) { fprintf(stderr, "kernel_launch: hipFuncSetAttribute failed\n"); grid = -1; return; }
        if (hipOccupancyMaxActiveBlocksPerMultiprocessor(&per_cu, (const void*)mk_fwd, NTHR, LDS_BYTES) != hipSuccess || per_cu < 1) { fprintf(stderr, "kernel_launch: occupancy query says %d\n", per_cu); }
        (void)hipGetLastError();
        grid = cus;
    }
    if (grid < 0) return;
    if (hipMemsetAsync((char*)d_ws + WS_CTL, 0, CTL_ZERO_BYTES, stream) != hipSuccess) return;
    Args a{};
    for (int i = 0; i < 24; ++i) a.in[i] = (const float*)d_in[i];
    a.out = (float*)d_out; a.ws = (unsigned char*)d_ws;
#if MK_N_LAUNCHES == 1
    a.ph_lo = 0; a.ph_hi = NPHASE;
    hipLaunchKernelGGL(mk_fwd, dim3(grid), dim3(NTHR), LDS_BYTES, stream, a);
#else
    for (int p = 0; p < NPHASE; ++p) { a.ph_lo = p; a.ph_hi = p + 1; hipLaunchKernelGGL(mk_fwd, dim3(grid), dim3(NTHR), LDS_BYTES, stream, a); }
#endif
}
```

```cpp
#include <hip/hip_runtime.h>
#include <cstdio>
#include <cstdint>

#ifndef MK_N_LAUNCHES
#define MK_N_LAUNCHES 1
#endif

namespace pg8 {
#define PG8_LAS __attribute__((address_space(3)))
typedef unsigned short bf16_t;
typedef short bf16x8 __attribute__((ext_vector_type(8)));
typedef float f32x4 __attribute__((ext_vector_type(4)));
typedef unsigned u32x4 __attribute__((ext_vector_type(4)));
constexpr int BM = 256, BK = 64, HALF = 128, HTB = HALF * BK * 2  , STAGE_BYTES = 8 * HTB, NXCD = 8, WGM = 8;

__host__ __device__ __forceinline__ int lds_byte(int r, int c) { const int st = (r >> 4) * 2 + (c >> 5), rr = r & 15, cc = c & 31, ob = rr * 64 + cc * 2; return st * 1024 + (ob ^ (((ob >> 9) & 1) << 5)); }
__host__ __device__ __forceinline__ void stage_rc(int b, int& R, int& C) { const int st = b / 1024, sb = b % 1024, swz = sb ^ (((sb >> 9) & 1) << 5); R = (st >> 1) * 16 + swz / 64; C = (st & 1) * 32 + (swz % 64) / 2; }
__host__ __device__ __forceinline__ int perm32(int rho) { const int n = rho >> 4, i = rho & 15; return 8 * (i >> 2) + 4 * n + (i & 3); }

struct Unit { int pm, pn, last; };
struct Gemm { const bf16_t* A; const bf16_t* Bt; int M, N, K; };

typedef __bf16 hwbf16x2_t __attribute__((ext_vector_type(2))); typedef float f32x2_cv __attribute__((ext_vector_type(2)));
__device__ __forceinline__ unsigned cvt_pk_bf16(float lo, float hi) { const f32x2_cv v = {lo, hi}; const hwbf16x2_t b = __builtin_convertvector(v, hwbf16x2_t); return __builtin_bit_cast(unsigned, b); }
typedef float f32x2 __attribute__((ext_vector_type(2)));
typedef int i32x4 __attribute__((ext_vector_type(4)));
__device__ __forceinline__ f32x4 mma16(bf16x8 a, bf16x8 b, f32x4 c) { return __builtin_amdgcn_mfma_f32_16x16x32_bf16(a, b, c, 0, 0, 0); }
__device__ __forceinline__ i32x4 mma16(bf16x8 a, bf16x8 b, i32x4 c) { return __builtin_amdgcn_mfma_i32_16x16x64_i8(__builtin_bit_cast(i32x4, a), __builtin_bit_cast(i32x4, b), c, 0, 0, 0); }
__device__ __forceinline__ void tile_of(int wgid, int nM, int nN, int& pm, int& pn) {
    const int nwg = nM * nN;
    { const int q = nwg / NXCD, r = nwg % NXCD, xcd = wgid % NXCD, off = wgid / NXCD; wgid = (xcd < r ? xcd * (q + 1) : r * (q + 1) + (xcd - r) * q) + off; }
    const int nig = WGM * nN, gid = wgid / nig, fm = gid * WGM, gsz = (nM - fm) < WGM ? (nM - fm) : WGM;
    pm = fm + ((wgid % nig) % gsz); pn = (wgid % nig) / gsz;
}
struct GroupedOrder {
    int mM, mN, per, total, G, c; unsigned* sig;
    __device__ __forceinline__ void init(int E, int mM_, int mN_, int G_, int c_, unsigned* sig_ = nullptr) { mM = mM_; mN = mN_; per = mM * mN; total = E * per; G = G_; c = c_; sig = sig_; }
    __device__ __forceinline__ bool next(int i, Unit& u) const {
        const long L = (long)i * G + c; if (L >= total) return false;
        const int e = (int)(L / per), l = (int)(L % per); int pm, pn; tile_of(l, mM, mN, pm, pn);
        u.pm = e * mM + pm; u.pn = e * mN + pn; u.last = (i == (total + G - 1) / G - 1) ? 1 : 0; return true;
    }
    __device__ __forceinline__ void a_ready(const Unit& u) const { if (sig && u.last && threadIdx.x == 0) __hip_atomic_store(sig, 1u, __ATOMIC_RELAXED, __HIP_MEMORY_SCOPE_AGENT); }
    __device__ __forceinline__ void done(const Unit&) const {}
};
__device__ __forceinline__ float xmax16(float v) { const auto r = __builtin_amdgcn_permlane16_swap(__builtin_bit_cast(unsigned, v), __builtin_bit_cast(unsigned, v), false, false); return fmaxf(__builtin_bit_cast(float, r[0]), __builtin_bit_cast(float, r[1])); }
__device__ __forceinline__ float xmax32(float v) { const auto r = __builtin_amdgcn_permlane32_swap(__builtin_bit_cast(unsigned, v), __builtin_bit_cast(unsigned, v), false, false); return fmaxf(__builtin_bit_cast(float, r[0]), __builtin_bit_cast(float, r[1])); }
__device__ __forceinline__ float xsum16(float v) { const auto r = __builtin_amdgcn_permlane16_swap(__builtin_bit_cast(unsigned, v), __builtin_bit_cast(unsigned, v), false, false); return __builtin_bit_cast(float, r[0]) + __builtin_bit_cast(float, r[1]); }
__device__ __forceinline__ float xsum32(float v) { const auto r = __builtin_amdgcn_permlane32_swap(__builtin_bit_cast(unsigned, v), __builtin_bit_cast(unsigned, v), false, false); return __builtin_bit_cast(float, r[0]) + __builtin_bit_cast(float, r[1]); }
__device__ __forceinline__ float silu_f(float x) { return x * __builtin_amdgcn_rcpf(1.0f + __expf(-x)); }
struct EpiStore {
    static constexpr bool PERM = true, AFTER_DRAIN = false; typedef f32x4 acc_t;
    bf16_t* O; int ldc; int nN;
    __device__ __forceinline__ void operator()(const f32x4 (&acc)[2][2][4][2], const Unit& u, int wr, int wc, int fr, int fq) const {
        const int row0 = u.pm * BM + wr * 64 + fr, col0 = (u.pn % nN) * BM + wc * 32 + 8 * fq;
#pragma unroll
        for (int ai = 0; ai < 2; ++ai)
#pragma unroll
            for (int m = 0; m < 4; ++m) { bf16_t* rowp = O + (size_t)(row0 + ai * HALF + m * 16) * ldc + col0;
#pragma unroll
                for (int bj = 0; bj < 2; ++bj) { const f32x4 v0 = acc[ai][bj][m][0], v1 = acc[ai][bj][m][1];
                    u32x4 w; w.x = cvt_pk_bf16(v0[0], v0[1]); w.y = cvt_pk_bf16(v0[2], v0[3]); w.z = cvt_pk_bf16(v1[0], v1[1]); w.w = cvt_pk_bf16(v1[2], v1[3]);
                    *(u32x4*)(rowp + bj * HALF) = w; } }
    }
};
struct EpiSwiGLU {
    static constexpr bool PERM = true, AFTER_DRAIN = false; typedef f32x4 acc_t;
    bf16_t* O; int ldc; int nN;
    __device__ __forceinline__ void operator()(const f32x4 (&acc)[2][2][4][2], const Unit& u, int wr, int wc, int fr, int fq) const {
        const int row0 = u.pm * BM + wr * 64 + fr, col0 = (u.pn % nN) * HALF + wc * 32 + 8 * fq;
#pragma unroll
        for (int ai = 0; ai < 2; ++ai)
#pragma unroll
            for (int m = 0; m < 4; ++m) { bf16_t* rowp = O + (size_t)(row0 + ai * HALF + m * 16) * ldc + col0;
                f32x4 a0 = acc[ai][0][m][0], a1 = acc[ai][0][m][1]; const f32x4 b0 = acc[ai][1][m][0], b1 = acc[ai][1][m][1];
#pragma unroll
                for (int j = 0; j < 4; ++j) { a0[j] = silu_f(a0[j]) * b0[j]; a1[j] = silu_f(a1[j]) * b1[j]; }
                u32x4 w; w.x = cvt_pk_bf16(a0[0], a0[1]); w.y = cvt_pk_bf16(a0[2], a0[3]); w.z = cvt_pk_bf16(a1[0], a1[1]); w.w = cvt_pk_bf16(a1[2], a1[3]);
                *(u32x4*)rowp = w; }
    }
};
struct EpiStoreI8 {
    static constexpr bool PERM = true, AFTER_DRAIN = false; typedef i32x4 acc_t;
    bf16_t* O; int ldc; int nN; const float* sa; const float* sb;
    __device__ __forceinline__ void operator()(const i32x4 (&acc)[2][2][4][2], const Unit& u, int wr, int wc, int fr, int fq) const {
        const int row0 = u.pm * BM + wr * 64 + fr, col0 = (u.pn % nN) * BM + wc * 32 + 8 * fq; const float* sbp = sb + (size_t)u.pn * BM + wc * 32 + 8 * fq;
        f32x4 bs[2][2];
#pragma unroll
        for (int bj = 0; bj < 2; ++bj) { bs[bj][0] = *(const f32x4*)(sbp + bj * HALF); bs[bj][1] = *(const f32x4*)(sbp + bj * HALF + 4); }
#pragma unroll
        for (int ai = 0; ai < 2; ++ai)
#pragma unroll
            for (int m = 0; m < 4; ++m) { const int row = row0 + ai * HALF + m * 16; const float as = sa[row]; bf16_t* rowp = O + (size_t)row * ldc + col0;
#pragma unroll
                for (int bj = 0; bj < 2; ++bj) { const i32x4 i0 = acc[ai][bj][m][0], i1 = acc[ai][bj][m][1]; f32x4 v0, v1;
#pragma unroll
                    for (int j = 0; j < 4; ++j) { v0[j] = (float)i0[j] * as * bs[bj][0][j]; v1[j] = (float)i1[j] * as * bs[bj][1][j]; }
                    u32x4 w; w.x = cvt_pk_bf16(v0[0], v0[1]); w.y = cvt_pk_bf16(v0[2], v0[3]); w.z = cvt_pk_bf16(v1[0], v1[1]); w.w = cvt_pk_bf16(v1[2], v1[3]);
                    *(u32x4*)(rowp + bj * HALF) = w; } }
    }
};
struct EpiSwiGLUI8 {
    static constexpr bool PERM = true, AFTER_DRAIN = false; typedef i32x4 acc_t;
    bf16_t* O; int ldc; int nN; const float* sa; const float* sb; float* TM;
    __device__ __forceinline__ void operator()(const i32x4 (&acc)[2][2][4][2], const Unit& u, int wr, int wc, int fr, int fq) const {
        const int pnl = u.pn % nN, row0 = u.pm * BM + wr * 64 + fr, col0 = pnl * HALF + wc * 32 + 8 * fq; const float* sbp = sb + (size_t)u.pn * BM + wc * 32 + 8 * fq;
        f32x4 bs[2][2];
#pragma unroll
        for (int bj = 0; bj < 2; ++bj) { bs[bj][0] = *(const f32x4*)(sbp + bj * HALF); bs[bj][1] = *(const f32x4*)(sbp + bj * HALF + 4); }
#pragma unroll
        for (int ai = 0; ai < 2; ++ai)
#pragma unroll
            for (int m = 0; m < 4; ++m) { const int row = row0 + ai * HALF + m * 16; const float as = sa[row]; bf16_t* rowp = O + (size_t)row * ldc + col0;
                const i32x4 g0 = acc[ai][0][m][0], g1 = acc[ai][0][m][1], u0 = acc[ai][1][m][0], u1 = acc[ai][1][m][1]; f32x4 a0, a1; float mx = 0.f;
#pragma unroll
                for (int j = 0; j < 4; ++j) { a0[j] = silu_f((float)g0[j] * as * bs[0][0][j]) * ((float)u0[j] * as * bs[1][0][j]); a1[j] = silu_f((float)g1[j] * as * bs[0][1][j]) * ((float)u1[j] * as * bs[1][1][j]);
                    mx = fmaxf(mx, fmaxf(fabsf(a0[j]), fabsf(a1[j]))); }
                u32x4 w; w.x = cvt_pk_bf16(a0[0], a0[1]); w.y = cvt_pk_bf16(a0[2], a0[3]); w.z = cvt_pk_bf16(a1[0], a1[1]); w.w = cvt_pk_bf16(a1[2], a1[3]);
                *(u32x4*)rowp = w;
                mx = fmaxf(mx, __shfl_xor(mx, 16)); mx = fmaxf(mx, __shfl_xor(mx, 32));
                if (fq == 0) TM[(size_t)row * 64 + pnl * 4 + wc] = mx; }
    }
};
template <class Epi, class Sched, bool ALIGN_EPI = false, bool SP2 = false>
__device__ __forceinline__ void gemm_phase(PG8_LAS unsigned char* lds, const Gemm g, const Sched& S, const Epi& E, int tid_in) {
    int tid_l = tid_in; asm volatile("" : "+v"(tid_l)); const int tid = tid_l, wid = __builtin_amdgcn_readfirstlane(tid >> 6), lane = tid & 63, wr = wid >> 2, wc = wid & 3, fr = lane & 15, fq = lane >> 4;
    const int K = g.K, nt = K / BK;
    unsigned voffA[2], voffB[2];
#pragma unroll
    for (int i = 0; i < 2; ++i) { int R, C; stage_rc(tid * 16 + i * 8192, R, C); const int Rb = Epi::PERM ? ((R & ~31) + perm32(R & 31)) : R;
        voffA[i] = (unsigned)(R * K + C) * 2u; voffB[i] = (unsigned)(Rb * K + C) * 2u; }
    const size_t kstep = (size_t)(BK * 2);
    const size_t hstep = (size_t)HALF * K * 2;
    const size_t tstep = 2 * hstep;
    const unsigned ldsw = (unsigned)wid * 1024u;
    const int aoff = lds_byte(wr * 64 + fr, fq * 8), boff = lds_byte(wc * 32 + fr, fq * 8);
#define PG8_SA(b, h) (((b) * 2 + (h)) * HTB)
#define PG8_SB(b, h) ((4 + (b) * 2 + (h)) * HTB)
#define PG8_STAGE(bufoff, gbase, voff) do { _Pragma("unroll") for (int _i = 0; _i < 2; ++_i) \
        __builtin_amdgcn_global_load_lds((const unsigned*)((const char*)(gbase) + (voff)[_i]), (PG8_LAS unsigned*)(lds + (bufoff) + ldsw + _i * 8192), 16, 0, 0); } while (0)
#define PG8_LDA(dst, b, h) do { _Pragma("unroll") for (int m = 0; m < 4; ++m) _Pragma("unroll") for (int k = 0; k < 2; ++k) dst[m][k] = *(const PG8_LAS bf16x8*)(lds + PG8_SA(b, h) + aoff + m * 2048 + k * 1024); } while (0)
#define PG8_LDB(dst, b, h) do { _Pragma("unroll") for (int n = 0; n < 2; ++n) _Pragma("unroll") for (int k = 0; k < 2; ++k) dst[n][k] = *(const PG8_LAS bf16x8*)(lds + PG8_SB(b, h) + boff + n * 2048 + k * 1024); } while (0)
#define PG8_MMA(ai, bj, At, Bt) do { __builtin_amdgcn_s_setprio(1); _Pragma("unroll") for (int m = 0; m < 4; ++m) _Pragma("unroll") for (int n = 0; n < 2; ++n) _Pragma("unroll") for (int k = 0; k < 2; ++k) \
        acc[ai][bj][m][n] = mma16(Bt[n][k], At[m][k], acc[ai][bj][m][n]); __builtin_amdgcn_s_setprio(0); } while (0)
#define PG8_WAIT_V(n) asm volatile("s_waitcnt vmcnt(" #n ")" ::: "memory")
#define PG8_WAIT_L(n) asm volatile("s_waitcnt lgkmcnt(" #n ")" ::: "memory")
#define PG8_BAR __builtin_amdgcn_s_barrier()
#define PG8_SCHED __builtin_amdgcn_sched_barrier(0)
    Unit cur, nxt; int ui = 0;
    if (!S.next(0, cur)) return;
    typename Epi::acc_t acc[2][2][4][2];
#pragma unroll
    for (int a = 0; a < 2; ++a)
#pragma unroll
        for (int b = 0; b < 2; ++b)
#pragma unroll
            for (int m = 0; m < 4; ++m)
#pragma unroll
                for (int n = 0; n < 2; ++n) acc[a][b][m][n] = (typename Epi::acc_t){0, 0, 0, 0};
    bf16x8 At[4][2], B0[2][2], B1[2][2];
    const char* cA = (const char*)g.A + (size_t)cur.pm * tstep; const char* cB = (const char*)g.Bt + (size_t)cur.pn * tstep;
    S.a_ready(cur);
    if constexpr (SP2) {
        PG8_STAGE(PG8_SB(0, 0), cB, voffB); PG8_STAGE(PG8_SB(0, 1), cB + hstep, voffB); PG8_STAGE(PG8_SA(0, 0), cA, voffA); PG8_STAGE(PG8_SA(0, 1), cA + hstep, voffA);
        if (wr == 1) PG8_BAR;
        PG8_WAIT_V(2); PG8_BAR;
        PG8_STAGE(PG8_SB(1, 0), cB + kstep, voffB); PG8_STAGE(PG8_SA(1, 0), cA + kstep, voffA); PG8_STAGE(PG8_SB(1, 1), cB + hstep + kstep, voffB);
        PG8_WAIT_V(6); PG8_BAR;
    } else {
        PG8_STAGE(PG8_SB(0, 0), cB, voffB); PG8_STAGE(PG8_SA(0, 0), cA, voffA); PG8_STAGE(PG8_SB(0, 1), cB + hstep, voffB); PG8_STAGE(PG8_SA(0, 1), cA + hstep, voffA);
        if (wr == 1) PG8_BAR;
        PG8_WAIT_V(4); PG8_BAR;
        PG8_STAGE(PG8_SB(1, 0), cB + kstep, voffB); PG8_STAGE(PG8_SA(1, 0), cA + kstep, voffA); PG8_STAGE(PG8_SB(1, 1), cB + hstep + kstep, voffB);
        PG8_WAIT_V(6); PG8_BAR;
    }
    for (;;) {
        const bool has_next = S.next(ui + 1, nxt);
        const char* nA = has_next ? (const char*)g.A + (size_t)nxt.pm * tstep : cA; const char* nB = has_next ? (const char*)g.Bt + (size_t)nxt.pn * tstep : cB;
        for (int t = 0; t < nt; t += 2) {
            const bool last = (t == nt - 2);
            const char* a1 = cA + (size_t)(t + 1) * kstep;
            const char* a2 = last ? nA : cA + (size_t)(t + 2) * kstep; const char* b2 = last ? nB : cB + (size_t)(t + 2) * kstep;
            const char* a3 = a2 + kstep; const char* b3 = b2 + kstep;
            if (last && has_next) S.a_ready(nxt);
            if constexpr (SP2) {
            PG8_LDB(B0, 0, 0); PG8_LDB(B1, 0, 1); PG8_SCHED; PG8_LDA(At, 0, 0); PG8_STAGE(PG8_SA(1, 1), a1 + hstep, voffA);
            PG8_WAIT_V(8); PG8_WAIT_L(0); PG8_BAR; PG8_MMA(0, 0, At, B0); PG8_MMA(0, 1, At, B1); PG8_BAR; PG8_SCHED;
            PG8_LDA(At, 0, 1); PG8_STAGE(PG8_SB(0, 0), b2, voffB); PG8_STAGE(PG8_SB(0, 1), b2 + hstep, voffB); PG8_STAGE(PG8_SA(0, 0), a2, voffA);
            PG8_WAIT_V(8); PG8_WAIT_L(0); PG8_BAR; PG8_MMA(1, 0, At, B0); PG8_MMA(1, 1, At, B1); PG8_BAR; PG8_SCHED;
            PG8_LDB(B0, 1, 0); PG8_LDB(B1, 1, 1); PG8_SCHED; PG8_LDA(At, 1, 0); PG8_STAGE(PG8_SA(0, 1), a2 + hstep, voffA);
            PG8_WAIT_V(8); PG8_WAIT_L(0); PG8_BAR; PG8_MMA(0, 0, At, B0); PG8_MMA(0, 1, At, B1); PG8_BAR; PG8_SCHED;
            PG8_LDA(At, 1, 1); PG8_STAGE(PG8_SB(1, 0), b3, voffB); PG8_STAGE(PG8_SB(1, 1), b3 + hstep, voffB); PG8_STAGE(PG8_SA(1, 0), a3, voffA);
            PG8_WAIT_V(8); PG8_WAIT_L(0); PG8_BAR; PG8_MMA(1, 0, At, B0); PG8_MMA(1, 1, At, B1); PG8_BAR; PG8_SCHED;
            } else {
            PG8_LDB(B0, 0, 0); PG8_SCHED; PG8_LDA(At, 0, 0); PG8_STAGE(PG8_SA(1, 1), a1 + hstep, voffA);
            PG8_WAIT_L(8); PG8_BAR; PG8_WAIT_L(0); PG8_MMA(0, 0, At, B0); PG8_BAR; PG8_SCHED;
            PG8_LDB(B1, 0, 1); PG8_STAGE(PG8_SB(0, 0), b2, voffB);
            PG8_BAR; PG8_WAIT_L(0); PG8_MMA(0, 1, At, B1); PG8_BAR;
            PG8_LDA(At, 0, 1); PG8_STAGE(PG8_SA(0, 0), a2, voffA);
            PG8_BAR; PG8_WAIT_L(0); PG8_MMA(1, 0, At, B0); PG8_BAR; PG8_SCHED;
            PG8_STAGE(PG8_SB(0, 1), b2 + hstep, voffB);
            PG8_WAIT_V(6); PG8_BAR; PG8_MMA(1, 1, At, B1); PG8_BAR;
            PG8_LDB(B0, 1, 0); PG8_SCHED; PG8_LDA(At, 1, 0); PG8_STAGE(PG8_SA(0, 1), a2 + hstep, voffA);
            PG8_WAIT_L(8); PG8_BAR; PG8_WAIT_L(0); PG8_MMA(0, 0, At, B0); PG8_BAR; PG8_SCHED;
            PG8_LDB(B1, 1, 1); PG8_STAGE(PG8_SB(1, 0), b3, voffB);
            PG8_BAR; PG8_WAIT_L(0); PG8_MMA(0, 1, At, B1); PG8_BAR;
            PG8_LDA(At, 1, 1); PG8_STAGE(PG8_SA(1, 0), a3, voffA);
            PG8_BAR; PG8_WAIT_L(0); PG8_MMA(1, 0, At, B0); PG8_BAR; PG8_SCHED;
            PG8_STAGE(PG8_SB(1, 1), b3 + hstep, voffB);
            PG8_WAIT_V(6); PG8_BAR; PG8_MMA(1, 1, At, B1); PG8_BAR;
            }
        }
        if constexpr (ALIGN_EPI) { if (wr == 0) PG8_BAR; }
        if constexpr (!Epi::AFTER_DRAIN) { E(acc, cur, wr, wc, fr, fq); S.done(cur); }
        if (!has_next) break;
#pragma unroll
        for (int a = 0; a < 2; ++a)
#pragma unroll
            for (int b = 0; b < 2; ++b)
#pragma unroll
                for (int m = 0; m < 4; ++m)
#pragma unroll
                    for (int n = 0; n < 2; ++n) acc[a][b][m][n] = (typename Epi::acc_t){0, 0, 0, 0};
        cur = nxt; cA = nA; cB = nB; ++ui;
        if constexpr (ALIGN_EPI) { if (wr == 1) PG8_BAR; }
    }
    PG8_WAIT_V(0);
    if constexpr (!ALIGN_EPI) { if (wr == 0) PG8_BAR; }
    PG8_BAR;
    if constexpr (Epi::AFTER_DRAIN) { E.fused(acc, cur, wr, wc, fr, fq, lds, wid, lane); S.done(cur); }
#undef PG8_SA
#undef PG8_SB
#undef PG8_STAGE
#undef PG8_LDA
#undef PG8_LDB
#undef PG8_MMA
#undef PG8_WAIT_V
#undef PG8_WAIT_L
#undef PG8_BAR
#undef PG8_SCHED
}
}
#define LAS __attribute__((address_space(3)))
typedef unsigned short bf16;
typedef short bf16x8 __attribute__((ext_vector_type(8)));
typedef short bf16x4 __attribute__((ext_vector_type(4)));
typedef float f32x4 __attribute__((ext_vector_type(4)));
typedef float f32x2 __attribute__((ext_vector_type(2)));
typedef unsigned u32x4 __attribute__((ext_vector_type(4)));
typedef unsigned u32x2 __attribute__((ext_vector_type(2)));

constexpr int D = 2048, NB = 8, SEQ = 2048, CTXL = 256, DEPTH = 2, GRIDW = 64;
constexpr int NLAT = NB * SEQ, NCTX = NB * CTXL, NROW = NLAT + NCTX;
constexpr int HA = 8, DHA = 64, HB = 4, DKB = 128, DVB = 256, DECR = 16, GC = 4, CG = 128, MIXC = 128;
constexpr int NE = 16, FF = 2048, CAPL = 256, CAPC = 32;
constexpr int N_IN = 5664, NU = 5888;
constexpr int U_QA = 0, U_KA = 512, U_VA = 1024, U_KB = 1536, U_VB = 2048, U_QB = 3072, U_GB = 3584, U_UC = 4608, U_VC = 5120, U_DEC = 5632;
constexpr int MIX_A = 0, MIX_B = 512, MIX_C = 1536;
constexpr float EPS = 1e-6f;
constexpr int ME0 = NB * CAPL + NB * CAPC, ME1 = NB * CAPL;

constexpr size_t MiB = 1u << 20;
constexpr size_t WS_CTL = 0, CTL_ZERO_BYTES = 65536;
constexpr size_t WS_MOD = 1 * MiB;
constexpr size_t WS_ROPE = 2 * MiB;
constexpr size_t WS_CV = WS_ROPE + 65536;
constexpr size_t WS_AFF = 3 * MiB;
constexpr size_t WS_TSLOT = 5 * MiB;
constexpr size_t WS_GD = 6656 * 1024;
constexpr size_t WS_WIN = 8 * MiB;
constexpr size_t WS_SIN = WS_WIN + 24 * MiB;
constexpr size_t WS_WOUT = 54 * MiB;
constexpr size_t WS_W1 = 70 * MiB;
constexpr size_t WS_S1 = WS_W1 + 256 * MiB;
constexpr size_t WS_W2 = 582 * MiB;
constexpr size_t WS_S2 = WS_W2 + 128 * MiB;
constexpr size_t WS_H = 838 * MiB;
constexpr size_t WS_HS = WS_H + 36 * MiB;
constexpr size_t WS_XC = 910 * MiB;
constexpr size_t WS_R1 = 926 * MiB;
constexpr size_t WS_R2 = 1133 * MiB;
constexpr size_t WS_XSS = WS_R2 + 72 * MiB;
constexpr size_t WS_TM = WS_R1 + 144 * MiB;
constexpr size_t WS_ACTS = WS_TM + 9 * MiB;
constexpr size_t WS_ACTQ = 1349 * MiB;
constexpr size_t WS_GQ = WS_R2, WS_GK = WS_R2 + 36 * MiB, WS_GV = WS_R2 + 72 * MiB;
constexpr size_t WS_MIX = 1277 * MiB;
constexpr size_t WS_OB = 1349 * MiB;
constexpr size_t WS_END = 1421 * MiB;
constexpr size_t WS_DUMMY = WS_END;
constexpr size_t WS_XB = WS_END + 72 * MiB;
constexpr size_t WS_END2 = WS_XB + 72 * MiB;
static_assert((size_t)DEPTH * NU * D * 2 <= 46 * MiB && (size_t)NROW * NU * 2 <= 207 * MiB && (size_t)NE * ME0 * D * 2 <= 144 * MiB && (size_t)NROW * D * 2 <= 72 * MiB, "ws map");
constexpr int CW_TMO = 0, CW_BAR = 4096, CW_BG = 8192, CW_SIG = 8256;

constexpr int LDS_BYTES = 147456, NWAVES = 8, NTHR = 512;
constexpr int LDS_XB = 147456 - 64;

using pg8::silu_f; using pg8::xmax16; using pg8::xmax32; using pg8::xsum16; using pg8::xsum32;
typedef __bf16 hwbf16x2 __attribute__((ext_vector_type(2)));
__device__ __forceinline__ unsigned pk2(float lo, float hi) { const f32x2 v = {lo, hi}; const hwbf16x2 b = __builtin_convertvector(v, hwbf16x2); return __builtin_bit_cast(unsigned, b); }
__device__ __forceinline__ unsigned f2bf(float f) { return pk2(f, 0.f) & 0xffffu; }
__device__ __forceinline__ float bf2f(unsigned b) { return __builtin_bit_cast(float, b << 16); }
__device__ __forceinline__ float bflo(unsigned w) { return __builtin_bit_cast(float, w << 16); }
__device__ __forceinline__ float bfhi(unsigned w) { return __builtin_bit_cast(float, w & 0xffff0000u); }
template <int CTRL, int ROWMASK> __device__ __forceinline__ float dpp_f(float old, float v) { return __builtin_bit_cast(float, __builtin_amdgcn_update_dpp(__builtin_bit_cast(int, old), __builtin_bit_cast(int, v), CTRL, ROWMASK, 0xf, false)); }
__device__ __forceinline__ float wave_sum(float v) {
    v += dpp_f<0xB1, 0xf>(0.f, v); v += dpp_f<0x4E, 0xf>(0.f, v); v += dpp_f<0x141, 0xf>(0.f, v); v += dpp_f<0x140, 0xf>(0.f, v);
    v += dpp_f<0x142, 0xa>(0.f, v); v += dpp_f<0x143, 0xc>(0.f, v);
    return __builtin_bit_cast(float, __builtin_amdgcn_readlane(__builtin_bit_cast(int, v), 63));
}
__device__ __forceinline__ float gelu_tanh(float x) { const float u = 0.7978845608028654f * (x + 0.044715f * x * x * x); const float e = __expf(2.0f * u); return 0.5f * x * (2.0f - 2.0f * __builtin_amdgcn_rcpf(1.0f + e)); }
__device__ __forceinline__ float log_sigmoid(float z) { return fminf(z, 0.0f) - __logf(1.0f + __expf(-fabsf(z))); }
#define LDS_WAIT() asm volatile("s_waitcnt lgkmcnt(0)" ::: "memory")

__device__ __forceinline__ void row_load_f32(const float* p, int lane, float (&v)[32]) {
#pragma unroll
    for (int j = 0; j < 4; ++j) { const f32x4 a = *(const f32x4*)(p + 512 * j + 8 * lane), b = *(const f32x4*)(p + 512 * j + 8 * lane + 4);
        v[8 * j + 0] = a[0]; v[8 * j + 1] = a[1]; v[8 * j + 2] = a[2]; v[8 * j + 3] = a[3]; v[8 * j + 4] = b[0]; v[8 * j + 5] = b[1]; v[8 * j + 6] = b[2]; v[8 * j + 7] = b[3]; }
}
__device__ __forceinline__ void row_load_f32_nt(const float* p, int lane, float (&v)[32]) {
#pragma unroll
    for (int j = 0; j < 4; ++j) { const f32x4 a = __builtin_nontemporal_load((const f32x4*)(p + 512 * j + 8 * lane)), b = __builtin_nontemporal_load((const f32x4*)(p + 512 * j + 8 * lane + 4));
        v[8 * j + 0] = a[0]; v[8 * j + 1] = a[1]; v[8 * j + 2] = a[2]; v[8 * j + 3] = a[3]; v[8 * j + 4] = b[0]; v[8 * j + 5] = b[1]; v[8 * j + 6] = b[2]; v[8 * j + 7] = b[3]; }
}
__device__ __forceinline__ void row_load_bf16_nt(const bf16* p, int lane, float (&v)[32]) {
#pragma unroll
    for (int j = 0; j < 4; ++j) { const u32x4 a = __builtin_nontemporal_load((const u32x4*)(p + 512 * j + 8 * lane));
        v[8 * j + 0] = bflo(a.x); v[8 * j + 1] = bfhi(a.x); v[8 * j + 2] = bflo(a.y); v[8 * j + 3] = bfhi(a.y); v[8 * j + 4] = bflo(a.z); v[8 * j + 5] = bfhi(a.z); v[8 * j + 6] = bflo(a.w); v[8 * j + 7] = bfhi(a.w); }
}
__device__ __forceinline__ void row_store_f32(float* p, int lane, const float (&v)[32]) {
#pragma unroll
    for (int j = 0; j < 4; ++j) { __builtin_nontemporal_store((f32x4){v[8 * j], v[8 * j + 1], v[8 * j + 2], v[8 * j + 3]}, (f32x4*)(p + 512 * j + 8 * lane)); __builtin_nontemporal_store((f32x4){v[8 * j + 4], v[8 * j + 5], v[8 * j + 6], v[8 * j + 7]}, (f32x4*)(p + 512 * j + 8 * lane + 4)); }
}
__device__ __forceinline__ void row_load_bf16(const bf16* p, int lane, float (&v)[32]) {
#pragma unroll
    for (int j = 0; j < 4; ++j) { const u32x4 a = *(const u32x4*)(p + 512 * j + 8 * lane);
        v[8 * j + 0] = bflo(a.x); v[8 * j + 1] = bfhi(a.x); v[8 * j + 2] = bflo(a.y); v[8 * j + 3] = bfhi(a.y); v[8 * j + 4] = bflo(a.z); v[8 * j + 5] = bfhi(a.z); v[8 * j + 6] = bflo(a.w); v[8 * j + 7] = bfhi(a.w); }
}
__device__ __forceinline__ void row_store_bf16(bf16* p, int lane, const float (&v)[32]) {
#pragma unroll
    for (int j = 0; j < 4; ++j) { u32x4 a; a.x = pk2(v[8 * j], v[8 * j + 1]); a.y = pk2(v[8 * j + 2], v[8 * j + 3]); a.z = pk2(v[8 * j + 4], v[8 * j + 5]); a.w = pk2(v[8 * j + 6], v[8 * j + 7]); __builtin_nontemporal_store(a, (u32x4*)(p + 512 * j + 8 * lane)); }
}
__device__ __forceinline__ float row_sumsq(const float (&v)[32]) { float s = 0.f;
#pragma unroll
    for (int i = 0; i < 32; ++i) s += v[i] * v[i];
    return wave_sum(s); }

#define XB_TMO      128
#define XB_XCNT(j)  (256  + 64 * (j))
#define XB_XSUB(j)  (1280 + 64 * (j))
#define XB_XGEN(j)  (2304 + 64 * (j))
#define XB_TOP      3328
#define XB_TOPGEN   3392
#define XCD_BAR_WORDS 3456
#define XB_SPIN_CAP (1u << 18)
#define LAS __attribute__((address_space(3)))

__device__ __forceinline__ unsigned xb_ld(unsigned* p)              { return __hip_atomic_load(p, __ATOMIC_RELAXED, __HIP_MEMORY_SCOPE_AGENT); }
__device__ __forceinline__ unsigned xb_add(unsigned* p, unsigned v) { return __hip_atomic_fetch_add(p, v, __ATOMIC_RELAXED, __HIP_MEMORY_SCOPE_AGENT); }
__device__ __forceinline__ unsigned xb_xcc_id() { return (unsigned)__builtin_amdgcn_s_getreg((3 << 11) | 20) & 0xFu; }
#define XB_SPIN(cond, bar) do { unsigned _sp = 0; while (cond) { __builtin_amdgcn_s_sleep(1); \
    if ((++_sp & 255u) == 0u) { if (xb_ld(&(bar)[XB_TMO])) break; if (_sp > XB_SPIN_CAP) { atomicAdd(&(bar)[XB_TMO], 1u); break; } } } } while (0)

struct XcdBarrier {
    unsigned* bar; unsigned x;
    volatile LAS unsigned* st;
};

__device__ __forceinline__ XcdBarrier xcd_barrier_post(unsigned* bar, volatile LAS unsigned* st) {
    XcdBarrier b; b.bar = bar; b.x = xb_xcc_id(); b.st = st;
    if (threadIdx.x == 0) (void)xb_add(&bar[XB_XCNT(b.x)], 1u);
    return b;
}
__device__ __forceinline__ void xcd_barrier_complete(unsigned* bar, unsigned x, unsigned& nloc, unsigned& nx) {
    const unsigned G = gridDim.x * gridDim.y * gridDim.z;
    unsigned sum, cnt, mine, sp = 0u;
    for (;;) {
        sum = 0u; cnt = 0u; mine = 0u;
#pragma unroll
        for (unsigned j = 0; j < 16; ++j) { const unsigned c = xb_ld(&bar[XB_XCNT(j)]); sum += c; cnt += (c > 0u) ? 1u : 0u; mine = (j == x) ? c : mine; }
        if (sum == G) break;
        __builtin_amdgcn_s_sleep(1);
        if ((++sp & 255u) == 0u) { if (xb_ld(&bar[XB_TMO])) break; if (sp > XB_SPIN_CAP) { atomicAdd(&bar[XB_TMO], 1u); break; } }
    }
    nloc = mine > 0u ? mine : 1u; nx = cnt > 0u ? cnt : 1u;
}

__device__ __forceinline__ void xcd_barrier(const XcdBarrier& b) {
    asm volatile("s_waitcnt vmcnt(0)" ::: "memory");
    __syncthreads();
    if (threadIdx.x == 0) {
        unsigned* bar = b.bar;
        __builtin_amdgcn_s_waitcnt(0);
        unsigned nloc = b.st[0], nx = b.st[1];
        if (nloc == 0u) { xcd_barrier_complete(bar, b.x, nloc, nx); b.st[0] = nloc; b.st[1] = nx; }
        const unsigned old = xb_add(&bar[XB_XSUB(b.x)], 1u);
        const unsigned gen = old / nloc;
        if (old + 1u == (gen + 1u) * nloc) {
            __builtin_amdgcn_fence(__ATOMIC_RELEASE, "agent");
            asm volatile("s_waitcnt vmcnt(0)" ::: "memory");
            const unsigned og = xb_add(&bar[XB_TOP], 1u);
            const unsigned tg = og / nx;
            if (og + 1u == (tg + 1u) * nx) xb_add(&bar[XB_TOPGEN], 1u);
            else XB_SPIN(xb_ld(&bar[XB_TOPGEN]) == tg, bar);
            __builtin_amdgcn_fence(__ATOMIC_ACQUIRE, "agent");
            xb_add(&bar[XB_XGEN(b.x)], 1u);
            asm volatile("s_waitcnt vmcnt(0)" ::: "memory");
        } else {
            XB_SPIN(xb_ld(&bar[XB_XGEN(b.x)]) == gen, bar);
            __builtin_amdgcn_fence(__ATOMIC_ACQUIRE, "agent");
            asm volatile("s_waitcnt vmcnt(0)" ::: "memory");
        }
    }
    __syncthreads();
}

struct Frame {
    LAS unsigned char* lds;
    int tid, lane, wave, vcu, G;
    const float *x, *c, *ctx, *c_ctx, *w_ada, *b_ada, *g_pre_mix, *g_post_mix, *g_pre_ffn, *g_post_ffn, *w_in, *w_dec, *b_dec, *rpb, *g_gla, *ln_v_g, *ln_v_b, *w_sp, *b_sp, *w_out, *w_router, *w_gate, *w_up, *w_down;
    float* out; unsigned char* ws;
};

#define W_MOD(F) ((float*)((F).ws + WS_MOD))
#define W_ROPE(F) ((float*)((F).ws + WS_ROPE))
#define W_CV(F) ((bf16*)((F).ws + WS_CV))
#define W_AFF(F) ((float*)((F).ws + WS_AFF))
#define W_XC(F) ((float*)((F).ws + WS_XC))
#define W_XB(F) ((bf16*)((F).ws + WS_XB))
#define W_TSLOT(F) ((int*)((F).ws + WS_TSLOT))
#define W_WIN(F) ((bf16*)((F).ws + WS_WIN))
#define W_WOUT(F) ((bf16*)((F).ws + WS_WOUT))
#define W_W1(F) ((bf16*)((F).ws + WS_W1))
#define W_W2(F) ((bf16*)((F).ws + WS_W2))
#define W_H(F) ((bf16*)((F).ws + WS_H))
#define W_U(F) ((bf16*)((F).ws + WS_R1))
#define W_Y(F) ((bf16*)((F).ws + WS_R1))
#define W_ACT(F) ((bf16*)((F).ws + WS_R1))
#define W_XS(F) ((bf16*)((F).ws + WS_R2))
#define W_MIX(F) ((bf16*)((F).ws + WS_MIX))
#define W_OB(F) ((bf16*)((F).ws + WS_OB))
#define W_SIN(F) ((float*)((F).ws + WS_SIN))
#define W_S1(F) ((float*)((F).ws + WS_S1))
#define W_S2(F) ((float*)((F).ws + WS_S2))
#define W_HQ(F) ((signed char*)((F).ws + WS_H))
#define W_HS(F) ((float*)((F).ws + WS_HS))
#define W_XSQ(F) ((signed char*)((F).ws + WS_R2))
#define W_XSS(F) ((float*)((F).ws + WS_XSS))
#define W_TM(F) ((float*)((F).ws + WS_TM))
#define W_ACTS(F) ((float*)((F).ws + WS_ACTS))
#define W_ACTQ(F) ((signed char*)((F).ws + WS_ACTQ))
__device__ __forceinline__ void launder(Frame& F) {
    int wv = F.wave; asm volatile("" : "+s"(wv)); F.wave = wv;
    unsigned ones = ~0u; asm volatile("" : "+s"(ones));
    int t = wv * 64 + (int)__builtin_amdgcn_mbcnt_hi(ones, __builtin_amdgcn_mbcnt_lo(ones, 0u)); asm volatile("" : "+v"(t)); F.tid = t; F.lane = t & 63;
    int v = F.vcu; asm volatile("" : "+s"(v)); F.vcu = v;
    __attribute__((address_space(1))) unsigned char* w = (__attribute__((address_space(1))) unsigned char*)F.ws; asm volatile("" : "+s"(w)); F.ws = (unsigned char*)w;
}

__device__ __forceinline__ float wave_max(float v) {
    v = fmaxf(v, dpp_f<0xB1, 0xf>(v, v)); v = fmaxf(v, dpp_f<0x4E, 0xf>(v, v)); v = fmaxf(v, dpp_f<0x141, 0xf>(v, v)); v = fmaxf(v, dpp_f<0x140, 0xf>(v, v));
    v = fmaxf(v, dpp_f<0x142, 0xa>(v, v)); v = fmaxf(v, dpp_f<0x143, 0xc>(v, v));
    return __builtin_bit_cast(float, __builtin_amdgcn_readlane(__builtin_bit_cast(int, v), 63));
}
__device__ __forceinline__ unsigned pack4_i8(float a, float b, float c, float d) { return ((unsigned)(int)a & 0xffu) | (((unsigned)(int)b & 0xffu) << 8) | (((unsigned)(int)c & 0xffu) << 16) | (((unsigned)(int)d & 0xffu) << 24); }
__device__ __forceinline__ unsigned q4_i8(float a, float b, float c, float d, float inv) {
    const unsigned x0 = __builtin_bit_cast(unsigned, fmaf(a, inv, 12582912.f)), x1 = __builtin_bit_cast(unsigned, fmaf(b, inv, 12582912.f)), x2 = __builtin_bit_cast(unsigned, fmaf(c, inv, 12582912.f)), x3 = __builtin_bit_cast(unsigned, fmaf(d, inv, 12582912.f));
    return __builtin_amdgcn_perm(x1, x0, 0x0c0c0400u) | __builtin_amdgcn_perm(x3, x2, 0x04000c0cu);
}
__device__ __forceinline__ void row_store_i8(signed char* p, int lane, const float (&v)[32], float inv) {
#pragma unroll
    for (int j = 0; j < 4; ++j) { u32x2 o; o.x = q4_i8(v[8 * j], v[8 * j + 1], v[8 * j + 2], v[8 * j + 3], inv); o.y = q4_i8(v[8 * j + 4], v[8 * j + 5], v[8 * j + 6], v[8 * j + 7], inv);
        __builtin_nontemporal_store(o, (u32x2*)(p + 512 * j + 8 * lane)); }
}

#define LBAR() do { asm volatile("s_waitcnt lgkmcnt(0)" ::: "memory"); __builtin_amdgcn_s_barrier(); asm volatile("" ::: "memory"); } while (0)
__device__ __forceinline__ int dest_row(int mode, int n) {
    if (mode == 1) return n < 3072 ? n : (n < 3104 ? U_DEC + (n - 3072) : n - 32);
    if (mode == 2) return ((n >> 7) << 8) + (n & 127);
    if (mode == 3) return ((n >> 7) << 8) + 128 + (n & 127);
    return n;
}
constexpr int IN_ITEMS = (N_IN + 63) / 64;
constexpr int BG_IN0 = IN_ITEMS, BG_A = BG_IN0 + NE * 3 * 32, BG_B = BG_A + IN_ITEMS, BG_TOTAL = BG_B + NE * 3 * 32;
__device__ __forceinline__ unsigned pkbf(float lo, float hi) { unsigned r; asm volatile("v_cvt_pk_bf16_f32 %0, %1, %2" : "=v"(r) : "v"(lo), "v"(hi)); return r; }
__device__ __forceinline__ void strip_item(Frame& F, int id) {
    const int lane = F.lane, n16 = lane & 15, kq = lane >> 4;
    LAS float* cm = (LAS float*)(F.lds); LAS unsigned* qb = (LAS unsigned*)(F.lds + 2048);
    const int l = id >= BG_A ? 1 : 0, idl = l ? id - BG_A : id; const bool isin = idl < IN_ITEMS; const int itm = isin ? idl : idl - IN_ITEMS;
    const int mi = itm >> 5, n0 = isin ? itm * 64 : (itm & 31) * 64, e = mi / 3, which = isin ? 3 : mi % 3; const size_t le = (size_t)l * NE + e;
    const float* W = isin ? F.w_in + (size_t)l * D * N_IN : (which == 0 ? F.w_gate + le * D * FF : (which == 1 ? F.w_up + le * D * FF : F.w_down + le * FF * D));
    const int mode = isin ? 1 : (which == 0 ? 2 : (which == 1 ? 3 : 0)), pitch = isin ? N_IN : D, N = isin ? N_IN : D;
    signed char* dq = isin ? (signed char*)(F.ws + WS_WIN) + (size_t)l * NU * D : (which == 2 ? (signed char*)(F.ws + WS_W2) + le * D * FF : (signed char*)(F.ws + WS_W1) + le * (2 * FF) * D);
    float* ds = isin ? W_SIN(F) + (size_t)l * NU : (which == 2 ? W_S2(F) + le * D : W_S1(F) + le * (2 * FF));
    const bool colok = (n0 + 4 * n16) < N;
    const float* src = W + (size_t)(256 * F.wave + 4 * kq) * pitch + n0 + 4 * n16;
    unsigned pk[16][4][2];
#pragma unroll
    for (int hb = 0; hb < 4; ++hb) {
        f32x4 t[4][4];
#pragma unroll
        for (int j = 0; j < 4; ++j)
#pragma unroll
            for (int e4 = 0; e4 < 4; ++e4) t[j][e4] = colok ? __builtin_nontemporal_load((const f32x4*)(src + (size_t)(16 * (4 * hb + j) + e4) * pitch)) : (f32x4){0.f, 0.f, 0.f, 0.f};
#pragma unroll
        for (int j = 0; j < 4; ++j) {
#pragma unroll
            for (int e4 = 0; e4 < 4; ++e4) { pk[4 * hb + j][e4][0] = pkbf(t[j][e4][0], t[j][e4][1]); pk[4 * hb + j][e4][1] = pkbf(t[j][e4][2], t[j][e4][3]); }
            asm volatile("" : "+v"(pk[4 * hb + j][0][0]), "+v"(pk[4 * hb + j][0][1]), "+v"(pk[4 * hb + j][1][0]), "+v"(pk[4 * hb + j][1][1]), "+v"(pk[4 * hb + j][2][0]), "+v"(pk[4 * hb + j][2][1]), "+v"(pk[4 * hb + j][3][0]), "+v"(pk[4 * hb + j][3][1]) :: "memory");
        }
    }
    typedef unsigned short u16x2 __attribute__((ext_vector_type(2)));
    u16x2 m01 = {0, 0}, m23 = {0, 0};
#pragma unroll
    for (int j = 0; j < 16; ++j)
#pragma unroll
        for (int e4 = 0; e4 < 4; ++e4) { m01 = __builtin_elementwise_max(m01, __builtin_bit_cast(u16x2, pk[j][e4][0] & 0x7fff7fffu)); m23 = __builtin_elementwise_max(m23, __builtin_bit_cast(u16x2, pk[j][e4][1] & 0x7fff7fffu)); }
    float mx[4] = {bf2f(m01[0]), bf2f(m01[1]), bf2f(m23[0]), bf2f(m23[1])};
#pragma unroll
    for (int c = 0; c < 4; ++c) { mx[c] = fmaxf(mx[c], __shfl_xor(mx[c], 16)); mx[c] = fmaxf(mx[c], __shfl_xor(mx[c], 32)); }
    if (lane < 16) *(LAS f32x4*)(cm + F.wave * 64 + 4 * lane) = (f32x4){mx[0], mx[1], mx[2], mx[3]};
#pragma unroll
    for (int j = 0; j < 16; ++j)
        asm volatile("" : "+v"(pk[j][0][0]), "+v"(pk[j][0][1]), "+v"(pk[j][1][0]), "+v"(pk[j][1][1]), "+v"(pk[j][2][0]), "+v"(pk[j][2][1]), "+v"(pk[j][3][0]), "+v"(pk[j][3][1]));
    LBAR();
    f32x4 cmx = (f32x4){0.f, 0.f, 0.f, 0.f};
#pragma unroll
    for (int w = 0; w < 8; ++w) { const f32x4 c4 = *(const LAS f32x4*)(cm + w * 64 + 4 * n16); cmx = __builtin_elementwise_max(cmx, c4); }
    float sc[4], iv[4];
#pragma unroll
    for (int c = 0; c < 4; ++c) { sc[c] = cmx[c] > 0.f ? cmx[c] * (1.0f / 127.0f) : 1.0f; iv[c] = 1.0f / sc[c]; }
    if (F.tid < 16 && colok) {
#pragma unroll
        for (int c = 0; c < 4; ++c) ds[dest_row(mode, n0 + 4 * F.tid + c)] = sc[c]; }
    const int sw = (n16 >> 1);
#pragma unroll
    for (int j = 0; j < 16; ++j) {
        unsigned o[4];
#pragma unroll
        for (int c = 0; c < 4; ++c) { unsigned x[4];
#pragma unroll
            for (int e4 = 0; e4 < 4; ++e4) { const unsigned wv = pk[j][e4][c >> 1]; const float xf = (c & 1) ? bfhi(wv) : bflo(wv); x[e4] = __builtin_bit_cast(unsigned, fmaf(xf, iv[c], 12582912.f)); }
            o[c] = __builtin_amdgcn_perm(x[1], x[0], 0x0c0c0400u) | __builtin_amdgcn_perm(x[3], x[2], 0x04000c0cu); }
        const int idx4 = (16 * F.wave + j) ^ sw;
#pragma unroll
        for (int c = 0; c < 4; ++c) qb[(4 * n16 + c) * 516 + 4 * idx4 + kq] = o[c];
    }
    LBAR();
#pragma unroll
    for (int q16 = 0; q16 < 16; ++q16) { const int p = F.tid + 512 * q16, n = p >> 7, c16 = p & 127;
        if (n0 + n < N) __builtin_nontemporal_store(*(const LAS u32x4*)(qb + n * 516 + 4 * (c16 ^ (n >> 3))), (u32x4*)(dq + (size_t)dest_row(mode, n0 + n) * D + 16 * c16)); }
    LBAR();
}
__device__ __forceinline__ void bg_loop(Frame& F, unsigned* ctl, const unsigned* sig, int limit) {
    LAS int* flag = (LAS int*)(F.lds + 140000);
    unsigned* head = ctl + CW_BG;
    __syncthreads();
    for (;;) {
        if (F.tid == 0) { int idx = -1;
            const bool stop = sig && __hip_atomic_load(sig, __ATOMIC_RELAXED, __HIP_MEMORY_SCOPE_AGENT) != 0u;
            if (!stop && (int)__hip_atomic_load(head, __ATOMIC_RELAXED, __HIP_MEMORY_SCOPE_AGENT) + BG_IN0 < limit) { idx = (int)__hip_atomic_fetch_add(head, 1u, __ATOMIC_RELAXED, __HIP_MEMORY_SCOPE_AGENT) + BG_IN0; if (idx >= BG_TOTAL) idx = -1; }
            *flag = idx; }
        __syncthreads();
        const int idx = *flag;
        __syncthreads();
        if (idx < 0) break;
        strip_item(F, idx);
    }
}
#ifndef MK_REPP0
#define MK_REPP0 0u
#endif
__device__ __forceinline__ void transpose_item(const float* W, int N, int k0, int n0, bf16* dst, int mode, LAS float* scr, int lane) {
    const bool nok = (n0 + lane) < N;
    const float* src = W + (size_t)k0 * N + n0 + lane;
#pragma unroll 8
    for (int i = 0; i < 64; ++i) scr[i * 65 + lane] = nok ? __builtin_nontemporal_load(src + (size_t)i * N) : 0.f;
    LDS_WAIT();
    const int c = lane & 7;
#pragma unroll
    for (int j = 0; j < 8; ++j) { const int nl = (lane >> 3) + 8 * j, n = n0 + nl; const LAS float* s = scr + (8 * c) * 65 + nl;
        u32x4 o; o.x = pk2(s[0 * 65], s[1 * 65]); o.y = pk2(s[2 * 65], s[3 * 65]); o.z = pk2(s[4 * 65], s[5 * 65]); o.w = pk2(s[6 * 65], s[7 * 65]);
        if (n < N) *(u32x4*)(dst + (size_t)dest_row(mode, n) * D + k0 + 8 * c) = o; }
    LDS_WAIT();
}
__device__ __forceinline__ void p0a(Frame& F) {
    const int gw = F.vcu * NWAVES + F.wave, NGW = F.G * NWAVES, lane = F.lane;
    for (int rep0 = 0; rep0 < 1 + (int)(MK_REPP0 & 1u); ++rep0) {
        LAS float* red = (LAS float*)F.lds;
        for (int it = F.vcu; it < DEPTH * 96; it += F.G) {
            const int l = it / 96, n0 = (it % 96) * 128;
            float acc[9][2];
#pragma unroll
            for (int r = 0; r < 9; ++r) { acc[r][0] = 0.f; acc[r][1] = 0.f; }
            for (int kb = 0; kb < 4; ++kb) {
                const int k0 = 256 * F.wave + 64 * kb;
                float sv[9];
#pragma unroll
                for (int r = 0; r < 8; ++r) sv[r] = silu_f(F.c[r * D + k0 + lane]);
                sv[8] = silu_f(F.c_ctx[k0 + lane]);
                const float* wp = F.w_ada + ((size_t)l * D + k0) * (6 * D) + n0 + 2 * lane;
#pragma unroll 4
                for (int kk = 0; kk < 64; ++kk) {
                    const f32x2 wv = __builtin_nontemporal_load((const f32x2*)(wp + (size_t)kk * (6 * D)));
#pragma unroll
                    for (int r = 0; r < 9; ++r) { const float s = __builtin_bit_cast(float, __builtin_amdgcn_readlane(__builtin_bit_cast(int, sv[r]), kk)); acc[r][0] += s * wv.x; acc[r][1] += s * wv.y; }
                }
            }
#pragma unroll
            for (int r = 0; r < 9; ++r) { red[(F.wave * 9 + r) * 128 + 2 * lane] = acc[r][0]; red[(F.wave * 9 + r) * 128 + 2 * lane + 1] = acc[r][1]; }
            __syncthreads();
            for (int o = F.tid; o < 9 * 128; o += NTHR) { const int r = o >> 7, col = o & 127; float s = 0.f;
#pragma unroll
                for (int w = 0; w < 8; ++w) s += red[(w * 9 + r) * 128 + col];
                W_MOD(F)[((size_t)l * 9 + r) * (6 * D) + n0 + col] = s + F.b_ada[(size_t)l * 6 * D + n0 + col]; }
            __syncthreads();
        }
    }
    {
        const int gid = (F.vcu * NTHR + F.tid);
        if (gid < 64 * 32) {
            const int pos = gid >> 5, f = gid & 31;
            double inv = 1.0; for (int i = 0; i < f; ++i) inv *= 0.74989420933245582730;
            const double xa = (double)pos * inv;
            const double q = __builtin_rint(xa * 0.63661977236758134308);
            double y = __builtin_fma(-q, 1.57079632679489655800, xa); y = __builtin_fma(-q, 6.12323399573676603587e-17, y);
            const double y2 = y * y;
            double sn = -1.0 / 1307674368000.0; sn = sn * y2 + 1.0 / 6227020800.0; sn = sn * y2 - 1.0 / 39916800.0; sn = sn * y2 + 1.0 / 362880.0; sn = sn * y2 - 1.0 / 5040.0; sn = sn * y2 + 1.0 / 120.0; sn = sn * y2 - 1.0 / 6.0; sn = sn * y2 + 1.0; sn *= y;
            double cs = 1.0 / 20922789888000.0; cs = cs * y2 - 1.0 / 87178291200.0; cs = cs * y2 + 1.0 / 479001600.0; cs = cs * y2 - 1.0 / 3628800.0; cs = cs * y2 + 1.0 / 40320.0; cs = cs * y2 - 1.0 / 720.0; cs = cs * y2 + 1.0 / 24.0; cs = cs * y2 - 0.5; cs = cs * y2 + 1.0;
            const int qi = ((int)q) & 3;
            const double c2 = (qi == 0) ? cs : (qi == 1) ? -sn : (qi == 2) ? -cs : sn;
            const double s2 = (qi == 0) ? sn : (qi == 1) ? cs : (qi == 2) ? -sn : -cs;
            W_ROPE(F)[gid] = (float)c2; W_ROPE(F)[2048 + gid] = (float)s2;
        }
    }
    {
        const int per = (NU - N_IN) * D / 16;
        for (int i = F.vcu * NTHR + F.tid; i < DEPTH * per; i += F.G * NTHR) { const int l = i / per, r = i % per;
            *(u32x4*)((signed char*)(F.ws + WS_WIN) + ((size_t)l * NU + N_IN) * D + (size_t)r * 16) = (u32x4){0u, 0u, 0u, 0u}; }
        for (int i = F.vcu * NTHR + F.tid; i < DEPTH * (NU - N_IN); i += F.G * NTHR) W_SIN(F)[(size_t)(i / (NU - N_IN)) * NU + N_IN + i % (NU - N_IN)] = 1.0f;
    }
    for (int rep1 = 0; rep1 < 1 + (int)((MK_REPP0 >> 1) & 1u); ++rep1) {
        LAS float* scr = (LAS float*)(F.lds + F.wave * 16640);
        constexpr int I_OUT = 32 * 32;
        for (int it = gw; it < DEPTH * I_OUT; it += NGW) {
            const int l = it / I_OUT, r = it % I_OUT;
            transpose_item(F.w_out + (size_t)l * D * D, D, (r >> 5) * 64, (r & 31) * 64, W_WOUT(F) + (size_t)l * D * D, 0, scr, lane);
        }
    }
    __syncthreads();
    for (int it = F.G - 1 - F.vcu; it < IN_ITEMS; it += F.G) strip_item(F, it);
    if (MK_REPP0 & 4u) { for (int it = F.vcu; it < BG_TOTAL; it += F.G) strip_item(F, it); }
    __syncthreads();
}

__device__ __forceinline__ void prenorm_row(Frame& F, int l, int m, const float (&xv)[32], int row) {
    const float r = 1.0f / sqrtf(row_sumsq(xv) * (1.0f / D) + EPS);
    const float* g = F.g_pre_mix + (size_t)l * D; const float* mod = W_MOD(F) + ((size_t)l * 9 + m) * (6 * D);
    float gv[32], shv[32], scv[32], hv[32];
    row_load_f32(g, F.lane, gv); row_load_f32(mod, F.lane, shv); row_load_f32(mod + D, F.lane, scv);
#pragma unroll
    for (int i = 0; i < 32; ++i) hv[i] = xv[i] * r * gv[i] * (1.0f + scv[i]) + shv[i];
    float am = 0.f;
#pragma unroll
    for (int i = 0; i < 32; ++i) am = fmaxf(am, fabsf(hv[i]));
    am = wave_max(am);
    const float scale = am > 0.f ? am * (1.0f / 127.0f) : 1.0f;
    row_store_i8(W_HQ(F) + (size_t)row * D, F.lane, hv, 1.0f / scale);
    if (F.lane == 0) W_HS(F)[row] = scale;
}
__device__ __forceinline__ void prenorm_row_cv(Frame& F, int l, int m, const float (&xv)[32], int row) {
    const bf16* cv = W_CV(F) + ((size_t)l * 9 + m) * 6 * D;
    float c4[32], c5[32], hv[32];
    row_load_bf16(cv + 4 * D, F.lane, c4); row_load_bf16(cv + 5 * D, F.lane, c5);
    const float r = 1.0f / sqrtf(row_sumsq(xv) * (1.0f / D) + EPS);
#pragma unroll
    for (int i = 0; i < 32; ++i) hv[i] = xv[i] * r * c4[i] + c5[i];
    float am = 0.f;
#pragma unroll
    for (int i = 0; i < 32; ++i) am = fmaxf(am, fabsf(hv[i]));
    am = wave_max(am);
    const float scale = am > 0.f ? am * (1.0f / 127.0f) : 1.0f;
    row_store_i8(W_HQ(F) + (size_t)row * D, F.lane, hv, 1.0f / scale);
    if (F.lane == 0) W_HS(F)[row] = scale;
}
__device__ __forceinline__ void p0b(Frame& F) {
    const int gw = F.vcu * NWAVES + F.wave, NGW = F.G * NWAVES;
    for (int i = F.vcu * NTHR + F.tid; i < DEPTH * 9 * (D / 8); i += F.G * NTHR) {
        const int lm = i / (D / 8), k0 = (i % (D / 8)) * 8, l = lm / 9; const float* mod = W_MOD(F) + (size_t)lm * (6 * D);
        bf16* cv = W_CV(F) + (size_t)lm * 6 * D + k0;
        float o[6][8];
#pragma unroll
        for (int e = 0; e < 8; ++e) { const int k = k0 + e;
            o[0][e] = mod[2 * D + k] * F.g_post_mix[(size_t)l * D + k]; o[1][e] = F.g_pre_ffn[(size_t)l * D + k] * (1.0f + mod[4 * D + k]); o[2][e] = mod[3 * D + k];
            o[3][e] = mod[5 * D + k] * F.g_post_ffn[(size_t)l * D + k]; o[4][e] = F.g_pre_mix[(size_t)l * D + k] * (1.0f + mod[D + k]); o[5][e] = mod[k]; }
#pragma unroll
        for (int v = 0; v < 6; ++v) { u32x4 w; w.x = pk2(o[v][0], o[v][1]); w.y = pk2(o[v][2], o[v][3]); w.z = pk2(o[v][4], o[v][5]); w.w = pk2(o[v][6], o[v][7]); *(u32x4*)(cv + (size_t)v * D) = w; }
    }
    for (int row = gw; row < NROW; row += 2 * NGW) {
        const int row2 = (row + NGW < NROW) ? row + NGW : row;
        const float* xp = row < NLAT ? F.x + (size_t)row * D : F.ctx + (size_t)(row - NLAT) * D; const int m = row < NLAT ? row / SEQ : 8;
        const float* xp2 = row2 < NLAT ? F.x + (size_t)row2 * D : F.ctx + (size_t)(row2 - NLAT) * D; const int m2 = row2 < NLAT ? row2 / SEQ : 8;
        float xv[32], xv2[32]; row_load_f32_nt(xp, F.lane, xv); row_load_f32_nt(xp2, F.lane, xv2);
        prenorm_row(F, 0, m, xv, row);
        prenorm_row(F, 0, m2, xv2, row2);
    }
}

#define MFMA16(a, b, c) __builtin_amdgcn_mfma_f32_16x16x32_bf16((a), (b), (c), 0, 0, 0)
__device__ __forceinline__ bf16x8 mk8(u32x2 lo, u32x2 hi) { u32x4 t; t.x = lo.x; t.y = lo.y; t.z = hi.x; t.w = hi.y; return __builtin_bit_cast(bf16x8, t); }
#define GLA_POS(i) (dir ? (nseg - 1 - (64 * cc + (i))) : (64 * cc + (i)))
struct PpIdx { int dir, h, cc, nseg, rowbase; bool lat; };
__device__ __forceinline__ PpIdx pp_idx(int un) { PpIdx I; const int cidx = un % 36, bhd = un / 36; I.dir = bhd & 1; I.h = (bhd >> 1) & 3; const int b = bhd >> 3; I.lat = cidx >= 4; I.cc = I.lat ? cidx - 4 : cidx; I.nseg = I.lat ? SEQ : CTXL; I.rowbase = I.lat ? b * SEQ : NLAT + b * CTXL; return I; }
#define PP_POS(I, i) ((I).dir ? ((I).nseg - 1 - (64 * (I).cc + (i))) : (64 * (I).cc + (i)))
struct PpRegs { u32x4 dec[4]; unsigned vw[16]; unsigned short qraw[16], kraw[16]; float wd[8]; float bd; };
__device__ __forceinline__ void pp_load_v(Frame& F, int un, PpRegs& R) {
    const PpIdx I = pp_idx(un); const int tid = F.tid; const bf16* U = W_U(F);
    { const int c15 = tid & 15, g1 = (tid >> 4) & 1;
#pragma unroll
      for (int it = 0; it < 4; ++it) R.dec[it] = *(const u32x4*)(U + (size_t)(I.rowbase + PP_POS(I, 16 * it + c15)) * NU + U_DEC + I.dir * 16 + 8 * g1); }
    const int vq = tid & 127, jp4 = tid >> 7;
#pragma unroll
    for (int jj = 0; jj < 16; ++jj) R.vw[jj] = *(const unsigned*)(U + (size_t)(I.rowbase + PP_POS(I, 16 * jp4 + jj)) * NU + U_VB + I.h * 256 + 2 * vq);
}
__device__ __forceinline__ void pp_load_w(Frame& F, int l, int un, PpRegs& R) {
    const PpIdx I = pp_idx(un); const int ch = I.h * 128 + 16 * F.wave + (F.tid & 15), g1 = (F.tid >> 4) & 1;
#pragma unroll
    for (int r = 0; r < 8; ++r) R.wd[r] = F.w_dec[(((size_t)l * 2 + I.dir) * DECR + 8 * g1 + r) * 512 + ch];
    R.bd = F.b_dec[((size_t)l * 2 + I.dir) * 512 + ch];
}
__device__ __forceinline__ void pp_load_qk(Frame& F, int un, PpRegs& R) {
    const PpIdx I = pp_idx(un); const int k = F.tid & 127, ip = F.tid >> 7; const bf16* U = W_U(F);
#pragma unroll
    for (int ii = 0; ii < 16; ++ii) { const bf16* rp = U + (size_t)(I.rowbase + PP_POS(I, 16 * ip + ii)) * NU; R.qraw[ii] = rp[U_QB + I.h * 128 + k]; R.kraw[ii] = rp[U_KB + I.h * 128 + k]; }
}
__device__ __forceinline__ void gla_prepass(Frame& F, int l, int un, int unx, PpRegs& R) {
    const int cidx = un % 36, bhd = un / 36, dir = bhd & 1, h = (bhd >> 1) & 3, b = bhd >> 3;
    const int tid = F.tid, lane = F.lane, w = F.wave, c15 = lane & 15, g = lane >> 4;
    LAS unsigned char* L = F.lds;
    LAS bf16* Qt = (LAS bf16*)(L);
    LAS bf16* Kt = (LAS bf16*)(L + 17408);
    LAS bf16* VT = (LAS bf16*)(L + 34816);
    LAS float* PS = (LAS float*)(L + 71680);
    LAS float* ZL = (LAS float*)(L + 73728);
    const bool lat = cidx >= 4; const int cc = lat ? cidx - 4 : cidx, nseg = lat ? SEQ : CTXL, rowbase = lat ? b * SEQ : NLAT + b * CTXL;
    const bool need_out = lat || (l == 0);
    const int k = tid & 127, ip = tid >> 7;
    bf16* GQ = (bf16*)(F.ws + WS_GQ) + (size_t)un * 8192; bf16* GK = (bf16*)(F.ws + WS_GK) + (size_t)un * 8192; bf16* GV = (bf16*)(F.ws + WS_GV) + (size_t)un * 16384; float* GD = (float*)(F.ws + WS_GD) + (size_t)un * 128;
    float rcs[16], rsn[16];
    { const float* COS = W_ROPE(F); const float* SIN = COS + 2048;
#pragma unroll
      for (int ii = 0; ii < 16; ++ii) { const int pos = GLA_POS(16 * ip + ii), pp = (k < 64) ? (pos >> 6) : (pos & 63); rcs[ii] = COS[pp * 32 + (k & 31)]; rsn[ii] = SIN[pp * 32 + (k & 31)]; } }
    {
        const int vq = tid & 127, jp4 = tid >> 7; unsigned vw[16];
#pragma unroll
        for (int jj = 0; jj < 16; ++jj) vw[jj] = R.vw[jj];
        u32x4 a0, a1, b0, b1;
        a0.x = (vw[0] & 0xffffu) | (vw[1] << 16); a0.y = (vw[2] & 0xffffu) | (vw[3] << 16); a0.z = (vw[4] & 0xffffu) | (vw[5] << 16); a0.w = (vw[6] & 0xffffu) | (vw[7] << 16);
        a1.x = (vw[8] & 0xffffu) | (vw[9] << 16); a1.y = (vw[10] & 0xffffu) | (vw[11] << 16); a1.z = (vw[12] & 0xffffu) | (vw[13] << 16); a1.w = (vw[14] & 0xffffu) | (vw[15] << 16);
        b0.x = (vw[0] >> 16) | (vw[1] & 0xffff0000u); b0.y = (vw[2] >> 16) | (vw[3] & 0xffff0000u); b0.z = (vw[4] >> 16) | (vw[5] & 0xffff0000u); b0.w = (vw[6] >> 16) | (vw[7] & 0xffff0000u);
        b1.x = (vw[8] >> 16) | (vw[9] & 0xffff0000u); b1.y = (vw[10] >> 16) | (vw[11] & 0xffff0000u); b1.z = (vw[12] >> 16) | (vw[13] & 0xffff0000u); b1.w = (vw[14] >> 16) | (vw[15] & 0xffff0000u);
        *(LAS u32x4*)(VT + (2 * vq) * 72 + 16 * jp4) = a0; *(LAS u32x4*)(VT + (2 * vq) * 72 + 16 * jp4 + 8) = a1;
        *(LAS u32x4*)(VT + (2 * vq + 1) * 72 + 16 * jp4) = b0; *(LAS u32x4*)(VT + (2 * vq + 1) * 72 + 16 * jp4 + 8) = b1;
    }
    {
        u32x4 bw;
        { float ws_[8];
#pragma unroll
          for (int j = 0; j < 8; ++j) { const float wv = R.wd[j]; const float hj = bflo(pk2(wv, wv)); ws_[j] = (g >= 2) ? wv - hj : wv; }
          bw.x = pk2(ws_[0], ws_[1]); bw.y = pk2(ws_[2], ws_[3]); bw.z = pk2(ws_[4], ws_[5]); bw.w = pk2(ws_[6], ws_[7]); }
        const bf16x8 bop = __builtin_bit_cast(bf16x8, bw); const float bdv = R.bd;
#pragma unroll
        for (int it = 0; it < 4; ++it) {
            const f32x4 z4 = MFMA16(__builtin_bit_cast(bf16x8, R.dec[it]), bop, ((f32x4){bdv, bdv, bdv, bdv}));
#pragma unroll
            for (int rg = 0; rg < 4; ++rg) { const float z = z4[rg];
                const float e = __builtin_amdgcn_exp2f(fabsf(z) * -1.4426950408889634f);
                ZL[(16 * it + 4 * g + rg) * 132 + 16 * w + c15] = (fminf(z, 0.0f) * 1.4426950408889634f - __builtin_amdgcn_logf(1.0f + e)) * (1.0f / 16.0f); }
        }
    }
    asm volatile("" ::: "memory");
    pp_load_v(F, unx, R);
    pp_load_w(F, l, unx, R);
    LBAR();
    float bloc[16]; float run = 0.f;
#pragma unroll
    for (int ii = 0; ii < 16; ++ii) { run += ZL[(16 * ip + ii) * 132 + k]; bloc[ii] = run; }
    PS[ip * 128 + k] = run;
    LBAR();
    {
        float off = 0.f, btot = 0.f;
#pragma unroll
        for (int p = 0; p < 4; ++p) { const float s = PS[p * 128 + k]; btot += s; if (p < ip) off += s; }
        const float etot = __builtin_amdgcn_exp2f(btot);
        if (ip == 0) GD[k] = etot;
        unsigned short kh[16];
        float qpart[16], kpart[16];
        if (lat) {
#pragma unroll
            for (int ii = 0; ii < 16; ++ii) { qpart[ii] = __shfl_xor(bf2f(R.qraw[ii]), 32); kpart[ii] = __shfl_xor(bf2f(R.kraw[ii]), 32); }
            asm volatile("" ::: "memory");
        }
#pragma unroll
        for (int ii = 0; ii < 16; ++ii) {
            const int i = 16 * ip + ii; const float bb = bloc[ii] + off;
            float qv = bf2f(R.qraw[ii]), kv = bf2f(R.kraw[ii]);
            if (lat) {
                const float cs = rcs[ii], sn = rsn[ii];
                const float qo = qpart[ii], ko = kpart[ii];
                qv = qv * cs + ((k & 32) ? qo : -qo) * sn; kv = kv * cs + ((k & 32) ? ko : -ko) * sn;
            }
            const float eb = __builtin_amdgcn_exp2f(bb), kt = kv * __builtin_amdgcn_rcpf(eb);
            Qt[i * 136 + k] = (bf16)f2bf(qv * 0.08838834764831845f * eb);
            Kt[i * 136 + k] = (bf16)f2bf(kt);
            kh[ii] = (unsigned short)f2bf(kt * etot);
        }
        u32x4 w0, w1;
        w0.x = kh[0] | ((unsigned)kh[1] << 16); w0.y = kh[2] | ((unsigned)kh[3] << 16); w0.z = kh[4] | ((unsigned)kh[5] << 16); w0.w = kh[6] | ((unsigned)kh[7] << 16);
        w1.x = kh[8] | ((unsigned)kh[9] << 16); w1.y = kh[10] | ((unsigned)kh[11] << 16); w1.z = kh[12] | ((unsigned)kh[13] << 16); w1.w = kh[14] | ((unsigned)kh[15] << 16);
        *(u32x4*)(GK + k * 64 + 16 * ip) = w0; *(u32x4*)(GK + k * 64 + 16 * ip + 8) = w1;
    }
    asm volatile("" ::: "memory");
    pp_load_qk(F, unx, R);
    {
        const int v = tid >> 1, hf = tid & 1; const LAS bf16* sp = VT + v * 72 + 32 * hf; bf16* dp = GV + v * 64 + 32 * hf;
#pragma unroll
        for (int q = 0; q < 4; ++q) *(u32x4*)(dp + 8 * q) = *(const LAS u32x4*)(sp + 8 * q);
    }
    LBAR();
    if (need_out) {
        {
#pragma unroll
            for (int q = 0; q < 2; ++q) { const int p = tid + 512 * q, i = p >> 4, c8 = (p & 15) * 8; *(u32x4*)(GQ + i * 128 + c8) = *(const LAS u32x4*)(Qt + i * 136 + c8); }
        }
        const int ib = w & 3, vh = w >> 2;
        bf16x8 qf[4];
#pragma unroll
        for (int ks = 0; ks < 4; ++ks) qf[ks] = *(const LAS bf16x8*)(Qt + (16 * ib + c15) * 136 + 32 * ks + 8 * g);
        f32x4 at[4];
#pragma unroll
        for (int jb = 0; jb < 4; ++jb) { at[jb] = (f32x4){0.f, 0.f, 0.f, 0.f};
#pragma unroll
            for (int ks = 0; ks < 4; ++ks) { const bf16x8 a = *(const LAS bf16x8*)(Kt + (16 * jb + c15) * 136 + 32 * ks + 8 * g); at[jb] = MFMA16(a, qf[ks], at[jb]); }
#pragma unroll
            for (int rg = 0; rg < 4; ++rg) if (16 * jb + 4 * g + rg > 16 * ib + c15) at[jb][rg] = 0.f; }
        bf16x8 pf[2];
#pragma unroll
        for (int k2 = 0; k2 < 2; ++k2) { u32x4 t; t.x = pk2(at[2 * k2][0], at[2 * k2][1]); t.y = pk2(at[2 * k2][2], at[2 * k2][3]); t.z = pk2(at[2 * k2 + 1][0], at[2 * k2 + 1][1]); t.w = pk2(at[2 * k2 + 1][2], at[2 * k2 + 1][3]); pf[k2] = __builtin_bit_cast(bf16x8, t); }
        bf16* op = W_OB(F) + ((size_t)dir * NROW + rowbase + GLA_POS(16 * ib + c15)) * (HB * DVB) + h * 256 + 4 * g;
#pragma unroll
        for (int vt = 0; vt < 8; ++vt) { const int vtile = 8 * vh + vt; f32x4 o = (f32x4){0.f, 0.f, 0.f, 0.f};
#pragma unroll
            for (int k2 = 0; k2 < 2; ++k2) { const LAS bf16* vp = VT + (16 * vtile + c15) * 72 + 32 * k2 + 4 * g; o = MFMA16(mk8(*(const LAS u32x2*)vp, *(const LAS u32x2*)(vp + 16)), pf[k2], o); }
            u32x2 ov; ov.x = pk2(o[0], o[1]); ov.y = pk2(o[2], o[3]);
            *(u32x2*)(op + 16 * vtile) = ov; }
    }
    LBAR();
}
struct ChRegs { u32x4 rq[2], rk[2], rv; u32x2 oi[2]; };
__device__ __forceinline__ void gla_chain(Frame& F, int l, int ch, bool dry) {
    const int b = ch >> 5, h = (ch >> 3) & 3, dir = (ch >> 2) & 1, vs = ch & 3;
    const int tid = F.tid, lane = F.lane, w = F.wave, c15 = lane & 15, g = lane >> 4;
    LAS unsigned char* L = F.lds;
    constexpr int BUFB = 45056;
    LAS float* DKall = (LAS float*)(L + 2 * BUFB + 2 * 17408);
    LAS unsigned char* PART = L + 2 * BUFB;
    const int un0 = (((b * 4 + h) * 2) + dir) * 36;
    const bf16* GQ = (const bf16*)(F.ws + WS_GQ) + (size_t)un0 * 8192; const bf16* GK = (const bf16*)(F.ws + WS_GK) + (size_t)un0 * 8192;
    const bf16* GV = (const bf16*)(F.ws + WS_GV) + (size_t)un0 * 16384 + (size_t)vs * 4096; const float* GD = (const float*)(F.ws + WS_GD) + (size_t)un0 * 128;
    const int vt4 = w & 3, kq = w >> 2;
    bf16* OBd = W_OB(F) + (size_t)dir * NROW * (HB * DVB) + h * 256 + vs * 64 + 16 * vt4 + 4 * g;
    bf16* OBs = dry ? (bf16*)(F.ws + WS_DUMMY) + (size_t)dir * NROW * (HB * DVB) + h * 256 + vs * 64 + 16 * vt4 + 4 * g : OBd;
    f32x4 sacc[4];
#pragma unroll
    for (int t = 0; t < 4; ++t) sacc[t] = (f32x4){0.f, 0.f, 0.f, 0.f};
    for (int i = tid; i < 36 * 128; i += NTHR) DKall[i] = GD[i];
#define CH_OROW(c, it) (((c) >= 4 ? b * SEQ : NLAT + b * CTXL) + (dir ? (((c) >= 4 ? SEQ : CTXL) - 1 - (64 * ((c) >= 4 ? (c) - 4 : (c)) + 16 * (it) + c15)) : (64 * ((c) >= 4 ? (c) - 4 : (c)) + 16 * (it) + c15)))
#define CH_LOAD(R, c) do { const bool no_ = (c) >= 4 || l == 0; \
        _Pragma("unroll") for (int q_ = 0; q_ < 2; ++q_) { const int p_ = tid + 512 * q_; if (no_) R.rq[q_] = *(const u32x4*)(GQ + (size_t)(c) * 8192 + p_ * 8); R.rk[q_] = *(const u32x4*)(GK + (size_t)(c) * 8192 + p_ * 8); } \
        R.rv = *(const u32x4*)(GV + (size_t)(c) * 16384 + tid * 8); \
        if (no_) { R.oi[0] = *(const u32x2*)(OBd + (size_t)CH_OROW(c, 2 * kq) * (HB * DVB)); R.oi[1] = *(const u32x2*)(OBd + (size_t)CH_OROW(c, 2 * kq + 1) * (HB * DVB)); } } while (0)
#define CH_PUT(R, bs) do { LAS unsigned char* B_ = L + (bs) * BUFB; \
        _Pragma("unroll") for (int q_ = 0; q_ < 2; ++q_) { const int p_ = tid + 512 * q_; *(LAS u32x4*)((LAS bf16*)B_ + (p_ >> 4) * 136 + (p_ & 15) * 8) = R.rq[q_]; *(LAS u32x4*)((LAS bf16*)(B_ + 17408) + (p_ >> 3) * 72 + (p_ & 7) * 8) = R.rk[q_]; } \
        *(LAS u32x4*)((LAS bf16*)(B_ + 35840) + (tid >> 3) * 72 + (tid & 7) * 8) = R.rv; } while (0)
#define CH_FIN(cp, par) do { \
        const f32x4 pp0_ = *(const LAS f32x4*)(PART + (par) * 16384 + ((w ^ 4) * 2 + 0) * 1024 + lane * 16), pp1_ = *(const LAS f32x4*)(PART + (par) * 16384 + ((w ^ 4) * 2 + 1) * 1024 + lane * 16); \
        { const f32x4 o = pown[0] + pp0_; u32x2 ov; ov.x = pk2(o[0] + bflo(poi[0].x), o[1] + bfhi(poi[0].x)); ov.y = pk2(o[2] + bflo(poi[0].y), o[3] + bfhi(poi[0].y)); *(u32x2*)(OBs + (size_t)CH_OROW(cp, 2 * kq) * (HB * DVB)) = ov; } \
        { const f32x4 o = pown[1] + pp1_; u32x2 ov; ov.x = pk2(o[0] + bflo(poi[1].x), o[1] + bfhi(poi[1].x)); ov.y = pk2(o[2] + bflo(poi[1].y), o[3] + bfhi(poi[1].y)); *(u32x2*)(OBs + (size_t)CH_OROW(cp, 2 * kq + 1) * (HB * DVB)) = ov; } } while (0)
#define CH_STEP(cidx, RC, RN) do { \
        const bool need_out_ = (cidx) >= 4 || l == 0; const int bs_ = (cidx) & 1; \
        LAS unsigned char* B = L + bs_ * BUFB; \
        const LAS bf16* Qt = (const LAS bf16*)B; const LAS bf16* KhT = (const LAS bf16*)(B + 17408); const LAS bf16* VTs = (const LAS bf16*)(B + 35840); const LAS float* Dk = DKall + (cidx) * 128; \
        if (pend) CH_FIN((cidx) - 1, bs_ ^ 1);                                \
        const u32x2 oi0_ = RC.oi[0], oi1_ = RC.oi[1];                       \
        if ((cidx) + 2 < 36) CH_LOAD(RC, (cidx) + 2);                         \
        if (need_out_) {                                                      \
            bf16x8 sop[2], qop[4][2]; \
            _Pragma("unroll") for (int k2 = 0; k2 < 2; ++k2) { u32x4 t_; t_.x = pk2(sacc[2 * k2][0], sacc[2 * k2][1]); t_.y = pk2(sacc[2 * k2][2], sacc[2 * k2][3]); t_.z = pk2(sacc[2 * k2 + 1][0], sacc[2 * k2 + 1][1]); t_.w = pk2(sacc[2 * k2 + 1][2], sacc[2 * k2 + 1][3]); sop[k2] = __builtin_bit_cast(bf16x8, t_); } \
            _Pragma("unroll") for (int x4 = 0; x4 < 4; ++x4) { const int it_ = (x4 < 2) ? 2 * kq + x4 : 2 * (1 - kq) + (x4 - 2);     \
                _Pragma("unroll") for (int k2 = 0; k2 < 2; ++k2) { const LAS bf16* qp_ = Qt + (16 * it_ + c15) * 136 + 16 * (4 * kq + 2 * k2) + 4 * g; qop[x4][k2] = mk8(*(const LAS u32x2*)qp_, *(const LAS u32x2*)(qp_ + 16)); } } \
            asm volatile("" ::: "memory"); \
            f32x4 pa_[4]; \
            _Pragma("unroll") for (int x4 = 0; x4 < 4; ++x4) { pa_[x4] = MFMA16(sop[0], qop[x4][0], ((f32x4){0.f, 0.f, 0.f, 0.f})); pa_[x4] = MFMA16(sop[1], qop[x4][1], pa_[x4]); } \
            pown[0] = pa_[0]; pown[1] = pa_[1]; \
            *(LAS f32x4*)(PART + bs_ * 16384 + (w * 2 + 0) * 1024 + lane * 16) = pa_[2]; *(LAS f32x4*)(PART + bs_ * 16384 + (w * 2 + 1) * 1024 + lane * 16) = pa_[3]; \
        } \
        poi[0] = oi0_; poi[1] = oi1_; pend = need_out_; \
        { bf16x8 va[2], kb[4][2]; f32x4 dk[4]; \
        _Pragma("unroll") for (int k2 = 0; k2 < 2; ++k2) va[k2] = *(const LAS bf16x8*)(VTs + (16 * vt4 + c15) * 72 + 32 * k2 + 8 * g); \
        _Pragma("unroll") for (int t4 = 0; t4 < 4; ++t4) { dk[t4] = *(const LAS f32x4*)(Dk + 16 * (4 * kq + t4) + 4 * g); _Pragma("unroll") for (int k2 = 0; k2 < 2; ++k2) kb[t4][k2] = *(const LAS bf16x8*)(KhT + (16 * (4 * kq + t4) + c15) * 72 + 32 * k2 + 8 * g); } \
        asm volatile("" ::: "memory"); \
        _Pragma("unroll") for (int t4 = 0; t4 < 4; ++t4) { \
            sacc[t4] = sacc[t4] * dk[t4]; \
            _Pragma("unroll") for (int k2 = 0; k2 < 2; ++k2) sacc[t4] = MFMA16(kb[t4][k2], va[k2], sacc[t4]); } } \
        if ((cidx) + 1 < 36) CH_PUT(RN, bs_ ^ 1);                             \
        LBAR(); \
    } while (0)
    ChRegs RA, RB;
    RA.rq[0] = RA.rq[1] = RB.rq[0] = RB.rq[1] = (u32x4){0u, 0u, 0u, 0u}; RA.oi[0] = RA.oi[1] = RB.oi[0] = RB.oi[1] = (u32x2){0u, 0u};
    f32x4 pown[2]; u32x2 poi[2]; bool pend = false;
    pown[0] = pown[1] = (f32x4){0.f, 0.f, 0.f, 0.f}; poi[0] = poi[1] = (u32x2){0u, 0u};
    CH_LOAD(RA, 0); CH_PUT(RA, 0); CH_LOAD(RB, 1);
    LBAR();
    for (int c2 = 0; c2 < 36; c2 += 2) {
        CH_STEP(c2, RA, RB);
        CH_STEP(c2 + 1, RB, RA);
    }
    if (pend) CH_FIN(35, 1);
#undef CH_LOAD
#undef CH_PUT
#undef CH_FIN
#undef CH_STEP
#undef CH_OROW
}
#undef GLA_POS

__device__ __forceinline__ int clampi(int v, int lo, int hi) { return v < lo ? lo : (v > hi ? hi : v); }
typedef short s16x4 __attribute__((ext_vector_type(4)));
#define ATT_TR(p) __builtin_bit_cast(u32x2, __builtin_amdgcn_ds_read_tr16_b64_v4i16((LAS s16x4*)(p)))
template <int NB, bool LOCAL>
__device__ __forceinline__ void attn_tile(const LAS bf16* Kt, const LAS bf16* Vt, const LAS float* bias_row, const bf16x8 (&qf)[2], int kb0, const int (&dco)[8], int c15, int g, float& m_run, float& l_run, f32x4 (&oacc)[4]) {
    f32x4 sc[NB];
    {
        bf16x8 kf[NB][2]; float bv[NB][4];
#pragma unroll
        for (int nb = 0; nb < NB; ++nb) {
#pragma unroll
            for (int s = 0; s < 2; ++s) kf[nb][s] = *(const LAS bf16x8*)(Kt + (kb0 + 16 * nb + c15) * 72 + 32 * s + 8 * g);
            if (LOCAL) {
#pragma unroll
                for (int rg = 0; rg < 4; ++rg) bv[nb][rg] = bias_row[dco[(4 * nb + rg) & 7]]; } }
        asm volatile("" ::: "memory");
#pragma unroll
        for (int nb = 0; nb < NB; ++nb) { sc[nb] = (f32x4){0.f, 0.f, 0.f, 0.f};
#pragma unroll
            for (int s = 0; s < 2; ++s) sc[nb] = MFMA16(kf[nb][s], qf[s], sc[nb]);
#pragma unroll
            for (int rg = 0; rg < 4; ++rg) sc[nb][rg] = sc[nb][rg] * 0.18033688011112042f + (LOCAL ? bv[nb][rg] : 0.f); }
    }
    float mt = -1e30f;
#pragma unroll
    for (int nb = 0; nb < NB; ++nb)
#pragma unroll
        for (int rg = 0; rg < 4; ++rg) mt = fmaxf(mt, sc[nb][rg]);
    mt = fmaxf(mt, __shfl_xor(mt, 16)); mt = fmaxf(mt, __shfl_xor(mt, 32));
    const float m_new = fmaxf(m_run, mt), alpha = __builtin_amdgcn_exp2f(m_run - m_new);
    m_run = m_new; float ps = 0.f;
#pragma unroll
    for (int nb = 0; nb < NB; ++nb)
#pragma unroll
        for (int rg = 0; rg < 4; ++rg) { const float p = __builtin_amdgcn_exp2f(sc[nb][rg] - m_new); sc[nb][rg] = p; ps += p; }
    l_run = l_run * alpha + ps;
    bf16x8 pf[NB / 2];
#pragma unroll
    for (int k2 = 0; k2 < NB / 2; ++k2) { u32x4 tt; tt.x = pk2(sc[2 * k2][0], sc[2 * k2][1]); tt.y = pk2(sc[2 * k2][2], sc[2 * k2][3]); tt.z = pk2(sc[2 * k2 + 1][0], sc[2 * k2 + 1][1]); tt.w = pk2(sc[2 * k2 + 1][2], sc[2 * k2 + 1][3]); pf[k2] = __builtin_bit_cast(bf16x8, tt); }
    {
        bf16x8 vf[4][NB / 2];
#pragma unroll
        for (int d = 0; d < 4; ++d)
#pragma unroll
            for (int k2 = 0; k2 < NB / 2; ++k2) { const LAS bf16* vp = Vt + (kb0 + 32 * k2 + 4 * g + (c15 >> 2)) * 80 + 16 * d + 4 * (c15 & 3);
                vf[d][k2] = mk8(ATT_TR(vp), ATT_TR(vp + 16 * 80)); }
        asm volatile("" ::: "memory");
#pragma unroll
        for (int d = 0; d < 4; ++d) { oacc[d] = oacc[d] * alpha;
#pragma unroll
            for (int k2 = 0; k2 < NB / 2; ++k2) oacc[d] = MFMA16(vf[d][k2], pf[k2], oacc[d]); }
    }
}
__device__ __forceinline__ void attn_unit(Frame& F, int l, int u) {
    const int tid = F.tid, lane = F.lane, w = F.wave, c15 = lane & 15, g = lane >> 4;
    LAS unsigned char* L = F.lds;
    LAS bf16* Ks = (LAS bf16*)L;
    LAS bf16* VTs = (LAS bf16*)(L + 18432);
    LAS float* rpbs = (LAS float*)(L + 38912);
    const bool isctx = u >= 1024;
    int b, h, r0 = 0, qb = 0;
    if (!isctx) { b = u >> 7; h = (u >> 4) & 7; r0 = (u & 15) * 2; } else { const int cu = u - 1024; b = cu >> 4; h = (cu >> 1) & 7; qb = cu & 1; }
    const int r = r0 + (w >> 2), cq = 16 * (w & 3) + c15;
    const int qrow = isctx ? NLAT + b * CTXL + qb * 128 + 16 * w + c15 : b * SEQ + r * 64 + cq;
    bf16x8 qf[2];
#pragma unroll
    for (int s = 0; s < 2; ++s) qf[s] = *(const bf16x8*)(W_U(F) + (size_t)qrow * NU + U_QA + h * 64 + 32 * s + 8 * g);
    int lo = 0, nloc = 0, rs = 0;
    if (!isctx) { lo = clampi(r0 - 4, 0, 24); nloc = clampi(r0 - 3, 0, 24) + 8 - lo; rs = clampi(r - 4, 0, 24); }
    const int ntiles = nloc + 4, cs0 = clampi(cq - 8, 0, 48), kb0 = clampi(16 * (w & 3) - 8, 0, 32);
    if (!isctx) for (int i = tid; i < 15 * 32; i += NTHR) { const int rr = i >> 5, cc2 = i & 31; rpbs[i] = cc2 < 31 ? F.rpb[((size_t)l * HA + h) * 465 + rr * 31 + cc2] * 1.4426950408889634f : -1e30f; }
    int dco[8];
#pragma unroll
    for (int e8 = 0; e8 < 8; ++e8) { const int ck = kb0 + 16 * (e8 >> 2) + 4 * g + (e8 & 3); dco[e8] = (ck >= cs0 && ck < cs0 + 16) ? clampi(ck - cq + 15, 0, 30) : 31; }
    const int key = tid >> 3, ch8 = (tid & 7) * 8;
#define ATT_ROW(t) ((t) < nloc ? b * SEQ + (lo + (t)) * 64 + key : NLAT + b * CTXL + ((t) - nloc) * 64 + key)
#define ATT_PUT(KR, VR, buf) do { *(LAS u32x4*)(Ks + (buf) * 4608 + key * 72 + ch8) = KR; *(LAS u32x4*)(VTs + (buf) * 5120 + key * 80 + ch8) = VR; } while (0)
#define ATT_LD(KR, VR, t) do { if ((t) < ntiles) { const bf16* rp_ = W_U(F) + (size_t)ATT_ROW(t) * NU + h * 64 + ch8; KR = *(const u32x4*)(rp_ + U_KA); VR = *(const u32x4*)(rp_ + U_VA); } } while (0)
#define ATT_STEP(t, KN, VN) do { if ((t) < ntiles) { const int buf = (t) & 1; const bool local = (t) < nloc; const int kr = lo + (t); \
        const bool active = !local || (kr >= rs && kr <= rs + 7); \
        if (active) { \
            if (local) attn_tile<2, true>(Ks + buf * 4608, VTs + buf * 5120, rpbs + (kr - r + 7) * 32, qf, kb0, dco, c15, g, m_run, l_run, oacc); \
            else attn_tile<4, false>(Ks + buf * 4608, VTs + buf * 5120, rpbs, qf, 0, dco, c15, g, m_run, l_run, oacc); \
        } \
        if ((t) + 1 < ntiles) ATT_PUT(KN, VN, buf ^ 1); \
        ATT_LD(KN, VN, (t) + 4); \
        LBAR(); } } while (0)
    u32x4 k0 = (u32x4){0u, 0u, 0u, 0u}, v0 = k0, k1 = k0, v1 = k0, k2 = k0, v2 = k0;
    ATT_LD(k0, v0, 0);
    ATT_PUT(k0, v0, 0);
    ATT_LD(k1, v1, 1); ATT_LD(k2, v2, 2); ATT_LD(k0, v0, 3);
    LBAR();
    float m_run = -1e30f, l_run = 0.f;
    f32x4 oacc[4];
#pragma unroll
    for (int d = 0; d < 4; ++d) oacc[d] = (f32x4){0.f, 0.f, 0.f, 0.f};
    for (int t3 = 0; t3 < ntiles; t3 += 3) {
        ATT_STEP(t3, k1, v1);
        ATT_STEP(t3 + 1, k2, v2);
        ATT_STEP(t3 + 2, k0, v0);
    }
#undef ATT_LD
#undef ATT_STEP
    float lt = l_run; lt += __shfl_xor(lt, 16); lt += __shfl_xor(lt, 32);
    const float inv = 1.0f / lt;
#pragma unroll
    for (int d = 0; d < 4; ++d) { u32x2 ov; ov.x = pk2(oacc[d][0] * inv, oacc[d][1] * inv); ov.y = pk2(oacc[d][2] * inv, oacc[d][3] * inv);
        *(u32x2*)(W_MIX(F) + (size_t)qrow * D + MIX_A + h * 64 + 16 * d + 4 * g) = ov; }
#undef ATT_ROW
#undef ATT_PUT
}

__device__ __forceinline__ void gmlp_unit(Frame& F, int l, int u) {
    const int tid = F.tid, lane = F.lane, w = F.wave, c15 = lane & 15, g = lane >> 4;
    LAS bf16* Wl = (LAS bf16*)F.lds;
    LAS bf16* VTl = (LAS bf16*)(F.lds + 34816);
    int rowbase, gg;
    if (u < 512) { const int b = u >> 6, n = (u >> 2) & 15; gg = u & 3; rowbase = b * SEQ + n * MIXC; } else { const int cu = u - 512, b = cu >> 3, n = (cu >> 2) & 1; gg = cu & 3; rowbase = NLAT + b * CTXL + n * MIXC; }
    {
        const int p = tid >> 2, q0 = (tid & 3) * 32; const float* wp = F.w_sp + (((size_t)l * GC + gg) * MIXC + p) * MIXC + q0;
#pragma unroll
        for (int j = 0; j < 4; ++j) { const f32x4 a = *(const f32x4*)(wp + 8 * j), b2 = *(const f32x4*)(wp + 8 * j + 4); u32x4 o; o.x = pk2(a[0], a[1]); o.y = pk2(a[2], a[3]); o.z = pk2(b2[0], b2[1]); o.w = pk2(b2[2], b2[3]); *(LAS u32x4*)(Wl + p * 136 + q0 + 8 * j) = o; }
    }
    {
        const int pos = tid >> 2, c0 = (tid & 3) * 32; const bf16* vp = W_U(F) + (size_t)(rowbase + pos) * NU + U_VC + gg * CG + c0;
        float xv[32];
#pragma unroll
        for (int j = 0; j < 4; ++j) { const u32x4 a = *(const u32x4*)(vp + 8 * j);
            xv[8 * j + 0] = gelu_tanh(bflo(a.x)); xv[8 * j + 1] = gelu_tanh(bfhi(a.x)); xv[8 * j + 2] = gelu_tanh(bflo(a.y)); xv[8 * j + 3] = gelu_tanh(bfhi(a.y));
            xv[8 * j + 4] = gelu_tanh(bflo(a.z)); xv[8 * j + 5] = gelu_tanh(bfhi(a.z)); xv[8 * j + 6] = gelu_tanh(bflo(a.w)); xv[8 * j + 7] = gelu_tanh(bfhi(a.w)); }
        float s = 0.f;
#pragma unroll
        for (int i = 0; i < 32; ++i) s += xv[i];
        s += __shfl_xor(s, 1); s += __shfl_xor(s, 2);
        const float mu = s * (1.0f / CG); float q = 0.f;
#pragma unroll
        for (int i = 0; i < 32; ++i) { const float d = xv[i] - mu; q += d * d; }
        q += __shfl_xor(q, 1); q += __shfl_xor(q, 2);
        const float rstd = 1.0f / sqrtf(q * (1.0f / CG) + EPS);
        const float* lg = F.ln_v_g + (size_t)l * (GC * CG) + gg * CG + c0; const float* lb = F.ln_v_b + (size_t)l * (GC * CG) + gg * CG + c0;
#pragma unroll
        for (int i = 0; i < 32; ++i) VTl[(c0 + i) * 136 + pos] = (bf16)f2bf((xv[i] - mu) * rstd * lg[i] + lb[i]);
    }
    __syncthreads();
    {
        const int pos = 16 * w + c15, row = rowbase + pos;
        const float bsp = F.b_sp[((size_t)l * GC + gg) * MIXC + pos];
        bf16x8 wf[4];
#pragma unroll
        for (int ks = 0; ks < 4; ++ks) wf[ks] = *(const LAS bf16x8*)(Wl + pos * 136 + 32 * ks + 8 * g);
        u32x2 uu8[8];
#pragma unroll
        for (int cb = 0; cb < 8; ++cb) uu8[cb] = *(const u32x2*)(W_U(F) + (size_t)row * NU + U_UC + gg * CG + 16 * cb + 4 * g);
#pragma unroll
        for (int cb = 0; cb < 8; ++cb) { f32x4 acc = (f32x4){0.f, 0.f, 0.f, 0.f};
#pragma unroll
            for (int ks = 0; ks < 4; ++ks) { const bf16x8 a = *(const LAS bf16x8*)(VTl + (16 * cb + c15) * 136 + 32 * ks + 8 * g); acc = MFMA16(a, wf[ks], acc); }
            const int col = gg * CG + 16 * cb + 4 * g;
            const u32x2 uu = uu8[cb];
            u32x2 ov; ov.x = pk2(gelu_tanh(bflo(uu.x)) * (acc[0] + bsp), gelu_tanh(bfhi(uu.x)) * (acc[1] + bsp)); ov.y = pk2(gelu_tanh(bflo(uu.y)) * (acc[2] + bsp), gelu_tanh(bfhi(uu.y)) * (acc[3] + bsp));
            *(u32x2*)(W_MIX(F) + (size_t)row * D + MIX_C + col) = ov; }
    }
    __syncthreads();
}

#ifndef MK_REPMIX
#define MK_REPMIX 0u
#endif
__device__ __forceinline__ void p_mixers(Frame& F, int l) {
    for (int rep = 0; rep < 1 + (int)(MK_REPMIX & 1u); ++rep) { PpRegs R; int un = F.vcu; if (un < 2304) { pp_load_v(F, un, R); pp_load_w(F, l, un, R); pp_load_qk(F, un, R); } for (; un < 2304; un += F.G) { launder(F); gla_prepass(F, l, un, (un + F.G < 2304) ? un + F.G : un, R); } }
    const int na = (l == 0) ? 1152 : 1024, nc = (l == 0) ? 576 : 512;
    for (int rep = 0; rep < 1 + (int)((MK_REPMIX >> 1) & 1u); ++rep) { for (int u = F.vcu; u < na; u += F.G) attn_unit(F, l, u); }
    __syncthreads();
    for (int rep = 0; rep < 1 + (int)((MK_REPMIX >> 2) & 1u); ++rep) { for (int u = (F.vcu + F.G / 2) % F.G; u < nc; u += F.G) gmlp_unit(F, l, u); }
}
__device__ __forceinline__ void p_chains(Frame& F, int l) {
    for (int rep = 0; rep < 1 + (int)((MK_REPMIX >> 3) & 1u); ++rep) for (int ch = F.vcu; ch < 256; ch += F.G) { gla_chain(F, l, ch, rep + 1 < 1 + (int)((MK_REPMIX >> 3) & 1u)); __syncthreads(); }
}

__device__ __forceinline__ void p_glaout(Frame& F, int l) {
    const int gw = F.vcu * NWAVES + F.wave, NGW = F.G * NWAVES, lane = F.lane, nrows = (l == 0) ? NROW : NLAT;
    for (int row = gw; row < nrows; row += NGW) {
#pragma unroll
        for (int j = 0; j < 2; ++j) { const int idx = 512 * j + 8 * lane;
            const u32x4 a = __builtin_nontemporal_load((const u32x4*)(W_OB(F) + (size_t)row * 1024 + idx)), b2 = __builtin_nontemporal_load((const u32x4*)(W_OB(F) + ((size_t)NROW + row) * 1024 + idx));
            float o[8]; o[0] = bflo(a.x) + bflo(b2.x); o[1] = bfhi(a.x) + bfhi(b2.x); o[2] = bflo(a.y) + bflo(b2.y); o[3] = bfhi(a.y) + bfhi(b2.y); o[4] = bflo(a.z) + bflo(b2.z); o[5] = bfhi(a.z) + bfhi(b2.z); o[6] = bflo(a.w) + bflo(b2.w); o[7] = bfhi(a.w) + bfhi(b2.w);
            float ss = 0.f;
#pragma unroll
            for (int e = 0; e < 8; ++e) ss += o[e] * o[e];
#pragma unroll
            for (int s = 1; s < 32; s <<= 1) ss += __shfl_xor(ss, s);
            const float rn = 1.0f / sqrtf(ss * (1.0f / DVB) + EPS);
            const float* gp = F.g_gla + (size_t)l * 1024 + idx; const f32x4 g0 = *(const f32x4*)gp, g1 = *(const f32x4*)(gp + 4);
            const u32x4 gb = __builtin_nontemporal_load((const u32x4*)(W_U(F) + (size_t)row * NU + U_GB + idx));
            float r8[8];
            r8[0] = o[0] * rn * g0[0] * silu_f(bflo(gb.x)); r8[1] = o[1] * rn * g0[1] * silu_f(bfhi(gb.x)); r8[2] = o[2] * rn * g0[2] * silu_f(bflo(gb.y)); r8[3] = o[3] * rn * g0[3] * silu_f(bfhi(gb.y));
            r8[4] = o[4] * rn * g1[0] * silu_f(bflo(gb.z)); r8[5] = o[5] * rn * g1[1] * silu_f(bfhi(gb.z)); r8[6] = o[6] * rn * g1[2] * silu_f(bflo(gb.w)); r8[7] = o[7] * rn * g1[3] * silu_f(bfhi(gb.w));
            u32x4 ov; ov.x = pk2(r8[0], r8[1]); ov.y = pk2(r8[2], r8[3]); ov.z = pk2(r8[4], r8[5]); ov.w = pk2(r8[6], r8[7]);
            *(u32x4*)(W_MIX(F) + (size_t)row * D + MIX_B + idx) = ov; }
    }
}

struct PmRow { u32x4 y[4]; f32x4 x[8]; };
__device__ __forceinline__ void unpack8(const u32x4 a, float* o) { o[0] = bflo(a.x); o[1] = bfhi(a.x); o[2] = bflo(a.y); o[3] = bfhi(a.y); o[4] = bflo(a.z); o[5] = bfhi(a.z); o[6] = bflo(a.w); o[7] = bfhi(a.w); }
__device__ __forceinline__ void postmix_load_y(Frame& F, int row, PmRow& R) {
    const bf16* yp = W_Y(F) + (size_t)row * D + 8 * F.lane;
#pragma unroll
    for (int j = 0; j < 4; ++j) R.y[j] = __builtin_nontemporal_load((const u32x4*)(yp + 512 * j));
}
template <bool FIRST> __device__ __forceinline__ void postmix_load_x(Frame& F, int row, PmRow& R) {
    const int lane = F.lane;
    if constexpr (FIRST) { const float* xin = (row < NLAT ? F.x + (size_t)row * D : F.ctx + (size_t)(row - NLAT) * D) + 8 * lane;
#pragma unroll
        for (int j = 0; j < 4; ++j) { R.x[2 * j] = __builtin_nontemporal_load((const f32x4*)(xin + 512 * j)); R.x[2 * j + 1] = __builtin_nontemporal_load((const f32x4*)(xin + 512 * j + 4)); } }
    else { const bf16* xb = W_XB(F) + (size_t)row * D + 8 * lane;
#pragma unroll
        for (int j = 0; j < 4; ++j) R.x[j] = __builtin_bit_cast(f32x4, __builtin_nontemporal_load((const u32x4*)(xb + 512 * j))); }
}
template <bool FIRST> __device__ __forceinline__ void postmix_s1(Frame& F, int l, int row, const PmRow& R, const u32x4 (&c0p)[4], float (&xv)[32], bool dry) {
    const int lane = F.lane;
    float ss = 0.f;
#pragma unroll
    for (int j = 0; j < 4; ++j) { float y8[8]; unpack8(R.y[j], y8);
#pragma unroll
        for (int e = 0; e < 8; ++e) ss += y8[e] * y8[e]; }
    const float r1 = 1.0f / sqrtf(wave_sum(ss) * (1.0f / D) + EPS);
    bf16* xdst = dry ? (bf16*)(F.ws + WS_DUMMY) + (size_t)row * D : W_XB(F) + (size_t)row * D;
#pragma unroll
    for (int j = 0; j < 4; ++j) { float y8[8], c8[8], x8[8]; unpack8(R.y[j], y8); unpack8(c0p[j], c8);
        if constexpr (FIRST) { x8[0] = R.x[2 * j][0]; x8[1] = R.x[2 * j][1]; x8[2] = R.x[2 * j][2]; x8[3] = R.x[2 * j][3]; x8[4] = R.x[2 * j + 1][0]; x8[5] = R.x[2 * j + 1][1]; x8[6] = R.x[2 * j + 1][2]; x8[7] = R.x[2 * j + 1][3]; }
        else unpack8(__builtin_bit_cast(u32x4, R.x[j]), x8);
#pragma unroll
        for (int e = 0; e < 8; ++e) xv[8 * j + e] = x8[e] + c8[e] * (y8[e] * r1); }
    row_store_bf16(xdst, lane, xv);
}
__device__ __forceinline__ void postmix_s2(Frame& F, int row, const u32x4 (&c1p)[4], const u32x4 (&c2p)[4], float (&xv)[32]) {
    const int lane = F.lane;
    const float r2 = 1.0f / sqrtf(row_sumsq(xv) * (1.0f / D) + EPS);
#pragma unroll
    for (int j = 0; j < 4; ++j) { float c1[8], c2[8]; unpack8(c1p[j], c1); unpack8(c2p[j], c2);
#pragma unroll
        for (int e = 0; e < 8; ++e) xv[8 * j + e] = xv[8 * j + e] * r2 * c1[e] + c2[e]; }
    float am = 0.f;
#pragma unroll
    for (int i = 0; i < 32; ++i) am = fmaxf(am, fabsf(xv[i]));
    am = wave_max(am);
    const float scale = am > 0.f ? am * (1.0f / 127.0f) : 1.0f;
    row_store_i8(W_HQ(F) + (size_t)row * D, lane, xv, 1.0f / scale);
    if (lane == 0) W_HS(F)[row] = scale;
}
template <bool FIRST> __device__ __forceinline__ void p_postmix_t(Frame& F, int l, bool dry) {
    const int gw = F.vcu * NWAVES + F.wave, NGW = F.G * NWAVES, lane = F.lane, nrows = (l == 0) ? NROW : NLAT;
    LAS float* WR = (LAS float*)F.lds;
    for (int i = F.tid; i < D * 4; i += NTHR) { const int k = i >> 2, e4 = (i & 3) * 4; const f32x4 wv = *(const f32x4*)(F.w_router + ((size_t)l * D + k) * NE + e4);
        WR[(e4 + 0) * D + k] = wv[0]; WR[(e4 + 1) * D + k] = wv[1]; WR[(e4 + 2) * D + k] = wv[2]; WR[(e4 + 3) * D + k] = wv[3]; }
    __syncthreads();
    const int npair = nrows / 2, pbase = npair / NGW, prem = npair % NGW;
    const int p0 = gw * pbase + (gw < prem ? gw : prem), p1 = p0 + pbase + (gw < prem ? 1 : 0);
    PmRow RA, RB;
    if (p0 < p1) { postmix_load_y(F, 2 * p0, RA); postmix_load_x<FIRST>(F, 2 * p0, RA); postmix_load_y(F, 2 * p0 + 1, RB); if constexpr (!FIRST) postmix_load_x<FIRST>(F, 2 * p0 + 1, RB); }
    for (int p = p0; p < p1; ++p) {
        launder(F);
        const int row = 2 * p, row2 = row + 1; const bool has2 = true; const int lane = F.lane;
        float h0[32], h1[32];
        {
            const int m0 = row < NLAT ? row / SEQ : 8;
            u32x4 c0p[4], c1p[4], c2p[4]; const bf16* cva = W_CV(F) + ((size_t)l * 9 + m0) * 6 * D + 8 * lane;
#pragma unroll
            for (int j = 0; j < 4; ++j) c0p[j] = *(const u32x4*)(cva + 512 * j);
            if constexpr (FIRST) postmix_load_x<FIRST>(F, row2, RB);
            postmix_s1<FIRST>(F, l, row, RA, c0p, h0, dry);
            asm volatile("" ::: "memory");
#pragma unroll
            for (int j = 0; j < 4; ++j) { c1p[j] = *(const u32x4*)(cva + D + 512 * j); c2p[j] = *(const u32x4*)(cva + 2 * D + 512 * j); }
            postmix_s1<FIRST>(F, l, row2, RB, c0p, h1, dry);
            postmix_s2(F, row, c1p, c2p, h0);
            postmix_s2(F, row2, c1p, c2p, h1);
        }
        asm volatile("" ::: "memory");
        if (p + 1 < p1) { postmix_load_y(F, row + 2, RA); postmix_load_x<FIRST>(F, row + 2, RA); postmix_load_y(F, row + 3, RB); if constexpr (!FIRST) postmix_load_x<FIRST>(F, row + 3, RB); }
        asm volatile("" ::: "memory");
        float a0[16], a1[16];
#pragma unroll
        for (int e = 0; e < 16; ++e) { a0[e] = 0.f; a1[e] = 0.f; }
#pragma unroll
        for (int j = 0; j < 4; ++j) {
#pragma unroll
            for (int e = 0; e < 16; ++e) { const LAS float* wp = WR + e * D + 512 * j + 8 * lane; const f32x4 wa = *(const LAS f32x4*)wp, wb = *(const LAS f32x4*)(wp + 4);
                a0[e] += h0[8 * j] * wa[0] + h0[8 * j + 1] * wa[1] + h0[8 * j + 2] * wa[2] + h0[8 * j + 3] * wa[3] + h0[8 * j + 4] * wb[0] + h0[8 * j + 5] * wb[1] + h0[8 * j + 6] * wb[2] + h0[8 * j + 7] * wb[3];
                a1[e] += h1[8 * j] * wa[0] + h1[8 * j + 1] * wa[1] + h1[8 * j + 2] * wa[2] + h1[8 * j + 3] * wa[3] + h1[8 * j + 4] * wb[0] + h1[8 * j + 5] * wb[1] + h1[8 * j + 6] * wb[2] + h1[8 * j + 7] * wb[3];
                if ((e & 1) == 1) asm volatile("" ::: "memory"); }
        }
        float mx0 = -1e30f, mx1 = -1e30f;
#pragma unroll
        for (int e = 0; e < 16; ++e) { a0[e] = wave_sum(a0[e]); a1[e] = wave_sum(a1[e]); mx0 = fmaxf(mx0, a0[e]); mx1 = fmaxf(mx1, a1[e]); }
        float s0 = 0.f, s1 = 0.f;
#pragma unroll
        for (int e = 0; e < 16; ++e) { a0[e] = __expf(a0[e] - mx0); a1[e] = __expf(a1[e] - mx1); s0 += a0[e]; s1 += a1[e]; }
        float val = 0.f;
#pragma unroll
        for (int e = 0; e < 16; ++e) { if ((lane & 15) == e) val = (lane < 16) ? a0[e] / s0 : a1[e] / s1; }
        if (lane < 16) W_AFF(F)[(size_t)row * NE + lane] = val;
        else if (lane < 32 && has2) W_AFF(F)[(size_t)row2 * NE + (lane & 15)] = val;
    }
}

__device__ __forceinline__ void p_postmix(Frame& F, int l, bool dry) { if (l == 0) p_postmix_t<true>(F, l, dry); else p_postmix_t<false>(F, l, dry); }

__device__ __forceinline__ int block_excl_scan(int v, LAS int* tmp, int lane, int wave, int& total) {
    int inc = v;
#pragma unroll
    for (int o = 1; o < 64; o <<= 1) { const int t = __shfl_up(inc, o); if (lane >= o) inc += t; }
    if (lane == 63) tmp[wave] = inc;
    __syncthreads();
    int base = 0, tot = 0;
#pragma unroll
    for (int ww = 0; ww < 8; ++ww) { const int t = tmp[ww]; tot += t; if (ww < wave) base += t; }
    __syncthreads();
    total = tot; return base + inc - v;
}
__device__ __forceinline__ void p_topk(Frame& F, int l) {
    const int tid = F.tid, lane = F.lane, wave = F.wave;
    LAS int* hist = (LAS int*)F.lds;
    LAS int* misc = (LAS int*)(F.lds + 1024);
    LAS int* stmp = (LAS int*)(F.lds + 1152);
    LAS int* list = (LAS int*)(F.lds + 2048);
    const int nsets = (l == 0) ? 256 : 128, ME = (l == 0) ? ME0 : ME1;
    for (int s = F.vcu; s < nsets; s += F.G) {
        const bool isctx = s >= 128; const int ss = isctx ? s - 128 : s, b = ss >> 4, e = ss & 15;
        const int n = isctx ? CTXL : SEQ, cap = isctx ? CAPC : CAPL, base = isctx ? NLAT + b * CTXL : b * SEQ, slot0 = isctx ? NB * CAPL + b * CAPC : b * CAPL;
        unsigned bits[4];
#pragma unroll
        for (int c = 0; c < 4; ++c) { const int i = 4 * tid + c; bits[c] = (i < n) ? __builtin_bit_cast(unsigned, W_AFF(F)[(size_t)(base + i) * NE + e]) : 0u; }
        unsigned prefix = 0u; int krem = cap;
        for (int pass = 0; pass < 4; ++pass) {
            const int shift = 24 - 8 * pass;
            if (tid < 256) hist[tid] = 0;
            __syncthreads();
#pragma unroll
            for (int c = 0; c < 4; ++c) { const int i = 4 * tid + c; if (i < n && (pass == 0 || (bits[c] >> (shift + 8)) == prefix)) __hip_atomic_fetch_add(&hist[(bits[c] >> shift) & 255u], 1, __ATOMIC_RELAXED, __HIP_MEMORY_SCOPE_WORKGROUP); }
            __syncthreads();
            if (wave == 0) {
                const int h0 = hist[4 * lane], h1 = hist[4 * lane + 1], h2 = hist[4 * lane + 2], h3 = hist[4 * lane + 3];
                const int tot = h0 + h1 + h2 + h3; int suf = tot;
#pragma unroll
                for (int o = 1; o < 64; o <<= 1) { const int t = __shfl_down(suf, o); if (lane + o < 64) suf += t; }
                const int above = suf - tot;
                if (above < krem && krem <= suf) {
                    int a = above, bin, cnt_above;
                    if (a + h3 >= krem) { bin = 3; cnt_above = a; } else { a += h3;
                        if (a + h2 >= krem) { bin = 2; cnt_above = a; } else { a += h2;
                            if (a + h1 >= krem) { bin = 1; cnt_above = a; } else { a += h1; bin = 0; cnt_above = a; } } }
                    misc[0] = 4 * lane + bin; misc[1] = cnt_above;
                }
            }
            __syncthreads();
            prefix = (prefix << 8) | (unsigned)misc[0]; krem -= misc[1];
            __syncthreads();
        }
        int neq = 0;
#pragma unroll
        for (int c = 0; c < 4; ++c) { const int i = 4 * tid + c; if (i < n && bits[c] == prefix) ++neq; }
        int tot_eq; int eqr = block_excl_scan(neq, stmp, lane, wave, tot_eq);
        bool sel[4]; int nsel = 0;
#pragma unroll
        for (int c = 0; c < 4; ++c) { const int i = 4 * tid + c; bool s2 = false; if (i < n) { if (bits[c] > prefix) s2 = true; else if (bits[c] == prefix) { s2 = eqr < krem; ++eqr; } } sel[c] = s2; nsel += s2 ? 1 : 0; }
        int tot_sel; int slot = block_excl_scan(nsel, stmp, lane, wave, tot_sel);
#pragma unroll
        for (int c = 0; c < 4; ++c) { const int i = 4 * tid + c; if (i < n) { int v = -1; if (sel[c]) { if (slot < cap) { list[slot] = i; v = slot0 + slot; } ++slot; } W_TSLOT(F)[(size_t)(base + i) * NE + e] = v; } }
        __syncthreads();
        for (int sl0 = wave; sl0 < cap; sl0 += 4 * NWAVES) {
            u32x4 cr[4][2]; float cs4[4]; int tk[4];
#pragma unroll
            for (int j = 0; j < 4; ++j) { tk[j] = list[sl0 + j * NWAVES]; const signed char* src = W_HQ(F) + (size_t)(base + tk[j]) * D; cr[j][0] = *(const u32x4*)(src + 16 * lane); cr[j][1] = *(const u32x4*)(src + 1024 + 16 * lane); cs4[j] = W_HS(F)[base + tk[j]]; }
#pragma unroll
            for (int j = 0; j < 4; ++j) { const int sl = sl0 + j * NWAVES; signed char* dst = W_XSQ(F) + ((size_t)e * ME + slot0 + sl) * D; *(u32x4*)(dst + 16 * lane) = cr[j][0]; *(u32x4*)(dst + 1024 + 16 * lane) = cr[j][1];
                if (lane == 0) W_XSS(F)[(size_t)e * ME + slot0 + sl] = cs4[j]; }
        }
        __syncthreads();
    }
}

__device__ __forceinline__ void p_actq(Frame& F, int l) {
    const int gw = F.vcu * NWAVES + F.wave, NGW = F.G * NWAVES, lane = F.lane, nrows = NE * ((l == 0) ? ME0 : ME1);
    for (int row = gw; row < nrows; row += 2 * NGW) {
        const int row2 = (row + NGW < nrows) ? row + NGW : row;
        float v[32], v2[32]; row_load_bf16_nt(W_ACT(F) + (size_t)row * FF, lane, v); row_load_bf16_nt(W_ACT(F) + (size_t)row2 * FF, lane, v2);
        const float t1 = W_TM(F)[(size_t)row * 64 + lane], t2 = W_TM(F)[(size_t)row2 * 64 + lane];
        const float am = wave_max(t1), am2 = wave_max(t2);
        const float scale = am > 0.f ? am * (1.0f / 127.0f) : 1.0f, scale2 = am2 > 0.f ? am2 * (1.0f / 127.0f) : 1.0f;
        row_store_i8(W_ACTQ(F) + (size_t)row * FF, lane, v, 1.0f / scale); row_store_i8(W_ACTQ(F) + (size_t)row2 * FF, lane, v2, 1.0f / scale2);
        if (lane == 0) { W_ACTS(F)[row] = scale; W_ACTS(F)[row2] = scale2; }
    }
}

__device__ __forceinline__ void p_combine(Frame& F, int l, bool dry) {
    const int gw = F.vcu * NWAVES + F.wave, NGW = F.G * NWAVES, lane = F.lane, nrows = (l == 0) ? NROW : NLAT, ME = (l == 0) ? ME0 : ME1;
    for (int row = gw; row < nrows; row += NGW) {
        const int m = row < NLAT ? row / SEQ : 8;
        float acc[32];
#pragma unroll
        for (int i = 0; i < 32; ++i) acc[i] = 0.f;
        {
            const int sl16 = (lane < NE) ? W_TSLOT(F)[(size_t)row * NE + lane] : -1; const float gt16 = (lane < NE) ? W_AFF(F)[(size_t)row * NE + lane] : 0.f;
            unsigned long long msk = __ballot(sl16 >= 0);
            while (msk) {
                int ee[4]; int ns = 0;
#pragma unroll
                for (int j = 0; j < 4; ++j) { ee[j] = msk ? (int)__builtin_ctzll(msk) : 0; if (msk) { ++ns; msk &= msk - 1; } }
                u32x4 yr[4][4]; float gg[4];
#pragma unroll
                for (int j = 0; j < 4; ++j) if (j < ns) {
                    const int slot = __builtin_amdgcn_readlane(sl16, ee[j]); gg[j] = __builtin_bit_cast(float, __builtin_amdgcn_readlane(__builtin_bit_cast(int, gt16), ee[j]));
                    const bf16* yp = W_XS(F) + ((size_t)ee[j] * ME + slot) * D + 8 * lane;
#pragma unroll
                    for (int q = 0; q < 4; ++q) yr[j][q] = __builtin_nontemporal_load((const u32x4*)(yp + 512 * q)); }
#pragma unroll
                for (int j = 0; j < 4; ++j) if (j < ns) {
#pragma unroll
                    for (int q = 0; q < 4; ++q) { const u32x4 a = yr[j][q];
                        acc[8 * q + 0] += gg[j] * bflo(a.x); acc[8 * q + 1] += gg[j] * bfhi(a.x); acc[8 * q + 2] += gg[j] * bflo(a.y); acc[8 * q + 3] += gg[j] * bfhi(a.y);
                        acc[8 * q + 4] += gg[j] * bflo(a.z); acc[8 * q + 5] += gg[j] * bfhi(a.z); acc[8 * q + 6] += gg[j] * bflo(a.w); acc[8 * q + 7] += gg[j] * bfhi(a.w); } }
            }
        }
        const float r1 = 1.0f / sqrtf(row_sumsq(acc) * (1.0f / D) + EPS);
        float xv[32], c3[32];
        row_load_bf16_nt(W_XB(F) + (size_t)row * D, lane, xv); row_load_bf16(W_CV(F) + (((size_t)l * 9 + m) * 6 + 3) * D, lane, c3);
#pragma unroll
        for (int i = 0; i < 32; ++i) xv[i] = xv[i] + c3[i] * (acc[i] * r1);
        if (l + 1 < DEPTH) row_store_bf16(dry ? (bf16*)(F.ws + WS_DUMMY) + (size_t)row * D : W_XB(F) + (size_t)row * D, lane, xv);
        else row_store_f32(dry ? (float*)(F.ws + WS_DUMMY) + (size_t)(row & 8191) * D : F.out + (size_t)row * D, lane, xv);
        if (l + 1 < DEPTH) prenorm_row_cv(F, l + 1, m, xv, row);
    }
}
struct Args { const float* in[24]; float* out; unsigned char* ws; int ph_lo, ph_hi; };
constexpr int NPHASE = 2 + 11 * DEPTH;
__global__ void __launch_bounds__(NTHR, 2) mk_fwd(Args args) {
    extern __shared__ __attribute__((aligned(16))) unsigned char lds_raw[];
    Frame F;
    F.lds = (LAS unsigned char*)lds_raw;
    F.tid = threadIdx.x; F.lane = F.tid & 63; F.wave = __builtin_amdgcn_readfirstlane(F.tid >> 6);
    F.G = gridDim.x; { const int bx = blockIdx.x; F.vcu = (F.G % 8 == 0) ? (bx % 8) * (F.G / 8) + bx / 8 : bx; }
    F.x = args.in[0]; F.c = args.in[1]; F.ctx = args.in[2]; F.c_ctx = args.in[3]; F.w_ada = args.in[4]; F.b_ada = args.in[5]; F.g_pre_mix = args.in[6]; F.g_post_mix = args.in[7];
    F.g_pre_ffn = args.in[8]; F.g_post_ffn = args.in[9]; F.w_in = args.in[10]; F.w_dec = args.in[11]; F.b_dec = args.in[12]; F.rpb = args.in[13]; F.g_gla = args.in[14]; F.ln_v_g = args.in[15];
    F.ln_v_b = args.in[16]; F.w_sp = args.in[17]; F.b_sp = args.in[18]; F.w_out = args.in[19]; F.w_router = args.in[20]; F.w_gate = args.in[21]; F.w_up = args.in[22]; F.w_down = args.in[23];
    F.out = args.out;
    unsigned char* ws = args.ws;
    F.ws = ws;

    const int lo = args.ph_lo, hi = args.ph_hi;
    unsigned* ctl = (unsigned*)(ws + WS_CTL);
    if (F.tid < 16) ((LAS unsigned*)(F.lds + LDS_XB))[F.tid] = 0u;
    __syncthreads();
    XcdBarrier bar; bar.bar = (unsigned*)(ws + WS_CTL) + CW_BAR; bar.x = 0; bar.st = nullptr;
    if (hi - lo > 1) bar = xcd_barrier_post((unsigned*)(ws + WS_CTL) + CW_BAR, (volatile LAS unsigned*)(F.lds + LDS_XB));
#ifndef MK_MASK
#define MK_MASK 0xFFFFFFFFu
#endif
#define PH(b) ((MK_MASK >> (b)) & 1u)
#ifndef MK_REP
#define MK_REP 0u
#endif
#define NREP(b) (1 + (int)((MK_REP >> (b)) & 1u))
#define REPBAR(b, rep) do { if ((rep) + 1 < NREP(b)) xcd_barrier(bar); } while (0)
#define IN(k) (lo <= (k) && (k) < hi)
#define SEAM(k) do { if (IN(k) && IN((k) + 1)) xcd_barrier(bar); } while (0)

    if (PH(0) && IN(0)) { for (int rep = 0; rep < NREP(0); ++rep) { launder(F); p0a(F); REPBAR(0, rep); } } SEAM(0);
    if (PH(1) && IN(1)) { for (int rep = 0; rep < NREP(1); ++rep) { launder(F); p0b(F); REPBAR(1, rep); } } SEAM(1);
    for (int l = 0; l < DEPTH; ++l) {
        const int pb = 2 + 11 * l;
        if (PH(2) && IN(pb + 0)) {
          for (int rep = 0; rep < NREP(2); ++rep) {
            launder(F);
            pg8::Gemm g{(const pg8::bf16_t*)W_HQ(F), (const pg8::bf16_t*)(F.ws + WS_WIN + (size_t)l * NU * D), NROW, NU, D / 2};
            constexpr int GG = 237;
            unsigned* sig = ctl + CW_SIG + 64 * (pb + 0);
            if ((int)blockIdx.x < GG || F.G != 256) {
                pg8::GroupedOrder S; S.init(1, NROW / 256, NU / 256, F.G == 256 ? GG : F.G, (int)blockIdx.x, sig);
                pg8::EpiStoreI8 E{W_U(F), NU, NU / 256, W_HS(F), W_SIN(F) + (size_t)l * NU};
                pg8::gemm_phase<pg8::EpiStoreI8, pg8::GroupedOrder, true, true>(F.lds, g, S, E, F.tid);
            } else bg_loop(F, ctl, sig, BG_TOTAL);
            REPBAR(2, rep); }
        } SEAM(pb + 0);
        if (PH(3) && IN(pb + 1)) { for (int rep = 0; rep < NREP(3); ++rep) { launder(F); p_mixers(F, l); REPBAR(3, rep); } } SEAM(pb + 1);
        if (PH(11) && IN(pb + 2)) { for (int rep = 0; rep < NREP(11); ++rep) { launder(F); p_chains(F, l); REPBAR(11, rep); } } SEAM(pb + 2);
        if (PH(4) && IN(pb + 3)) { for (int rep = 0; rep < NREP(4); ++rep) { launder(F); p_glaout(F, l); REPBAR(4, rep); } } SEAM(pb + 3);
        if (PH(5) && IN(pb + 4)) {
          for (int rep = 0; rep < NREP(5); ++rep) {
            launder(F);
            const int M = (l == 0) ? NROW : NLAT;
            pg8::Gemm g{W_MIX(F), W_WOUT(F) + (size_t)l * D * D, M, D, D};
            const int GG = (l == 0) ? 192 : 256;
            unsigned* sig = ctl + CW_SIG + 64 * (pb + 4);
            if ((int)blockIdx.x < GG || F.G != 256) {
                pg8::GroupedOrder S; S.init(1, M / 256, D / 256, F.G == 256 ? GG : F.G, (int)blockIdx.x, sig);
                pg8::EpiStore E{W_Y(F), D, D / 256};
                pg8::gemm_phase<pg8::EpiStore, pg8::GroupedOrder, true, true>(F.lds, g, S, E, F.tid);
            } else bg_loop(F, ctl, sig, BG_TOTAL);
            REPBAR(5, rep); }
        } SEAM(pb + 4);
        if (PH(6) && IN(pb + 5)) { if (MK_REPMIX & 16u) { launder(F); p_postmix(F, l, true); xcd_barrier(bar); } launder(F); p_postmix(F, l, false); } SEAM(pb + 5);
        if (PH(7) && IN(pb + 6)) { for (int rep = 0; rep < NREP(7); ++rep) { launder(F); p_topk(F, l); launder(F); bg_loop(F, ctl, nullptr, l == 0 ? BG_A : BG_TOTAL); REPBAR(7, rep); } } SEAM(pb + 6);
        if (PH(8) && IN(pb + 7)) {
          for (int rep = 0; rep < NREP(8); ++rep) {
            launder(F);
            const int ME = (l == 0) ? ME0 : ME1;
            pg8::Gemm g{(const pg8::bf16_t*)W_XSQ(F), (const pg8::bf16_t*)((F).ws + WS_W1 + (size_t)l * NE * (2 * FF) * D), NE * ME, NE * 2 * FF, D / 2};
            pg8::GroupedOrder S; S.init(NE, ME / 256, 2 * FF / 256, F.G, (int)blockIdx.x);
            pg8::EpiSwiGLUI8 E{W_ACT(F), FF, 2 * FF / 256, W_XSS(F), W_S1(F) + (size_t)l * NE * (2 * FF), W_TM(F)};
            pg8::gemm_phase<pg8::EpiSwiGLUI8, pg8::GroupedOrder, true, true>(F.lds, g, S, E, F.tid); REPBAR(8, rep); }
        } SEAM(pb + 7);
        if (PH(12) && IN(pb + 8)) { launder(F); p_actq(F, l); } SEAM(pb + 8);
        if (PH(9) && IN(pb + 9)) {
          for (int rep = 0; rep < NREP(9); ++rep) {
            launder(F);
            const int ME = (l == 0) ? ME0 : ME1;
            pg8::Gemm g{(const pg8::bf16_t*)W_ACTQ(F), (const pg8::bf16_t*)((F).ws + WS_W2 + (size_t)l * NE * D * FF), NE * ME, NE * D, FF / 2};
            const int GG = (l == 0) ? 231 : 256;
            unsigned* sig = ctl + CW_SIG + 64 * (pb + 9);
            if ((int)blockIdx.x < GG || F.G != 256) {
                pg8::GroupedOrder S; S.init(NE, ME / 256, D / 256, F.G == 256 ? GG : F.G, (int)blockIdx.x, sig);
                pg8::EpiStoreI8 E{W_XS(F), D, D / 256, W_ACTS(F), W_S2(F) + (size_t)l * NE * D};
                pg8::gemm_phase<pg8::EpiStoreI8, pg8::GroupedOrder, true, true>(F.lds, g, S, E, F.tid);
            } else bg_loop(F, ctl, sig, BG_TOTAL);
            REPBAR(9, rep); }
        } SEAM(pb + 9);
        if (PH(10) && IN(pb + 10)) { if (MK_REPMIX & 32u) { launder(F); p_combine(F, l, true); xcd_barrier(bar); } launder(F); p_combine(F, l, false); if (l == 0) { launder(F); bg_loop(F, ctl, nullptr, BG_B); } } SEAM(pb + 10);
    }
#undef IN
#undef SEAM
}

extern "C" void kernel_launch(void* const* d_in, const int* in_sizes, int n_in, void* d_out, int out_size, void* d_ws, size_t ws_size, hipStream_t stream) {
    static int grid = 0;
    if (grid == 0) {
        if (n_in != 24 || out_size != NLAT * D || ws_size < WS_END2) { fprintf(stderr, "kernel_launch: unexpected shapes (n_in %d out %d ws %zu)\n", n_in, out_size, ws_size); grid = -1; return; }
        int dev = 0, cus = 0, per_cu = 0;
        if (hipGetDevice(&dev) != hipSuccess || hipDeviceGetAttribute(&cus, hipDeviceAttributeMultiprocessorCount, dev) != hipSuccess) { grid = -1; return; }
        if (hipFuncSetAttribute((const void*)mk_fwd, hipFuncAttributeMaxDynamicSharedMemorySize, LDS_BYTES) != hipSuccess) { fprintf(stderr, "kernel_launch: hipFuncSetAttribute failed\n"); grid = -1; return; }
        if (hipOccupancyMaxActiveBlocksPerMultiprocessor(&per_cu, (const void*)mk_fwd, NTHR, LDS_BYTES) != hipSuccess || per_cu < 1) { fprintf(stderr, "kernel_launch: occupancy query says %d\n", per_cu); }
        (void)hipGetLastError();
        grid = cus;
    }
    if (grid < 0) return;
    if (hipMemsetAsync((char*)d_ws + WS_CTL, 0, CTL_ZERO_BYTES, stream) != hipSuccess) return;
    Args a{};
    for (int i = 0; i < 24; ++i) a.in[i] = (const float*)d_in[i];
    a.out = (float*)d_out; a.ws = (unsigned char*)d_ws;
#if MK_N_LAUNCHES == 1
    a.ph_lo = 0; a.ph_hi = NPHASE;
    hipLaunchKernelGGL(mk_fwd, dim3(grid), dim3(NTHR), LDS_BYTES, stream, a);
#else
    for (int p = 0; p < NPHASE; ++p) { a.ph_lo = p; a.ph_hi = p + 1; hipLaunchKernelGGL(mk_fwd, dim3(grid), dim3(NTHR), LDS_BYTES, stream, a); }
#endif
}
```

```cpp
#include <hip/hip_runtime.h>
#include <cstdio>
#include <cstdint>

#ifndef MK_N_LAUNCHES
#define MK_N_LAUNCHES 1
#endif

namespace pg8 {
#define PG8_LAS __attribute__((address_space(3)))
typedef unsigned short bf16_t;
typedef short bf16x8 __attribute__((ext_vector_type(8)));
typedef float f32x4 __attribute__((ext_vector_type(4)));
typedef unsigned u32x4 __attribute__((ext_vector_type(4)));
constexpr int BM = 256, BK = 64, HALF = 128, HTB = HALF * BK * 2  , STAGE_BYTES = 8 * HTB, NXCD = 8, WGM = 8;

__host__ __device__ __forceinline__ int lds_byte(int r, int c) { const int st = (r >> 4) * 2 + (c >> 5), rr = r & 15, cc = c & 31, ob = rr * 64 + cc * 2; return st * 1024 + (ob ^ (((ob >> 9) & 1) << 5)); }
__host__ __device__ __forceinline__ void stage_rc(int b, int& R, int& C) { const int st = b / 1024, sb = b % 1024, swz = sb ^ (((sb >> 9) & 1) << 5); R = (st >> 1) * 16 + swz / 64; C = (st & 1) * 32 + (swz % 64) / 2; }
__host__ __device__ __forceinline__ int perm32(int rho) { const int n = rho >> 4, i = rho & 15; return 8 * (i >> 2) + 4 * n + (i & 3); }

struct Unit { int pm, pn, last; };
struct Gemm { const bf16_t* A; const bf16_t* Bt; int M, N, K; };

typedef __bf16 hwbf16x2_t __attribute__((ext_vector_type(2))); typedef float f32x2_cv __attribute__((ext_vector_type(2)));
__device__ __forceinline__ unsigned cvt_pk_bf16(float lo, float hi) { const f32x2_cv v = {lo, hi}; const hwbf16x2_t b = __builtin_convertvector(v, hwbf16x2_t); return __builtin_bit_cast(unsigned, b); }
typedef float f32x2 __attribute__((ext_vector_type(2)));
typedef int i32x4 __attribute__((ext_vector_type(4)));
__device__ __forceinline__ f32x4 mma16(bf16x8 a, bf16x8 b, f32x4 c) { return __builtin_amdgcn_mfma_f32_16x16x32_bf16(a, b, c, 0, 0, 0); }
__device__ __forceinline__ i32x4 mma16(bf16x8 a, bf16x8 b, i32x4 c) { return __builtin_amdgcn_mfma_i32_16x16x64_i8(__builtin_bit_cast(i32x4, a), __builtin_bit_cast(i32x4, b), c, 0, 0, 0); }
__device__ __forceinline__ void tile_of(int wgid, int nM, int nN, int& pm, int& pn) {
    const int nwg = nM * nN;
    { const int q = nwg / NXCD, r = nwg % NXCD, xcd = wgid % NXCD, off = wgid / NXCD; wgid = (xcd < r ? xcd * (q + 1) : r * (q + 1) + (xcd - r) * q) + off; }
    const int nig = WGM * nN, gid = wgid / nig, fm = gid * WGM, gsz = (nM - fm) < WGM ? (nM - fm) : WGM;
    pm = fm + ((wgid % nig) % gsz); pn = (wgid % nig) / gsz;
}
struct GroupedOrder {
    int mM, mN, per, total, G, c; unsigned* sig;
    __device__ __forceinline__ void init(int E, int mM_, int mN_, int G_, int c_, unsigned* sig_ = nullptr) { mM = mM_; mN = mN_; per = mM * mN; total = E * per; G = G_; c = c_; sig = sig_; }
    __device__ __forceinline__ bool next(int i, Unit& u) const {
        const long L = (long)i * G + c; if (L >= total) return false;
        const int e = (int)(L / per), l = (int)(L % per); int pm, pn; tile_of(l, mM, mN, pm, pn);
        u.pm = e * mM + pm; u.pn = e * mN + pn; u.last = (i == (total + G - 1) / G - 1) ? 1 : 0; return true;
    }
    __device__ __forceinline__ void a_ready(const Unit& u) const { if (sig && u.last && threadIdx.x == 0) __hip_atomic_store(sig, 1u, __ATOMIC_RELAXED, __HIP_MEMORY_SCOPE_AGENT); }
    __device__ __forceinline__ void done(const Unit&) const {}
};
__device__ __forceinline__ float xmax16(float v) { const auto r = __builtin_amdgcn_permlane16_swap(__builtin_bit_cast(unsigned, v), __builtin_bit_cast(unsigned, v), false, false); return fmaxf(__builtin_bit_cast(float, r[0]), __builtin_bit_cast(float, r[1])); }
__device__ __forceinline__ float xmax32(float v) { const auto r = __builtin_amdgcn_permlane32_swap(__builtin_bit_cast(unsigned, v), __builtin_bit_cast(unsigned, v), false, false); return fmaxf(__builtin_bit_cast(float, r[0]), __builtin_bit_cast(float, r[1])); }
__device__ __forceinline__ float xsum16(float v) { const auto r = __builtin_amdgcn_permlane16_swap(__builtin_bit_cast(unsigned, v), __builtin_bit_cast(unsigned, v), false, false); return __builtin_bit_cast(float, r[0]) + __builtin_bit_cast(float, r[1]); }
__device__ __forceinline__ float xsum32(float v) { const auto r = __builtin_amdgcn_permlane32_swap(__builtin_bit_cast(unsigned, v), __builtin_bit_cast(unsigned, v), false, false); return __builtin_bit_cast(float, r[0]) + __builtin_bit_cast(float, r[1]); }
__device__ __forceinline__ float silu_f(float x) { return x * __builtin_amdgcn_rcpf(1.0f + __expf(-x)); }
struct EpiStore {
    static constexpr bool PERM = true, AFTER_DRAIN = false; typedef f32x4 acc_t;
    bf16_t* O; int ldc; int nN;
    __device__ __forceinline__ void operator()(const f32x4 (&acc)[2][2][4][2], const Unit& u, int wr, int wc, int fr, int fq) const {
        const int row0 = u.pm * BM + wr * 64 + fr, col0 = (u.pn % nN) * BM + wc * 32 + 8 * fq;
#pragma unroll
        for (int ai = 0; ai < 2; ++ai)
#pragma unroll
            for (int m = 0; m < 4; ++m) { bf16_t* rowp = O + (size_t)(row0 + ai * HALF + m * 16) * ldc + col0;
#pragma unroll
                for (int bj = 0; bj < 2; ++bj) { const f32x4 v0 = acc[ai][bj][m][0], v1 = acc[ai][bj][m][1];
                    u32x4 w; w.x = cvt_pk_bf16(v0[0], v0[1]); w.y = cvt_pk_bf16(v0[2], v0[3]); w.z = cvt_pk_bf16(v1[0], v1[1]); w.w = cvt_pk_bf16(v1[2], v1[3]);
                    *(u32x4*)(rowp + bj * HALF) = w; } }
    }
};
struct EpiSwiGLU {
    static constexpr bool PERM = true, AFTER_DRAIN = false; typedef f32x4 acc_t;
    bf16_t* O; int ldc; int nN;
    __device__ __forceinline__ void operator()(const f32x4 (&acc)[2][2][4][2], const Unit& u, int wr, int wc, int fr, int fq) const {
        const int row0 = u.pm * BM + wr * 64 + fr, col0 = (u.pn % nN) * HALF + wc * 32 + 8 * fq;
#pragma unroll
        for (int ai = 0; ai < 2; ++ai)
#pragma unroll
            for (int m = 0; m < 4; ++m) { bf16_t* rowp = O + (size_t)(row0 + ai * HALF + m * 16) * ldc + col0;
                f32x4 a0 = acc[ai][0][m][0], a1 = acc[ai][0][m][1]; const f32x4 b0 = acc[ai][1][m][0], b1 = acc[ai][1][m][1];
#pragma unroll
                for (int j = 0; j < 4; ++j) { a0[j] = silu_f(a0[j]) * b0[j]; a1[j] = silu_f(a1[j]) * b1[j]; }
                u32x4 w; w.x = cvt_pk_bf16(a0[0], a0[1]); w.y = cvt_pk_bf16(a0[2], a0[3]); w.z = cvt_pk_bf16(a1[0], a1[1]); w.w = cvt_pk_bf16(a1[2], a1[3]);
                *(u32x4*)rowp = w; }
    }
};
struct EpiStoreI8 {
    static constexpr bool PERM = true, AFTER_DRAIN = false; typedef i32x4 acc_t;
    bf16_t* O; int ldc; int nN; const float* sa; const float* sb;
    __device__ __forceinline__ void operator()(const i32x4 (&acc)[2][2][4][2], const Unit& u, int wr, int wc, int fr, int fq) const {
        const int row0 = u.pm * BM + wr * 64 + fr, col0 = (u.pn % nN) * BM + wc * 32 + 8 * fq; const float* sbp = sb + (size_t)u.pn * BM + wc * 32 + 8 * fq;
        f32x4 bs[2][2];
#pragma unroll
        for (int bj = 0; bj < 2; ++bj) { bs[bj][0] = *(const f32x4*)(sbp + bj * HALF); bs[bj][1] = *(const f32x4*)(sbp + bj * HALF + 4); }
#pragma unroll
        for (int ai = 0; ai < 2; ++ai)
#pragma unroll
            for (int m = 0; m < 4; ++m) { const int row = row0 + ai * HALF + m * 16; const float as = sa[row]; bf16_t* rowp = O + (size_t)row * ldc + col0;
#pragma unroll
                for (int bj = 0; bj < 2; ++bj) { const i32x4 i0 = acc[ai][bj][m][0], i1 = acc[ai][bj][m][1]; f32x4 v0, v1;
#pragma unroll
                    for (int j = 0; j < 4; ++j) { v0[j] = (float)i0[j] * as * bs[bj][0][j]; v1[j] = (float)i1[j] * as * bs[bj][1][j]; }
                    u32x4 w; w.x = cvt_pk_bf16(v0[0], v0[1]); w.y = cvt_pk_bf16(v0[2], v0[3]); w.z = cvt_pk_bf16(v1[0], v1[1]); w.w = cvt_pk_bf16(v1[2], v1[3]);
                    *(u32x4*)(rowp + bj * HALF) = w; } }
    }
};
struct EpiSwiGLUI8 {
    static constexpr bool PERM = true, AFTER_DRAIN = false; typedef i32x4 acc_t;
    bf16_t* O; int ldc; int nN; const float* sa; const float* sb; float* TM;
    __device__ __forceinline__ void operator()(const i32x4 (&acc)[2][2][4][2], const Unit& u, int wr, int wc, int fr, int fq) const {
        const int pnl = u.pn % nN, row0 = u.pm * BM + wr * 64 + fr, col0 = pnl * HALF + wc * 32 + 8 * fq; const float* sbp = sb + (size_t)u.pn * BM + wc * 32 + 8 * fq;
        f32x4 bs[2][2];
#pragma unroll
        for (int bj = 0; bj < 2; ++bj) { bs[bj][0] = *(const f32x4*)(sbp + bj * HALF); bs[bj][1] = *(const f32x4*)(sbp + bj * HALF + 4); }
#pragma unroll
        for (int ai = 0; ai < 2; ++ai)
#pragma unroll
            for (int m = 0; m < 4; ++m) { const int row = row0 + ai * HALF + m * 16; const float as = sa[row]; bf16_t* rowp = O + (size_t)row * ldc + col0;
                const i32x4 g0 = acc[ai][0][m][0], g1 = acc[ai][0][m][1], u0 = acc[ai][1][m][0], u1 = acc[ai][1][m][1]; f32x4 a0, a1; float mx = 0.f;
#pragma unroll
                for (int j = 0; j < 4; ++j) { a0[j] = silu_f((float)g0[j] * as * bs[0][0][j]) * ((float)u0[j] * as * bs[1][0][j]); a1[j] = silu_f((float)g1[j] * as * bs[0][1][j]) * ((float)u1[j] * as * bs[1][1][j]);
                    mx = fmaxf(mx, fmaxf(fabsf(a0[j]), fabsf(a1[j]))); }
                u32x4 w; w.x = cvt_pk_bf16(a0[0], a0[1]); w.y = cvt_pk_bf16(a0[2], a0[3]); w.z = cvt_pk_bf16(a1[0], a1[1]); w.w = cvt_pk_bf16(a1[2], a1[3]);
                *(u32x4*)rowp = w;
                mx = fmaxf(mx, __shfl_xor(mx, 16)); mx = fmaxf(mx, __shfl_xor(mx, 32));
                if (fq == 0) TM[(size_t)row * 64 + pnl * 4 + wc] = mx; }
    }
};
template <class Epi, class Sched, bool ALIGN_EPI = false, bool SP2 = false>
__device__ __forceinline__ void gemm_phase(PG8_LAS unsigned char* lds, const Gemm g, const Sched& S, const Epi& E, int tid_in) {
    int tid_l = tid_in; asm volatile("" : "+v"(tid_l)); const int tid = tid_l, wid = __builtin_amdgcn_readfirstlane(tid >> 6), lane = tid & 63, wr = wid >> 2, wc = wid & 3, fr = lane & 15, fq = lane >> 4;
    const int K = g.K, nt = K / BK;
    unsigned voffA[2], voffB[2];
#pragma unroll
    for (int i = 0; i < 2; ++i) { int R, C; stage_rc(tid * 16 + i * 8192, R, C); const int Rb = Epi::PERM ? ((R & ~31) + perm32(R & 31)) : R;
        voffA[i] = (unsigned)(R * K + C) * 2u; voffB[i] = (unsigned)(Rb * K + C) * 2u; }
    const size_t kstep = (size_t)(BK * 2);
    const size_t hstep = (size_t)HALF * K * 2;
    const size_t tstep = 2 * hstep;
    const unsigned ldsw = (unsigned)wid * 1024u;
    const int aoff = lds_byte(wr * 64 + fr, fq * 8), boff = lds_byte(wc * 32 + fr, fq * 8);
#define PG8_SA(b, h) (((b) * 2 + (h)) * HTB)
#define PG8_SB(b, h) ((4 + (b) * 2 + (h)) * HTB)
#define PG8_STAGE(bufoff, gbase, voff) do { _Pragma("unroll") for (int _i = 0; _i < 2; ++_i) \
        __builtin_amdgcn_global_load_lds((const unsigned*)((const char*)(gbase) + (voff)[_i]), (PG8_LAS unsigned*)(lds + (bufoff) + ldsw + _i * 8192), 16, 0, 0); } while (0)
#define PG8_LDA(dst, b, h) do { _Pragma("unroll") for (int m = 0; m < 4; ++m) _Pragma("unroll") for (int k = 0; k < 2; ++k) dst[m][k] = *(const PG8_LAS bf16x8*)(lds + PG8_SA(b, h) + aoff + m * 2048 + k * 1024); } while (0)
#define PG8_LDB(dst, b, h) do { _Pragma("unroll") for (int n = 0; n < 2; ++n) _Pragma("unroll") for (int k = 0; k < 2; ++k) dst[n][k] = *(const PG8_LAS bf16x8*)(lds + PG8_SB(b, h) + boff + n * 2048 + k * 1024); } while (0)
#define PG8_MMA(ai, bj, At, Bt) do { __builtin_amdgcn_s_setprio(1); _Pragma("unroll") for (int m = 0; m < 4; ++m) _Pragma("unroll") for (int n = 0; n < 2; ++n) _Pragma("unroll") for (int k = 0; k < 2; ++k) \
        acc[ai][bj][m][n] = mma16(Bt[n][k], At[m][k], acc[ai][bj][m][n]); __builtin_amdgcn_s_setprio(0); } while (0)
#define PG8_WAIT_V(n) asm volatile("s_waitcnt vmcnt(" #n ")" ::: "memory")
#define PG8_WAIT_L(n) asm volatile("s_waitcnt lgkmcnt(" #n ")" ::: "memory")
#define PG8_BAR __builtin_amdgcn_s_barrier()
#define PG8_SCHED __builtin_amdgcn_sched_barrier(0)
    Unit cur, nxt; int ui = 0;
    if (!S.next(0, cur)) return;
    typename Epi::acc_t acc[2][2][4][2];
#pragma unroll
    for (int a = 0; a < 2; ++a)
#pragma unroll
        for (int b = 0; b < 2; ++b)
#pragma unroll
            for (int m = 0; m < 4; ++m)
#pragma unroll
                for (int n = 0; n < 2; ++n) acc[a][b][m][n] = (typename Epi::acc_t){0, 0, 0, 0};
    bf16x8 At[4][2], B0[2][2], B1[2][2];
    const char* cA = (const char*)g.A + (size_t)cur.pm * tstep; const char* cB = (const char*)g.Bt + (size_t)cur.pn * tstep;
    S.a_ready(cur);
    if constexpr (SP2) {
        PG8_STAGE(PG8_SB(0, 0), cB, voffB); PG8_STAGE(PG8_SB(0, 1), cB + hstep, voffB); PG8_STAGE(PG8_SA(0, 0), cA, voffA); PG8_STAGE(PG8_SA(0, 1), cA + hstep, voffA);
        if (wr == 1) PG8_BAR;
        PG8_WAIT_V(2); PG8_BAR;
        PG8_STAGE(PG8_SB(1, 0), cB + kstep, voffB); PG8_STAGE(PG8_SA(1, 0), cA + kstep, voffA); PG8_STAGE(PG8_SB(1, 1), cB + hstep + kstep, voffB);
        PG8_WAIT_V(6); PG8_BAR;
    } else {
        PG8_STAGE(PG8_SB(0, 0), cB, voffB); PG8_STAGE(PG8_SA(0, 0), cA, voffA); PG8_STAGE(PG8_SB(0, 1), cB + hstep, voffB); PG8_STAGE(PG8_SA(0, 1), cA + hstep, voffA);
        if (wr == 1) PG8_BAR;
        PG8_WAIT_V(4); PG8_BAR;
        PG8_STAGE(PG8_SB(1, 0), cB + kstep, voffB); PG8_STAGE(PG8_SA(1, 0), cA + kstep, voffA); PG8_STAGE(PG8_SB(1, 1), cB + hstep + kstep, voffB);
        PG8_WAIT_V(6); PG8_BAR;
    }
    for (;;) {
        const bool has_next = S.next(ui + 1, nxt);
        const char* nA = has_next ? (const char*)g.A + (size_t)nxt.pm * tstep : cA; const char* nB = has_next ? (const char*)g.Bt + (size_t)nxt.pn * tstep : cB;
        for (int t = 0; t < nt; t += 2) {
            const bool last = (t == nt - 2);
            const char* a1 = cA + (size_t)(t + 1) * kstep;
            const char* a2 = last ? nA : cA + (size_t)(t + 2) * kstep; const char* b2 = last ? nB : cB + (size_t)(t + 2) * kstep;
            const char* a3 = a2 + kstep; const char* b3 = b2 + kstep;
            if (last && has_next) S.a_ready(nxt);
            if constexpr (SP2) {
            PG8_LDB(B0, 0, 0); PG8_LDB(B1, 0, 1); PG8_SCHED; PG8_LDA(At, 0, 0); PG8_STAGE(PG8_SA(1, 1), a1 + hstep, voffA);
            PG8_WAIT_V(8); PG8_WAIT_L(0); PG8_BAR; PG8_MMA(0, 0, At, B0); PG8_MMA(0, 1, At, B1); PG8_BAR; PG8_SCHED;
            PG8_LDA(At, 0, 1); PG8_STAGE(PG8_SB(0, 0), b2, voffB); PG8_STAGE(PG8_SB(0, 1), b2 + hstep, voffB); PG8_STAGE(PG8_SA(0, 0), a2, voffA);
            PG8_WAIT_V(8); PG8_WAIT_L(0); PG8_BAR; PG8_MMA(1, 0, At, B0); PG8_MMA(1, 1, At, B1); PG8_BAR; PG8_SCHED;
            PG8_LDB(B0, 1, 0); PG8_LDB(B1, 1, 1); PG8_SCHED; PG8_LDA(At, 1, 0); PG8_STAGE(PG8_SA(0, 1), a2 + hstep, voffA);
            PG8_WAIT_V(8); PG8_WAIT_L(0); PG8_BAR; PG8_MMA(0, 0, At, B0); PG8_MMA(0, 1, At, B1); PG8_BAR; PG8_SCHED;
            PG8_LDA(At, 1, 1); PG8_STAGE(PG8_SB(1, 0), b3, voffB); PG8_STAGE(PG8_SB(1, 1), b3 + hstep, voffB); PG8_STAGE(PG8_SA(1, 0), a3, voffA);
            PG8_WAIT_V(8); PG8_WAIT_L(0); PG8_BAR; PG8_MMA(1, 0, At, B0); PG8_MMA(1, 1, At, B1); PG8_BAR; PG8_SCHED;
            } else {
            PG8_LDB(B0, 0, 0); PG8_SCHED; PG8_LDA(At, 0, 0); PG8_STAGE(PG8_SA(1, 1), a1 + hstep, voffA);
            PG8_WAIT_L(8); PG8_BAR; PG8_WAIT_L(0); PG8_MMA(0, 0, At, B0); PG8_BAR; PG8_SCHED;
            PG8_LDB(B1, 0, 1); PG8_STAGE(PG8_SB(0, 0), b2, voffB);
            PG8_BAR; PG8_WAIT_L(0); PG8_MMA(0, 1, At, B1); PG8_BAR;
            PG8_LDA(At, 0, 1); PG8_STAGE(PG8_SA(0, 0), a2, voffA);
            PG8_BAR; PG8_WAIT_L(0); PG8_MMA(1, 0, At, B0); PG8_BAR; PG8_SCHED;
            PG8_STAGE(PG8_SB(0, 1), b2 + hstep, voffB);
            PG8_WAIT_V(6); PG8_BAR; PG8_MMA(1, 1, At, B1); PG8_BAR;
            PG8_LDB(B0, 1, 0); PG8_SCHED; PG8_LDA(At, 1, 0); PG8_STAGE(PG8_SA(0, 1), a2 + hstep, voffA);
            PG8_WAIT_L(8); PG8_BAR; PG8_WAIT_L(0); PG8_MMA(0, 0, At, B0); PG8_BAR; PG8_SCHED;
            PG8_LDB(B1, 1, 1); PG8_STAGE(PG8_SB(1, 0), b3, voffB);
            PG8_BAR; PG8_WAIT_L(0); PG8_MMA(0, 1, At, B1); PG8_BAR;
            PG8_LDA(At, 1, 1); PG8_STAGE(PG8_SA(1, 0), a3, voffA);
            PG8_BAR; PG8_WAIT_L(0); PG8_MMA(1, 0, At, B0); PG8_BAR; PG8_SCHED;
            PG8_STAGE(PG8_SB(1, 1), b3 + hstep, voffB);
            PG8_WAIT_V(6); PG8_BAR; PG8_MMA(1, 1, At, B1); PG8_BAR;
            }
        }
        if constexpr (ALIGN_EPI) { if (wr == 0) PG8_BAR; }
        if constexpr (!Epi::AFTER_DRAIN) { E(acc, cur, wr, wc, fr, fq); S.done(cur); }
        if (!has_next) break;
#pragma unroll
        for (int a = 0; a < 2; ++a)
#pragma unroll
            for (int b = 0; b < 2; ++b)
#pragma unroll
                for (int m = 0; m < 4; ++m)
#pragma unroll
                    for (int n = 0; n < 2; ++n) acc[a][b][m][n] = (typename Epi::acc_t){0, 0, 0, 0};
        cur = nxt; cA = nA; cB = nB; ++ui;
        if constexpr (ALIGN_EPI) { if (wr == 1) PG8_BAR; }
    }
    PG8_WAIT_V(0);
    if constexpr (!ALIGN_EPI) { if (wr == 0) PG8_BAR; }
    PG8_BAR;
    if constexpr (Epi::AFTER_DRAIN) { E.fused(acc, cur, wr, wc, fr, fq, lds, wid, lane); S.done(cur); }
#undef PG8_SA
#undef PG8_SB
#undef PG8_STAGE
#undef PG8_LDA
#undef PG8_LDB
#undef PG8_MMA
#undef PG8_WAIT_V
#undef PG8_WAIT_L
#undef PG8_BAR
#undef PG8_SCHED
}
}
#define LAS __attribute__((address_space(3)))
typedef unsigned short bf16;
typedef short bf16x8 __attribute__((ext_vector_type(8)));
typedef short bf16x4 __attribute__((ext_vector_type(4)));
typedef float f32x4 __attribute__((ext_vector_type(4)));
typedef float f32x2 __attribute__((ext_vector_type(2)));
typedef unsigned u32x4 __attribute__((ext_vector_type(4)));
typedef unsigned u32x2 __attribute__((ext_vector_type(2)));

constexpr int D = 2048, NB = 8, SEQ = 2048, CTXL = 256, DEPTH = 2, GRIDW = 64;
constexpr int NLAT = NB * SEQ, NCTX = NB * CTXL, NROW = NLAT + NCTX;
constexpr int HA = 8, DHA = 64, HB = 4, DKB = 128, DVB = 256, DECR = 16, GC = 4, CG = 128, MIXC = 128;
constexpr int NE = 16, FF = 2048, CAPL = 256, CAPC = 32;
constexpr int N_IN = 5664, NU = 5888;
constexpr int U_QA = 0, U_KA = 512, U_VA = 1024, U_KB = 1536, U_VB = 2048, U_QB = 3072, U_GB = 3584, U_UC = 4608, U_VC = 5120, U_DEC = 5632;
constexpr int MIX_A = 0, MIX_B = 512, MIX_C = 1536;
constexpr float EPS = 1e-6f;
constexpr int ME0 = NB * CAPL + NB * CAPC, ME1 = NB * CAPL;

constexpr size_t MiB = 1u << 20;
constexpr size_t WS_CTL = 0, CTL_ZERO_BYTES = 65536;
constexpr size_t WS_MOD = 1 * MiB;
constexpr size_t WS_ROPE = 2 * MiB;
constexpr size_t WS_CV = WS_ROPE + 65536;
constexpr size_t WS_AFF = 3 * MiB;
constexpr size_t WS_TSLOT = 5 * MiB;
constexpr size_t WS_GD = 6656 * 1024;
constexpr size_t WS_WIN = 8 * MiB;
constexpr size_t WS_SIN = WS_WIN + 24 * MiB;
constexpr size_t WS_WOUT = 54 * MiB;
constexpr size_t WS_W1 = 70 * MiB;
constexpr size_t WS_S1 = WS_W1 + 256 * MiB;
constexpr size_t WS_W2 = 582 * MiB;
constexpr size_t WS_S2 = WS_W2 + 128 * MiB;
constexpr size_t WS_H = 838 * MiB;
constexpr size_t WS_HS = WS_H + 36 * MiB;
constexpr size_t WS_XC = 910 * MiB;
constexpr size_t WS_R1 = 926 * MiB;
constexpr size_t WS_R2 = 1133 * MiB;
constexpr size_t WS_XSS = WS_R2 + 72 * MiB;
constexpr size_t WS_TM = WS_R1 + 144 * MiB;
constexpr size_t WS_ACTS = WS_TM + 9 * MiB;
constexpr size_t WS_ACTQ = 1349 * MiB;
constexpr size_t WS_GQ = WS_R2, WS_GK = WS_R2 + 36 * MiB, WS_GV = WS_R2 + 72 * MiB;
constexpr size_t WS_MIX = 1277 * MiB;
constexpr size_t WS_OB = 1349 * MiB;
constexpr size_t WS_END = 1421 * MiB;
constexpr size_t WS_DUMMY = WS_END;
constexpr size_t WS_XB = WS_END + 72 * MiB;
constexpr size_t WS_END2 = WS_XB + 72 * MiB;
static_assert((size_t)DEPTH * NU * D * 2 <= 46 * MiB && (size_t)NROW * NU * 2 <= 207 * MiB && (size_t)NE * ME0 * D * 2 <= 144 * MiB && (size_t)NROW * D * 2 <= 72 * MiB, "ws map");
constexpr int CW_TMO = 0, CW_BAR = 4096, CW_BG = 8192, CW_SIG = 8256;

constexpr int LDS_BYTES = 147456, NWAVES = 8, NTHR = 512;
constexpr int LDS_XB = 147456 - 64;

using pg8::silu_f; using pg8::xmax16; using pg8::xmax32; using pg8::xsum16; using pg8::xsum32;
typedef __bf16 hwbf16x2 __attribute__((ext_vector_type(2)));
__device__ __forceinline__ unsigned pk2(float lo, float hi) { const f32x2 v = {lo, hi}; const hwbf16x2 b = __builtin_convertvector(v, hwbf16x2); return __builtin_bit_cast(unsigned, b); }
__device__ __forceinline__ unsigned f2bf(float f) { return pk2(f, 0.f) & 0xffffu; }
__device__ __forceinline__ float bf2f(unsigned b) { return __builtin_bit_cast(float, b << 16); }
__device__ __forceinline__ float bflo(unsigned w) { return __builtin_bit_cast(float, w << 16); }
__device__ __forceinline__ float bfhi(unsigned w) { return __builtin_bit_cast(float, w & 0xffff0000u); }
template <int CTRL, int ROWMASK> __device__ __forceinline__ float dpp_f(float old, float v) { return __builtin_bit_cast(float, __builtin_amdgcn_update_dpp(__builtin_bit_cast(int, old), __builtin_bit_cast(int, v), CTRL, ROWMASK, 0xf, false)); }
__device__ __forceinline__ float wave_sum(float v) {
    v += dpp_f<0xB1, 0xf>(0.f, v); v += dpp_f<0x4E, 0xf>(0.f, v); v += dpp_f<0x141, 0xf>(0.f, v); v += dpp_f<0x140, 0xf>(0.f, v);
    v += dpp_f<0x142, 0xa>(0.f, v); v += dpp_f<0x143, 0xc>(0.f, v);
    return __builtin_bit_cast(float, __builtin_amdgcn_readlane(__builtin_bit_cast(int, v), 63));
}
__device__ __forceinline__ float gelu_tanh(float x) { const float u = 0.7978845608028654f * (x + 0.044715f * x * x * x); const float e = __expf(2.0f * u); return 0.5f * x * (2.0f - 2.0f * __builtin_amdgcn_rcpf(1.0f + e)); }
__device__ __forceinline__ float log_sigmoid(float z) { return fminf(z, 0.0f) - __logf(1.0f + __expf(-fabsf(z))); }
#define LDS_WAIT() asm volatile("s_waitcnt lgkmcnt(0)" ::: "memory")

__device__ __forceinline__ void row_load_f32(const float* p, int lane, float (&v)[32]) {
#pragma unroll
    for (int j = 0; j < 4; ++j) { const f32x4 a = *(const f32x4*)(p + 512 * j + 8 * lane), b = *(const f32x4*)(p + 512 * j + 8 * lane + 4);
        v[8 * j + 0] = a[0]; v[8 * j + 1] = a[1]; v[8 * j + 2] = a[2]; v[8 * j + 3] = a[3]; v[8 * j + 4] = b[0]; v[8 * j + 5] = b[1]; v[8 * j + 6] = b[2]; v[8 * j + 7] = b[3]; }
}
__device__ __forceinline__ void row_load_f32_nt(const float* p, int lane, float (&v)[32]) {
#pragma unroll
    for (int j = 0; j < 4; ++j) { const f32x4 a = __builtin_nontemporal_load((const f32x4*)(p + 512 * j + 8 * lane)), b = __builtin_nontemporal_load((const f32x4*)(p + 512 * j + 8 * lane + 4));
        v[8 * j + 0] = a[0]; v[8 * j + 1] = a[1]; v[8 * j + 2] = a[2]; v[8 * j + 3] = a[3]; v[8 * j + 4] = b[0]; v[8 * j + 5] = b[1]; v[8 * j + 6] = b[2]; v[8 * j + 7] = b[3]; }
}
__device__ __forceinline__ void row_load_bf16_nt(const bf16* p, int lane, float (&v)[32]) {
#pragma unroll
    for (int j = 0; j < 4; ++j) { const u32x4 a = __builtin_nontemporal_load((const u32x4*)(p + 512 * j + 8 * lane));
        v[8 * j + 0] = bflo(a.x); v[8 * j + 1] = bfhi(a.x); v[8 * j + 2] = bflo(a.y); v[8 * j + 3] = bfhi(a.y); v[8 * j + 4] = bflo(a.z); v[8 * j + 5] = bfhi(a.z); v[8 * j + 6] = bflo(a.w); v[8 * j + 7] = bfhi(a.w); }
}
__device__ __forceinline__ void row_store_f32(float* p, int lane, const float (&v)[32]) {
#pragma unroll
    for (int j = 0; j < 4; ++j) { __builtin_nontemporal_store((f32x4){v[8 * j], v[8 * j + 1], v[8 * j + 2], v[8 * j + 3]}, (f32x4*)(p + 512 * j + 8 * lane)); __builtin_nontemporal_store((f32x4){v[8 * j + 4], v[8 * j + 5], v[8 * j + 6], v[8 * j + 7]}, (f32x4*)(p + 512 * j + 8 * lane + 4)); }
}
__device__ __forceinline__ void row_load_bf16(const bf16* p, int lane, float (&v)[32]) {
#pragma unroll
    for (int j = 0; j < 4; ++j) { const u32x4 a = *(const u32x4*)(p + 512 * j + 8 * lane);
        v[8 * j + 0] = bflo(a.x); v[8 * j + 1] = bfhi(a.x); v[8 * j + 2] = bflo(a.y); v[8 * j + 3] = bfhi(a.y); v[8 * j + 4] = bflo(a.z); v[8 * j + 5] = bfhi(a.z); v[8 * j + 6] = bflo(a.w); v[8 * j + 7] = bfhi(a.w); }
}
__device__ __forceinline__ void row_store_bf16(bf16* p, int lane, const float (&v)[32]) {
#pragma unroll
    for (int j = 0; j < 4; ++j) { u32x4 a; a.x = pk2(v[8 * j], v[8 * j + 1]); a.y = pk2(v[8 * j + 2], v[8 * j + 3]); a.z = pk2(v[8 * j + 4], v[8 * j + 5]); a.w = pk2(v[8 * j + 6], v[8 * j + 7]); __builtin_nontemporal_store(a, (u32x4*)(p + 512 * j + 8 * lane)); }
}
__device__ __forceinline__ float row_sumsq(const float (&v)[32]) { float s = 0.f;
#pragma unroll
    for (int i = 0; i < 32; ++i) s += v[i] * v[i];
    return wave_sum(s); }

#define XB_TMO      128
#define XB_XCNT(j)  (256  + 64 * (j))
#define XB_XSUB(j)  (1280 + 64 * (j))
#define XB_XGEN(j)  (2304 + 64 * (j))
#define XB_TOP      3328
#define XB_TOPGEN   3392
#define XCD_BAR_WORDS 3456
#define XB_SPIN_CAP (1u << 18)
#define LAS __attribute__((address_space(3)))

__device__ __forceinline__ unsigned xb_ld(unsigned* p)              { return __hip_atomic_load(p, __ATOMIC_RELAXED, __HIP_MEMORY_SCOPE_AGENT); }
__device__ __forceinline__ unsigned xb_add(unsigned* p, unsigned v) { return __hip_atomic_fetch_add(p, v, __ATOMIC_RELAXED, __HIP_MEMORY_SCOPE_AGENT); }
__device__ __forceinline__ unsigned xb_xcc_id() { return (unsigned)__builtin_amdgcn_s_getreg((3 << 11) | 20) & 0xFu; }
#define XB_SPIN(cond, bar) do { unsigned _sp = 0; while (cond) { __builtin_amdgcn_s_sleep(1); \
    if ((++_sp & 255u) == 0u) { if (xb_ld(&(bar)[XB_TMO])) break; if (_sp > XB_SPIN_CAP) { atomicAdd(&(bar)[XB_TMO], 1u); break; } } } } while (0)

struct XcdBarrier {
    unsigned* bar; unsigned x;
    volatile LAS unsigned* st;
};

__device__ __forceinline__ XcdBarrier xcd_barrier_post(unsigned* bar, volatile LAS unsigned* st) {
    XcdBarrier b; b.bar = bar; b.x = xb_xcc_id(); b.st = st;
    if (threadIdx.x == 0) (void)xb_add(&bar[XB_XCNT(b.x)], 1u);
    return b;
}
__device__ __forceinline__ void xcd_barrier_complete(unsigned* bar, unsigned x, unsigned& nloc, unsigned& nx) {
    const unsigned G = gridDim.x * gridDim.y * gridDim.z;
    unsigned sum, cnt, mine, sp = 0u;
    for (;;) {
        sum = 0u; cnt = 0u; mine = 0u;
#pragma unroll
        for (unsigned j = 0; j < 16; ++j) { const unsigned c = xb_ld(&bar[XB_XCNT(j)]); sum += c; cnt += (c > 0u) ? 1u : 0u; mine = (j == x) ? c : mine; }
        if (sum == G) break;
        __builtin_amdgcn_s_sleep(1);
        if ((++sp & 255u) == 0u) { if (xb_ld(&bar[XB_TMO])) break; if (sp > XB_SPIN_CAP) { atomicAdd(&bar[XB_TMO], 1u); break; } }
    }
    nloc = mine > 0u ? mine : 1u; nx = cnt > 0u ? cnt : 1u;
}

__device__ __forceinline__ void xcd_barrier(const XcdBarrier& b) {
    asm volatile("s_waitcnt vmcnt(0)" ::: "memory");
    __syncthreads();
    if (threadIdx.x == 0) {
        unsigned* bar = b.bar;
        __builtin_amdgcn_s_waitcnt(0);
        unsigned nloc = b.st[0], nx = b.st[1];
        if (nloc == 0u) { xcd_barrier_complete(bar, b.x, nloc, nx); b.st[0] = nloc; b.st[1] = nx; }
        const unsigned old = xb_add(&bar[XB_XSUB(b.x)], 1u);
        const unsigned gen = old / nloc;
        if (old + 1u == (gen + 1u) * nloc) {
            __builtin_amdgcn_fence(__ATOMIC_RELEASE, "agent");
            asm volatile("s_waitcnt vmcnt(0)" ::: "memory");
            const unsigned og = xb_add(&bar[XB_TOP], 1u);
            const unsigned tg = og / nx;
            if (og + 1u == (tg + 1u) * nx) xb_add(&bar[XB_TOPGEN], 1u);
            else XB_SPIN(xb_ld(&bar[XB_TOPGEN]) == tg, bar);
            __builtin_amdgcn_fence(__ATOMIC_ACQUIRE, "agent");
            xb_add(&bar[XB_XGEN(b.x)], 1u);
            asm volatile("s_waitcnt vmcnt(0)" ::: "memory");
        } else {
            XB_SPIN(xb_ld(&bar[XB_XGEN(b.x)]) == gen, bar);
            __builtin_amdgcn_fence(__ATOMIC_ACQUIRE, "agent");
            asm volatile("s_waitcnt vmcnt(0)" ::: "memory");
        }
    }
    __syncthreads();
}

struct Frame {
    LAS unsigned char* lds;
    int tid, lane, wave, vcu, G;
    const float *x, *c, *ctx, *c_ctx, *w_ada, *b_ada, *g_pre_mix, *g_post_mix, *g_pre_ffn, *g_post_ffn, *w_in, *w_dec, *b_dec, *rpb, *g_gla, *ln_v_g, *ln_v_b, *w_sp, *b_sp, *w_out, *w_router, *w_gate, *w_up, *w_down;
    float* out; unsigned char* ws;
};

#define W_MOD(F) ((float*)((F).ws + WS_MOD))
#define W_ROPE(F) ((float*)((F).ws + WS_ROPE))
#define W_CV(F) ((bf16*)((F).ws + WS_CV))
#define W_AFF(F) ((float*)((F).ws + WS_AFF))
#define W_XC(F) ((float*)((F).ws + WS_XC))
#define W_XB(F) ((bf16*)((F).ws + WS_XB))
#define W_TSLOT(F) ((int*)((F).ws + WS_TSLOT))
#define W_WIN(F) ((bf16*)((F).ws + WS_WIN))
#define W_WOUT(F) ((bf16*)((F).ws + WS_WOUT))
#define W_W1(F) ((bf16*)((F).ws + WS_W1))
#define W_W2(F) ((bf16*)((F).ws + WS_W2))
#define W_H(F) ((bf16*)((F).ws + WS_H))
#define W_U(F) ((bf16*)((F).ws + WS_R1))
#define W_Y(F) ((bf16*)((F).ws + WS_R1))
#define W_ACT(F) ((bf16*)((F).ws + WS_R1))
#define W_XS(F) ((bf16*)((F).ws + WS_R2))
#define W_MIX(F) ((bf16*)((F).ws + WS_MIX))
#define W_OB(F) ((bf16*)((F).ws + WS_OB))
#define W_SIN(F) ((float*)((F).ws + WS_SIN))
#define W_S1(F) ((float*)((F).ws + WS_S1))
#define W_S2(F) ((float*)((F).ws + WS_S2))
#define W_HQ(F) ((signed char*)((F).ws + WS_H))
#define W_HS(F) ((float*)((F).ws + WS_HS))
#define W_XSQ(F) ((signed char*)((F).ws + WS_R2))
#define W_XSS(F) ((float*)((F).ws + WS_XSS))
#define W_TM(F) ((float*)((F).ws + WS_TM))
#define W_ACTS(F) ((float*)((F).ws + WS_ACTS))
#define W_ACTQ(F) ((signed char*)((F).ws + WS_ACTQ))
__device__ __forceinline__ void launder(Frame& F) {
    int wv = F.wave; asm volatile("" : "+s"(wv)); F.wave = wv;
    unsigned ones = ~0u; asm volatile("" : "+s"(ones));
    int t = wv * 64 + (int)__builtin_amdgcn_mbcnt_hi(ones, __builtin_amdgcn_mbcnt_lo(ones, 0u)); asm volatile("" : "+v"(t)); F.tid = t; F.lane = t & 63;
    int v = F.vcu; asm volatile("" : "+s"(v)); F.vcu = v;
    __attribute__((address_space(1))) unsigned char* w = (__attribute__((address_space(1))) unsigned char*)F.ws; asm volatile("" : "+s"(w)); F.ws = (unsigned char*)w;
}

__device__ __forceinline__ float wave_max(float v) {
    v = fmaxf(v, dpp_f<0xB1, 0xf>(v, v)); v = fmaxf(v, dpp_f<0x4E, 0xf>(v, v)); v = fmaxf(v, dpp_f<0x141, 0xf>(v, v)); v = fmaxf(v, dpp_f<0x140, 0xf>(v, v));
    v = fmaxf(v, dpp_f<0x142, 0xa>(v, v)); v = fmaxf(v, dpp_f<0x143, 0xc>(v, v));
    return __builtin_bit_cast(float, __builtin_amdgcn_readlane(__builtin_bit_cast(int, v), 63));
}
__device__ __forceinline__ unsigned pack4_i8(float a, float b, float c, float d) { return ((unsigned)(int)a & 0xffu) | (((unsigned)(int)b & 0xffu) << 8) | (((unsigned)(int)c & 0xffu) << 16) | (((unsigned)(int)d & 0xffu) << 24); }
__device__ __forceinline__ unsigned q4_i8(float a, float b, float c, float d, float inv) {
    const unsigned x0 = __builtin_bit_cast(unsigned, fmaf(a, inv, 12582912.f)), x1 = __builtin_bit_cast(unsigned, fmaf(b, inv, 12582912.f)), x2 = __builtin_bit_cast(unsigned, fmaf(c, inv, 12582912.f)), x3 = __builtin_bit_cast(unsigned, fmaf(d, inv, 12582912.f));
    return __builtin_amdgcn_perm(x1, x0, 0x0c0c0400u) | __builtin_amdgcn_perm(x3, x2, 0x04000c0cu);
}
__device__ __forceinline__ void row_store_i8(signed char* p, int lane, const float (&v)[32], float inv) {
#pragma unroll
    for (int j = 0; j < 4; ++j) { u32x2 o; o.x = q4_i8(v[8 * j], v[8 * j + 1], v[8 * j + 2], v[8 * j + 3], inv); o.y = q4_i8(v[8 * j + 4], v[8 * j + 5], v[8 * j + 6], v[8 * j + 7], inv);
        __builtin_nontemporal_store(o, (u32x2*)(p + 512 * j + 8 * lane)); }
}

#define LBAR() do { asm volatile("s_waitcnt lgkmcnt(0)" ::: "memory"); __builtin_amdgcn_s_barrier(); asm volatile("" ::: "memory"); } while (0)
__device__ __forceinline__ int dest_row(int mode, int n) {
    if (mode == 1) return n < 3072 ? n : (n < 3104 ? U_DEC + (n - 3072) : n - 32);
    if (mode == 2) return ((n >> 7) << 8) + (n & 127);
    if (mode == 3) return ((n >> 7) << 8) + 128 + (n & 127);
    return n;
}
constexpr int IN_ITEMS = (N_IN + 63) / 64;
constexpr int BG_IN0 = IN_ITEMS, BG_A = BG_IN0 + NE * 3 * 32, BG_B = BG_A + IN_ITEMS, BG_TOTAL = BG_B + NE * 3 * 32;
__device__ __forceinline__ unsigned pkbf(float lo, float hi) { unsigned r; asm volatile("v_cvt_pk_bf16_f32 %0, %1, %2" : "=v"(r) : "v"(lo), "v"(hi)); return r; }
__device__ __forceinline__ void strip_item(Frame& F, int id) {
    const int lane = F.lane, n16 = lane & 15, kq = lane >> 4;
    LAS float* cm = (LAS float*)(F.lds); LAS unsigned* qb = (LAS unsigned*)(F.lds + 2048);
    const int l = id >= BG_A ? 1 : 0, idl = l ? id - BG_A : id; const bool isin = idl < IN_ITEMS; const int itm = isin ? idl : idl - IN_ITEMS;
    const int mi = itm >> 5, n0 = isin ? itm * 64 : (itm & 31) * 64, e = mi / 3, which = isin ? 3 : mi % 3; const size_t le = (size_t)l * NE + e;
    const float* W = isin ? F.w_in + (size_t)l * D * N_IN : (which == 0 ? F.w_gate + le * D * FF : (which == 1 ? F.w_up + le * D * FF : F.w_down + le * FF * D));
    const int mode = isin ? 1 : (which == 0 ? 2 : (which == 1 ? 3 : 0)), pitch = isin ? N_IN : D, N = isin ? N_IN : D;
    signed char* dq = isin ? (signed char*)(F.ws + WS_WIN) + (size_t)l * NU * D : (which == 2 ? (signed char*)(F.ws + WS_W2) + le * D * FF : (signed char*)(F.ws + WS_W1) + le * (2 * FF) * D);
    float* ds = isin ? W_SIN(F) + (size_t)l * NU : (which == 2 ? W_S2(F) + le * D : W_S1(F) + le * (2 * FF));
    const bool colok = (n0 + 4 * n16) < N;
    const float* src = W + (size_t)(256 * F.wave + 4 * kq) * pitch + n0 + 4 * n16;
    unsigned pk[16][4][2];
#pragma unroll
    for (int hb = 0; hb < 4; ++hb) {
        f32x4 t[4][4];
#pragma unroll
        for (int j = 0; j < 4; ++j)
#pragma unroll
            for (int e4 = 0; e4 < 4; ++e4) t[j][e4] = colok ? __builtin_nontemporal_load((const f32x4*)(src + (size_t)(16 * (4 * hb + j) + e4) * pitch)) : (f32x4){0.f, 0.f, 0.f, 0.f};
#pragma unroll
        for (int j = 0; j < 4; ++j) {
#pragma unroll
            for (int e4 = 0; e4 < 4; ++e4) { pk[4 * hb + j][e4][0] = pkbf(t[j][e4][0], t[j][e4][1]); pk[4 * hb + j][e4][1] = pkbf(t[j][e4][2], t[j][e4][3]); }
            asm volatile("" : "+v"(pk[4 * hb + j][0][0]), "+v"(pk[4 * hb + j][0][1]), "+v"(pk[4 * hb + j][1][0]), "+v"(pk[4 * hb + j][1][1]), "+v"(pk[4 * hb + j][2][0]), "+v"(pk[4 * hb + j][2][1]), "+v"(pk[4 * hb + j][3][0]), "+v"(pk[4 * hb + j][3][1]) :: "memory");
        }
    }
    typedef unsigned short u16x2 __attribute__((ext_vector_type(2)));
    u16x2 m01 = {0, 0}, m23 = {0, 0};
#pragma unroll
    for (int j = 0; j < 16; ++j)
#pragma unroll
        for (int e4 = 0; e4 < 4; ++e4) { m01 = __builtin_elementwise_max(m01, __builtin_bit_cast(u16x2, pk[j][e4][0] & 0x7fff7fffu)); m23 = __builtin_elementwise_max(m23, __builtin_bit_cast(u16x2, pk[j][e4][1] & 0x7fff7fffu)); }
    float mx[4] = {bf2f(m01[0]), bf2f(m01[1]), bf2f(m23[0]), bf2f(m23[1])};
#pragma unroll
    for (int c = 0; c < 4; ++c) { mx[c] = fmaxf(mx[c], __shfl_xor(mx[c], 16)); mx[c] = fmaxf(mx[c], __shfl_xor(mx[c], 32)); }
    if (lane < 16) *(LAS f32x4*)(cm + F.wave * 64 + 4 * lane) = (f32x4){mx[0], mx[1], mx[2], mx[3]};
#pragma unroll
    for (int j = 0; j < 16; ++j)
        asm volatile("" : "+v"(pk[j][0][0]), "+v"(pk[j][0][1]), "+v"(pk[j][1][0]), "+v"(pk[j][1][1]), "+v"(pk[j][2][0]), "+v"(pk[j][2][1]), "+v"(pk[j][3][0]), "+v"(pk[j][3][1]));
    LBAR();
    f32x4 cmx = (f32x4){0.f, 0.f, 0.f, 0.f};
#pragma unroll
    for (int w = 0; w < 8; ++w) { const f32x4 c4 = *(const LAS f32x4*)(cm + w * 64 + 4 * n16); cmx = __builtin_elementwise_max(cmx, c4); }
    float sc[4], iv[4];
#pragma unroll
    for (int c = 0; c < 4; ++c) { sc[c] = cmx[c] > 0.f ? cmx[c] * (1.0f / 127.0f) : 1.0f; iv[c] = 1.0f / sc[c]; }
    if (F.tid < 16 && colok) {
#pragma unroll
        for (int c = 0; c < 4; ++c) ds[dest_row(mode, n0 + 4 * F.tid + c)] = sc[c]; }
    const int sw = (n16 >> 1);
#pragma unroll
    for (int j = 0; j < 16; ++j) {
        unsigned o[4];
#pragma unroll
        for (int c = 0; c < 4; ++c) { unsigned x[4];
#pragma unroll
            for (int e4 = 0; e4 < 4; ++e4) { const unsigned wv = pk[j][e4][c >> 1]; const float xf = (c & 1) ? bfhi(wv) : bflo(wv); x[e4] = __builtin_bit_cast(unsigned, fmaf(xf, iv[c], 12582912.f)); }
            o[c] = __builtin_amdgcn_perm(x[1], x[0], 0x0c0c0400u) | __builtin_amdgcn_perm(x[3], x[2], 0x04000c0cu); }
        const int idx4 = (16 * F.wave + j) ^ sw;
#pragma unroll
        for (int c = 0; c < 4; ++c) qb[(4 * n16 + c) * 516 + 4 * idx4 + kq] = o[c];
    }
    LBAR();
#pragma unroll
    for (int q16 = 0; q16 < 16; ++q16) { const int p = F.tid + 512 * q16, n = p >> 7, c16 = p & 127;
        if (n0 + n < N) __builtin_nontemporal_store(*(const LAS u32x4*)(qb + n * 516 + 4 * (c16 ^ (n >> 3))), (u32x4*)(dq + (size_t)dest_row(mode, n0 + n) * D + 16 * c16)); }
    LBAR();
}
__device__ __forceinline__ void bg_loop(Frame& F, unsigned* ctl, const unsigned* sig, int limit) {
    LAS int* flag = (LAS int*)(F.lds + 140000);
    unsigned* head = ctl + CW_BG;
    __syncthreads();
    for (;;) {
        if (F.tid == 0) { int idx = -1;
            const bool stop = sig && __hip_atomic_load(sig, __ATOMIC_RELAXED, __HIP_MEMORY_SCOPE_AGENT) != 0u;
            if (!stop && (int)__hip_atomic_load(head, __ATOMIC_RELAXED, __HIP_MEMORY_SCOPE_AGENT) + BG_IN0 < limit) { idx = (int)__hip_atomic_fetch_add(head, 1u, __ATOMIC_RELAXED, __HIP_MEMORY_SCOPE_AGENT) + BG_IN0; if (idx >= BG_TOTAL) idx = -1; }
            *flag = idx; }
        __syncthreads();
        const int idx = *flag;
        __syncthreads();
        if (idx < 0) break;
        strip_item(F, idx);
    }
}
#ifndef MK_REPP0
#define MK_REPP0 0u
#endif
__device__ __forceinline__ void transpose_item(const float* W, int N, int k0, int n0, bf16* dst, int mode, LAS float* scr, int lane) {
    const bool nok = (n0 + lane) < N;
    const float* src = W + (size_t)k0 * N + n0 + lane;
#pragma unroll 8
    for (int i = 0; i < 64; ++i) scr[i * 65 + lane] = nok ? __builtin_nontemporal_load(src + (size_t)i * N) : 0.f;
    LDS_WAIT();
    const int c = lane & 7;
#pragma unroll
    for (int j = 0; j < 8; ++j) { const int nl = (lane >> 3) + 8 * j, n = n0 + nl; const LAS float* s = scr + (8 * c) * 65 + nl;
        u32x4 o; o.x = pk2(s[0 * 65], s[1 * 65]); o.y = pk2(s[2 * 65], s[3 * 65]); o.z = pk2(s[4 * 65], s[5 * 65]); o.w = pk2(s[6 * 65], s[7 * 65]);
        if (n < N) *(u32x4*)(dst + (size_t)dest_row(mode, n) * D + k0 + 8 * c) = o; }
    LDS_WAIT();
}
__device__ __forceinline__ void p0a(Frame& F) {
    const int gw = F.vcu * NWAVES + F.wave, NGW = F.G * NWAVES, lane = F.lane;
    for (int rep0 = 0; rep0 < 1 + (int)(MK_REPP0 & 1u); ++rep0) {
        LAS float* red = (LAS float*)F.lds;
        for (int it = F.vcu; it < DEPTH * 96; it += F.G) {
            const int l = it / 96, n0 = (it % 96) * 128;
            float acc[9][2];
#pragma unroll
            for (int r = 0; r < 9; ++r) { acc[r][0] = 0.f; acc[r][1] = 0.f; }
            for (int kb = 0; kb < 4; ++kb) {
                const int k0 = 256 * F.wave + 64 * kb;
                float sv[9];
#pragma unroll
                for (int r = 0; r < 8; ++r) sv[r] = silu_f(F.c[r * D + k0 + lane]);
                sv[8] = silu_f(F.c_ctx[k0 + lane]);
                const float* wp = F.w_ada + ((size_t)l * D + k0) * (6 * D) + n0 + 2 * lane;
#pragma unroll 4
                for (int kk = 0; kk < 64; ++kk) {
                    const f32x2 wv = __builtin_nontemporal_load((const f32x2*)(wp + (size_t)kk * (6 * D)));
#pragma unroll
                    for (int r = 0; r < 9; ++r) { const float s = __builtin_bit_cast(float, __builtin_amdgcn_readlane(__builtin_bit_cast(int, sv[r]), kk)); acc[r][0] += s * wv.x; acc[r][1] += s * wv.y; }
                }
            }
#pragma unroll
            for (int r = 0; r < 9; ++r) { red[(F.wave * 9 + r) * 128 + 2 * lane] = acc[r][0]; red[(F.wave * 9 + r) * 128 + 2 * lane + 1] = acc[r][1]; }
            __syncthreads();
            for (int o = F.tid; o < 9 * 128; o += NTHR) { const int r = o >> 7, col = o & 127; float s = 0.f;
#pragma unroll
                for (int w = 0; w < 8; ++w) s += red[(w * 9 + r) * 128 + col];
                W_MOD(F)[((size_t)l * 9 + r) * (6 * D) + n0 + col] = s + F.b_ada[(size_t)l * 6 * D + n0 + col]; }
            __syncthreads();
        }
    }
    {
        const int gid = (F.vcu * NTHR + F.tid);
        if (gid < 64 * 32) {
            const int pos = gid >> 5, f = gid & 31;
            double inv = 1.0; for (int i = 0; i < f; ++i) inv *= 0.74989420933245582730;
            const double xa = (double)pos * inv;
            const double q = __builtin_rint(xa * 0.63661977236758134308);
            double y = __builtin_fma(-q, 1.57079632679489655800, xa); y = __builtin_fma(-q, 6.12323399573676603587e-17, y);
            const double y2 = y * y;
            double sn = -1.0 / 1307674368000.0; sn = sn * y2 + 1.0 / 6227020800.0; sn = sn * y2 - 1.0 / 39916800.0; sn = sn * y2 + 1.0 / 362880.0; sn = sn * y2 - 1.0 / 5040.0; sn = sn * y2 + 1.0 / 120.0; sn = sn * y2 - 1.0 / 6.0; sn = sn * y2 + 1.0; sn *= y;
            double cs = 1.0 / 20922789888000.0; cs = cs * y2 - 1.0 / 87178291200.0; cs = cs * y2 + 1.0 / 479001600.0; cs = cs * y2 - 1.0 / 3628800.0; cs = cs * y2 + 1.0 / 40320.0; cs = cs * y2 - 1.0 / 720.0; cs = cs * y2 + 1.0 / 24.0; cs = cs * y2 - 0.5; cs = cs * y2 + 1.0;
            const int qi = ((int)q) & 3;
            const double c2 = (qi == 0) ? cs : (qi == 1) ? -sn : (qi == 2) ? -cs : sn;
            const double s2 = (qi == 0) ? sn : (qi == 1) ? cs : (qi == 2) ? -sn : -cs;
            W_ROPE(F)[gid] = (float)c2; W_ROPE(F)[2048 + gid] = (float)s2;
        }
    }
    {
        const int per = (NU - N_IN) * D / 16;
        for (int i = F.vcu * NTHR + F.tid; i < DEPTH * per; i += F.G * NTHR) { const int l = i / per, r = i % per;
            *(u32x4*)((signed char*)(F.ws + WS_WIN) + ((size_t)l * NU + N_IN) * D + (size_t)r * 16) = (u32x4){0u, 0u, 0u, 0u}; }
        for (int i = F.vcu * NTHR + F.tid; i < DEPTH * (NU - N_IN); i += F.G * NTHR) W_SIN(F)[(size_t)(i / (NU - N_IN)) * NU + N_IN + i % (NU - N_IN)] = 1.0f;
    }
    for (int rep1 = 0; rep1 < 1 + (int)((MK_REPP0 >> 1) & 1u); ++rep1) {
        LAS float* scr = (LAS float*)(F.lds + F.wave * 16640);
        constexpr int I_OUT = 32 * 32;
        for (int it = gw; it < DEPTH * I_OUT; it += NGW) {
            const int l = it / I_OUT, r = it % I_OUT;
            transpose_item(F.w_out + (size_t)l * D * D, D, (r >> 5) * 64, (r & 31) * 64, W_WOUT(F) + (size_t)l * D * D, 0, scr, lane);
        }
    }
    __syncthreads();
    for (int it = F.G - 1 - F.vcu; it < IN_ITEMS; it += F.G) strip_item(F, it);
    if (MK_REPP0 & 4u) { for (int it = F.vcu; it < BG_TOTAL; it += F.G) strip_item(F, it); }
    __syncthreads();
}

__device__ __forceinline__ void prenorm_row(Frame& F, int l, int m, const float (&xv)[32], int row) {
    const float r = 1.0f / sqrtf(row_sumsq(xv) * (1.0f / D) + EPS);
    const float* g = F.g_pre_mix + (size_t)l * D; const float* mod = W_MOD(F) + ((size_t)l * 9 + m) * (6 * D);
    float gv[32], shv[32], scv[32], hv[32];
    row_load_f32(g, F.lane, gv); row_load_f32(mod, F.lane, shv); row_load_f32(mod + D, F.lane, scv);
#pragma unroll
    for (int i = 0; i < 32; ++i) hv[i] = xv[i] * r * gv[i] * (1.0f + scv[i]) + shv[i];
    float am = 0.f;
#pragma unroll
    for (int i = 0; i < 32; ++i) am = fmaxf(am, fabsf(hv[i]));
    am = wave_max(am);
    const float scale = am > 0.f ? am * (1.0f / 127.0f) : 1.0f;
    row_store_i8(W_HQ(F) + (size_t)row * D, F.lane, hv, 1.0f / scale);
    if (F.lane == 0) W_HS(F)[row] = scale;
}
__device__ __forceinline__ void prenorm_row_cv(Frame& F, int l, int m, const float (&xv)[32], int row) {
    const bf16* cv = W_CV(F) + ((size_t)l * 9 + m) * 6 * D;
    float c4[32], c5[32], hv[32];
    row_load_bf16(cv + 4 * D, F.lane, c4); row_load_bf16(cv + 5 * D, F.lane, c5);
    const float r = 1.0f / sqrtf(row_sumsq(xv) * (1.0f / D) + EPS);
#pragma unroll
    for (int i = 0; i < 32; ++i) hv[i] = xv[i] * r * c4[i] + c5[i];
    float am = 0.f;
#pragma unroll
    for (int i = 0; i < 32; ++i) am = fmaxf(am, fabsf(hv[i]));
    am = wave_max(am);
    const float scale = am > 0.f ? am * (1.0f / 127.0f) : 1.0f;
    row_store_i8(W_HQ(F) + (size_t)row * D, F.lane, hv, 1.0f / scale);
    if (F.lane == 0) W_HS(F)[row] = scale;
}
__device__ __forceinline__ void p0b(Frame& F) {
    const int gw = F.vcu * NWAVES + F.wave, NGW = F.G * NWAVES;
    for (int i = F.vcu * NTHR + F.tid; i < DEPTH * 9 * (D / 8); i += F.G * NTHR) {
        const int lm = i / (D / 8), k0 = (i % (D / 8)) * 8, l = lm / 9; const float* mod = W_MOD(F) + (size_t)lm * (6 * D);
        bf16* cv = W_CV(F) + (size_t)lm * 6 * D + k0;
        float o[6][8];
#pragma unroll
        for (int e = 0; e < 8; ++e) { const int k = k0 + e;
            o[0][e] = mod[2 * D + k] * F.g_post_mix[(size_t)l * D + k]; o[1][e] = F.g_pre_ffn[(size_t)l * D + k] * (1.0f + mod[4 * D + k]); o[2][e] = mod[3 * D + k];
            o[3][e] = mod[5 * D + k] * F.g_post_ffn[(size_t)l * D + k]; o[4][e] = F.g_pre_mix[(size_t)l * D + k] * (1.0f + mod[D + k]); o[5][e] = mod[k]; }
#pragma unroll
        for (int v = 0; v < 6; ++v) { u32x4 w; w.x = pk2(o[v][0], o[v][1]); w.y = pk2(o[v][2], o[v][3]); w.z = pk2(o[v][4], o[v][5]); w.w = pk2(o[v][6], o[v][7]); *(u32x4*)(cv + (size_t)v * D) = w; }
    }
    for (int row = gw; row < NROW; row += 2 * NGW) {
        const int row2 = (row + NGW < NROW) ? row + NGW : row;
        const float* xp = row < NLAT ? F.x + (size_t)row * D : F.ctx + (size_t)(row - NLAT) * D; const int m = row < NLAT ? row / SEQ : 8;
        const float* xp2 = row2 < NLAT ? F.x + (size_t)row2 * D : F.ctx + (size_t)(row2 - NLAT) * D; const int m2 = row2 < NLAT ? row2 / SEQ : 8;
        float xv[32], xv2[32]; row_load_f32_nt(xp, F.lane, xv); row_load_f32_nt(xp2, F.lane, xv2);
        prenorm_row(F, 0, m, xv, row);
        prenorm_row(F, 0, m2, xv2, row2);
    }
}

#define MFMA16(a, b, c) __builtin_amdgcn_mfma_f32_16x16x32_bf16((a), (b), (c), 0, 0, 0)
__device__ __forceinline__ bf16x8 mk8(u32x2 lo, u32x2 hi) { u32x4 t; t.x = lo.x; t.y = lo.y; t.z = hi.x; t.w = hi.y; return __builtin_bit_cast(bf16x8, t); }
#define GLA_POS(i) (dir ? (nseg - 1 - (64 * cc + (i))) : (64 * cc + (i)))
struct PpIdx { int dir, h, cc, nseg, rowbase; bool lat; };
__device__ __forceinline__ PpIdx pp_idx(int un) { PpIdx I; const int cidx = un % 36, bhd = un / 36; I.dir = bhd & 1; I.h = (bhd >> 1) & 3; const int b = bhd >> 3; I.lat = cidx >= 4; I.cc = I.lat ? cidx - 4 : cidx; I.nseg = I.lat ? SEQ : CTXL; I.rowbase = I.lat ? b * SEQ : NLAT + b * CTXL; return I; }
#define PP_POS(I, i) ((I).dir ? ((I).nseg - 1 - (64 * (I).cc + (i))) : (64 * (I).cc + (i)))
struct PpRegs { u32x4 dec[4]; unsigned vw[16]; unsigned short qraw[16], kraw[16]; float wd[8]; float bd; };
__device__ __forceinline__ void pp_load_v(Frame& F, int un, PpRegs& R) {
    const PpIdx I = pp_idx(un); const int tid = F.tid; const bf16* U = W_U(F);
    { const int c15 = tid & 15, g1 = (tid >> 4) & 1;
#pragma unroll
      for (int it = 0; it < 4; ++it) R.dec[it] = *(const u32x4*)(U + (size_t)(I.rowbase + PP_POS(I, 16 * it + c15)) * NU + U_DEC + I.dir * 16 + 8 * g1); }
    const int vq = tid & 127, jp4 = tid >> 7;
#pragma unroll
    for (int jj = 0; jj < 16; ++jj) R.vw[jj] = *(const unsigned*)(U + (size_t)(I.rowbase + PP_POS(I, 16 * jp4 + jj)) * NU + U_VB + I.h * 256 + 2 * vq);
}
__device__ __forceinline__ void pp_load_w(Frame& F, int l, int un, PpRegs& R) {
    const PpIdx I = pp_idx(un); const int ch = I.h * 128 + 16 * F.wave + (F.tid & 15), g1 = (F.tid >> 4) & 1;
#pragma unroll
    for (int r = 0; r < 8; ++r) R.wd[r] = F.w_dec[(((size_t)l * 2 + I.dir) * DECR + 8 * g1 + r) * 512 + ch];
    R.bd = F.b_dec[((size_t)l * 2 + I.dir) * 512 + ch];
}
__device__ __forceinline__ void pp_load_qk(Frame& F, int un, PpRegs& R) {
    const PpIdx I = pp_idx(un); const int k = F.tid & 127, ip = F.tid >> 7; const bf16* U = W_U(F);
#pragma unroll
    for (int ii = 0; ii < 16; ++ii) { const bf16* rp = U + (size_t)(I.rowbase + PP_POS(I, 16 * ip + ii)) * NU; R.qraw[ii] = rp[U_QB + I.h * 128 + k]; R.kraw[ii] = rp[U_KB + I.h * 128 + k]; }
}
__device__ __forceinline__ void gla_prepass(Frame& F, int l, int un, int unx, PpRegs& R) {
    const int cidx = un % 36, bhd = un / 36, dir = bhd & 1, h = (bhd >> 1) & 3, b = bhd >> 3;
    const int tid = F.tid, lane = F.lane, w = F.wave, c15 = lane & 15, g = lane >> 4;
    LAS unsigned char* L = F.lds;
    LAS bf16* Qt = (LAS bf16*)(L);
    LAS bf16* Kt = (LAS bf16*)(L + 17408);
    LAS bf16* VT = (LAS bf16*)(L + 34816);
    LAS float* PS = (LAS float*)(L + 71680);
    LAS float* ZL = (LAS float*)(L + 73728);
    const bool lat = cidx >= 4; const int cc = lat ? cidx - 4 : cidx, nseg = lat ? SEQ : CTXL, rowbase = lat ? b * SEQ : NLAT + b * CTXL;
    const bool need_out = lat || (l == 0);
    const int k = tid & 127, ip = tid >> 7;
    bf16* GQ = (bf16*)(F.ws + WS_GQ) + (size_t)un * 8192; bf16* GK = (bf16*)(F.ws + WS_GK) + (size_t)un * 8192; bf16* GV = (bf16*)(F.ws + WS_GV) + (size_t)un * 16384; float* GD = (float*)(F.ws + WS_GD) + (size_t)un * 128;
    float rcs[16], rsn[16];
    { const float* COS = W_ROPE(F); const float* SIN = COS + 2048;
#pragma unroll
      for (int ii = 0; ii < 16; ++ii) { const int pos = GLA_POS(16 * ip + ii), pp = (k < 64) ? (pos >> 6) : (pos & 63); rcs[ii] = COS[pp * 32 + (k & 31)]; rsn[ii] = SIN[pp * 32 + (k & 31)]; } }
    {
        const int vq = tid & 127, jp4 = tid >> 7; unsigned vw[16];
#pragma unroll
        for (int jj = 0; jj < 16; ++jj) vw[jj] = R.vw[jj];
        u32x4 a0, a1, b0, b1;
        a0.x = (vw[0] & 0xffffu) | (vw[1] << 16); a0.y = (vw[2] & 0xffffu) | (vw[3] << 16); a0.z = (vw[4] & 0xffffu) | (vw[5] << 16); a0.w = (vw[6] & 0xffffu) | (vw[7] << 16);
        a1.x = (vw[8] & 0xffffu) | (vw[9] << 16); a1.y = (vw[10] & 0xffffu) | (vw[11] << 16); a1.z = (vw[12] & 0xffffu) | (vw[13] << 16); a1.w = (vw[14] & 0xffffu) | (vw[15] << 16);
        b0.x = (vw[0] >> 16) | (vw[1] & 0xffff0000u); b0.y = (vw[2] >> 16) | (vw[3] & 0xffff0000u); b0.z = (vw[4] >> 16) | (vw[5] & 0xffff0000u); b0.w = (vw[6] >> 16) | (vw[7] & 0xffff0000u);
        b1.x = (vw[8] >> 16) | (vw[9] & 0xffff0000u); b1.y = (vw[10] >> 16) | (vw[11] & 0xffff0000u); b1.z = (vw[12] >> 16) | (vw[13] & 0xffff0000u); b1.w = (vw[14] >> 16) | (vw[15] & 0xffff0000u);
        *(LAS u32x4*)(VT + (2 * vq) * 72 + 16 * jp4) = a0; *(LAS u32x4*)(VT + (2 * vq) * 72 + 16 * jp4 + 8) = a1;
        *(LAS u32x4*)(VT + (2 * vq + 1) * 72 + 16 * jp4) = b0; *(LAS u32x4*)(VT + (2 * vq + 1) * 72 + 16 * jp4 + 8) = b1;
    }
    {
        u32x4 bw;
        { float ws_[8];
#pragma unroll
          for (int j = 0; j < 8; ++j) { const float wv = R.wd[j]; const float hj = bflo(pk2(wv, wv)); ws_[j] = (g >= 2) ? wv - hj : wv; }
          bw.x = pk2(ws_[0], ws_[1]); bw.y = pk2(ws_[2], ws_[3]); bw.z = pk2(ws_[4], ws_[5]); bw.w = pk2(ws_[6], ws_[7]); }
        const bf16x8 bop = __builtin_bit_cast(bf16x8, bw); const float bdv = R.bd;
#pragma unroll
        for (int it = 0; it < 4; ++it) {
            const f32x4 z4 = MFMA16(__builtin_bit_cast(bf16x8, R.dec[it]), bop, ((f32x4){bdv, bdv, bdv, bdv}));
#pragma unroll
            for (int rg = 0; rg < 4; ++rg) { const float z = z4[rg];
                const float e = __builtin_amdgcn_exp2f(fabsf(z) * -1.4426950408889634f);
                ZL[(16 * it + 4 * g + rg) * 132 + 16 * w + c15] = (fminf(z, 0.0f) * 1.4426950408889634f - __builtin_amdgcn_logf(1.0f + e)) * (1.0f / 16.0f); }
        }
    }
    asm volatile("" ::: "memory");
    pp_load_v(F, unx, R);
    pp_load_w(F, l, unx, R);
    LBAR();
    float bloc[16]; float run = 0.f;
#pragma unroll
    for (int ii = 0; ii < 16; ++ii) { run += ZL[(16 * ip + ii) * 132 + k]; bloc[ii] = run; }
    PS[ip * 128 + k] = run;
    LBAR();
    {
        float off = 0.f, btot = 0.f;
#pragma unroll
        for (int p = 0; p < 4; ++p) { const float s = PS[p * 128 + k]; btot += s; if (p < ip) off += s; }
        const float etot = __builtin_amdgcn_exp2f(btot);
        if (ip == 0) GD[k] = etot;
        unsigned short kh[16];
        float qpart[16], kpart[16];
        if (lat) {
#pragma unroll
            for (int ii = 0; ii < 16; ++ii) { qpart[ii] = __shfl_xor(bf2f(R.qraw[ii]), 32); kpart[ii] = __shfl_xor(bf2f(R.kraw[ii]), 32); }
            asm volatile("" ::: "memory");
        }
#pragma unroll
        for (int ii = 0; ii < 16; ++ii) {
            const int i = 16 * ip + ii; const float bb = bloc[ii] + off;
            float qv = bf2f(R.qraw[ii]), kv = bf2f(R.kraw[ii]);
            if (lat) {
                const float cs = rcs[ii], sn = rsn[ii];
                const float qo = qpart[ii], ko = kpart[ii];
                qv = qv * cs + ((k & 32) ? qo : -qo) * sn; kv = kv * cs + ((k & 32) ? ko : -ko) * sn;
            }
            const float eb = __builtin_amdgcn_exp2f(bb), kt = kv * __builtin_amdgcn_rcpf(eb);
            Qt[i * 136 + k] = (bf16)f2bf(qv * 0.08838834764831845f * eb);
            Kt[i * 136 + k] = (bf16)f2bf(kt);
            kh[ii] = (unsigned short)f2bf(kt * etot);
        }
        u32x4 w0, w1;
        w0.x = kh[0] | ((unsigned)kh[1] << 16); w0.y = kh[2] | ((unsigned)kh[3] << 16); w0.z = kh[4] | ((unsigned)kh[5] << 16); w0.w = kh[6] | ((unsigned)kh[7] << 16);
        w1.x = kh[8] | ((unsigned)kh[9] << 16); w1.y = kh[10] | ((unsigned)kh[11] << 16); w1.z = kh[12] | ((unsigned)kh[13] << 16); w1.w = kh[14] | ((unsigned)kh[15] << 16);
        *(u32x4*)(GK + k * 64 + 16 * ip) = w0; *(u32x4*)(GK + k * 64 + 16 * ip + 8) = w1;
    }
    asm volatile("" ::: "memory");
    pp_load_qk(F, unx, R);
    {
        const int v = tid >> 1, hf = tid & 1; const LAS bf16* sp = VT + v * 72 + 32 * hf; bf16* dp = GV + v * 64 + 32 * hf;
#pragma unroll
        for (int q = 0; q < 4; ++q) *(u32x4*)(dp + 8 * q) = *(const LAS u32x4*)(sp + 8 * q);
    }
    LBAR();
    if (need_out) {
        {
#pragma unroll
            for (int q = 0; q < 2; ++q) { const int p = tid + 512 * q, i = p >> 4, c8 = (p & 15) * 8; *(u32x4*)(GQ + i * 128 + c8) = *(const LAS u32x4*)(Qt + i * 136 + c8); }
        }
        const int ib = w & 3, vh = w >> 2;
        bf16x8 qf[4];
#pragma unroll
        for (int ks = 0; ks < 4; ++ks) qf[ks] = *(const LAS bf16x8*)(Qt + (16 * ib + c15) * 136 + 32 * ks + 8 * g);
        f32x4 at[4];
#pragma unroll
        for (int jb = 0; jb < 4; ++jb) { at[jb] = (f32x4){0.f, 0.f, 0.f, 0.f};
#pragma unroll
            for (int ks = 0; ks < 4; ++ks) { const bf16x8 a = *(const LAS bf16x8*)(Kt + (16 * jb + c15) * 136 + 32 * ks + 8 * g); at[jb] = MFMA16(a, qf[ks], at[jb]); }
#pragma unroll
            for (int rg = 0; rg < 4; ++rg) if (16 * jb + 4 * g + rg > 16 * ib + c15) at[jb][rg] = 0.f; }
        bf16x8 pf[2];
#pragma unroll
        for (int k2 = 0; k2 < 2; ++k2) { u32x4 t; t.x = pk2(at[2 * k2][0], at[2 * k2][1]); t.y = pk2(at[2 * k2][2], at[2 * k2][3]); t.z = pk2(at[2 * k2 + 1][0], at[2 * k2 + 1][1]); t.w = pk2(at[2 * k2 + 1][2], at[2 * k2 + 1][3]); pf[k2] = __builtin_bit_cast(bf16x8, t); }
        bf16* op = W_OB(F) + ((size_t)dir * NROW + rowbase + GLA_POS(16 * ib + c15)) * (HB * DVB) + h * 256 + 4 * g;
#pragma unroll
        for (int vt = 0; vt < 8; ++vt) { const int vtile = 8 * vh + vt; f32x4 o = (f32x4){0.f, 0.f, 0.f, 0.f};
#pragma unroll
            for (int k2 = 0; k2 < 2; ++k2) { const LAS bf16* vp = VT + (16 * vtile + c15) * 72 + 32 * k2 + 4 * g; o = MFMA16(mk8(*(const LAS u32x2*)vp, *(const LAS u32x2*)(vp + 16)), pf[k2], o); }
            u32x2 ov; ov.x = pk2(o[0], o[1]); ov.y = pk2(o[2], o[3]);
            *(u32x2*)(op + 16 * vtile) = ov; }
    }
    LBAR();
}
struct ChRegs { u32x4 rq[2], rk[2], rv; u32x2 oi[2]; };
__device__ __forceinline__ void gla_chain(Frame& F, int l, int ch, bool dry) {
    const int b = ch >> 5, h = (ch >> 3) & 3, dir = (ch >> 2) & 1, vs = ch & 3;
    const int tid = F.tid, lane = F.lane, w = F.wave, c15 = lane & 15, g = lane >> 4;
    LAS unsigned char* L = F.lds;
    constexpr int BUFB = 45056;
    LAS float* DKall = (LAS float*)(L + 2 * BUFB + 2 * 17408);
    LAS unsigned char* PART = L + 2 * BUFB;
    const int un0 = (((b * 4 + h) * 2) + dir) * 36;
    const bf16* GQ = (const bf16*)(F.ws + WS_GQ) + (size_t)un0 * 8192; const bf16* GK = (const bf16*)(F.ws + WS_GK) + (size_t)un0 * 8192;
    const bf16* GV = (const bf16*)(F.ws + WS_GV) + (size_t)un0 * 16384 + (size_t)vs * 4096; const float* GD = (const float*)(F.ws + WS_GD) + (size_t)un0 * 128;
    const int vt4 = w & 3, kq = w >> 2;
    bf16* OBd = W_OB(F) + (size_t)dir * NROW * (HB * DVB) + h * 256 + vs * 64 + 16 * vt4 + 4 * g;
    bf16* OBs = dry ? (bf16*)(F.ws + WS_DUMMY) + (size_t)dir * NROW * (HB * DVB) + h * 256 + vs * 64 + 16 * vt4 + 4 * g : OBd;
    f32x4 sacc[4];
#pragma unroll
    for (int t = 0; t < 4; ++t) sacc[t] = (f32x4){0.f, 0.f, 0.f, 0.f};
    for (int i = tid; i < 36 * 128; i += NTHR) DKall[i] = GD[i];
#define CH_OROW(c, it) (((c) >= 4 ? b * SEQ : NLAT + b * CTXL) + (dir ? (((c) >= 4 ? SEQ : CTXL) - 1 - (64 * ((c) >= 4 ? (c) - 4 : (c)) + 16 * (it) + c15)) : (64 * ((c) >= 4 ? (c) - 4 : (c)) + 16 * (it) + c15)))
#define CH_LOAD(R, c) do { const bool no_ = (c) >= 4 || l == 0; \
        _Pragma("unroll") for (int q_ = 0; q_ < 2; ++q_) { const int p_ = tid + 512 * q_; if (no_) R.rq[q_] = *(const u32x4*)(GQ + (size_t)(c) * 8192 + p_ * 8); R.rk[q_] = *(const u32x4*)(GK + (size_t)(c) * 8192 + p_ * 8); } \
        R.rv = *(const u32x4*)(GV + (size_t)(c) * 16384 + tid * 8); \
        if (no_) { R.oi[0] = *(const u32x2*)(OBd + (size_t)CH_OROW(c, 2 * kq) * (HB * DVB)); R.oi[1] = *(const u32x2*)(OBd + (size_t)CH_OROW(c, 2 * kq + 1) * (HB * DVB)); } } while (0)
#define CH_PUT(R, bs) do { LAS unsigned char* B_ = L + (bs) * BUFB; \
        _Pragma("unroll") for (int q_ = 0; q_ < 2; ++q_) { const int p_ = tid + 512 * q_; *(LAS u32x4*)((LAS bf16*)B_ + (p_ >> 4) * 136 + (p_ & 15) * 8) = R.rq[q_]; *(LAS u32x4*)((LAS bf16*)(B_ + 17408) + (p_ >> 3) * 72 + (p_ & 7) * 8) = R.rk[q_]; } \
        *(LAS u32x4*)((LAS bf16*)(B_ + 35840) + (tid >> 3) * 72 + (tid & 7) * 8) = R.rv; } while (0)
#define CH_FIN(cp, par) do { \
        const f32x4 pp0_ = *(const LAS f32x4*)(PART + (par) * 16384 + ((w ^ 4) * 2 + 0) * 1024 + lane * 16), pp1_ = *(const LAS f32x4*)(PART + (par) * 16384 + ((w ^ 4) * 2 + 1) * 1024 + lane * 16); \
        { const f32x4 o = pown[0] + pp0_; u32x2 ov; ov.x = pk2(o[0] + bflo(poi[0].x), o[1] + bfhi(poi[0].x)); ov.y = pk2(o[2] + bflo(poi[0].y), o[3] + bfhi(poi[0].y)); *(u32x2*)(OBs + (size_t)CH_OROW(cp, 2 * kq) * (HB * DVB)) = ov; } \
        { const f32x4 o = pown[1] + pp1_; u32x2 ov; ov.x = pk2(o[0] + bflo(poi[1].x), o[1] + bfhi(poi[1].x)); ov.y = pk2(o[2] + bflo(poi[1].y), o[3] + bfhi(poi[1].y)); *(u32x2*)(OBs + (size_t)CH_OROW(cp, 2 * kq + 1) * (HB * DVB)) = ov; } } while (0)
#define CH_STEP(cidx, RC, RN) do { \
        const bool need_out_ = (cidx) >= 4 || l == 0; const int bs_ = (cidx) & 1; \
        LAS unsigned char* B = L + bs_ * BUFB; \
        const LAS bf16* Qt = (const LAS bf16*)B; const LAS bf16* KhT = (const LAS bf16*)(B + 17408); const LAS bf16* VTs = (const LAS bf16*)(B + 35840); const LAS float* Dk = DKall + (cidx) * 128; \
        if (pend) CH_FIN((cidx) - 1, bs_ ^ 1);                                \
        const u32x2 oi0_ = RC.oi[0], oi1_ = RC.oi[1];                       \
        if ((cidx) + 2 < 36) CH_LOAD(RC, (cidx) + 2);                         \
        if (need_out_) {                                                      \
            bf16x8 sop[2], qop[4][2]; \
            _Pragma("unroll") for (int k2 = 0; k2 < 2; ++k2) { u32x4 t_; t_.x = pk2(sacc[2 * k2][0], sacc[2 * k2][1]); t_.y = pk2(sacc[2 * k2][2], sacc[2 * k2][3]); t_.z = pk2(sacc[2 * k2 + 1][0], sacc[2 * k2 + 1][1]); t_.w = pk2(sacc[2 * k2 + 1][2], sacc[2 * k2 + 1][3]); sop[k2] = __builtin_bit_cast(bf16x8, t_); } \
            _Pragma("unroll") for (int x4 = 0; x4 < 4; ++x4) { const int it_ = (x4 < 2) ? 2 * kq + x4 : 2 * (1 - kq) + (x4 - 2);     \
                _Pragma("unroll") for (int k2 = 0; k2 < 2; ++k2) { const LAS bf16* qp_ = Qt + (16 * it_ + c15) * 136 + 16 * (4 * kq + 2 * k2) + 4 * g; qop[x4][k2] = mk8(*(const LAS u32x2*)qp_, *(const LAS u32x2*)(qp_ + 16)); } } \
            asm volatile("" ::: "memory"); \
            f32x4 pa_[4]; \
            _Pragma("unroll") for (int x4 = 0; x4 < 4; ++x4) { pa_[x4] = MFMA16(sop[0], qop[x4][0], ((f32x4){0.f, 0.f, 0.f, 0.f})); pa_[x4] = MFMA16(sop[1], qop[x4][1], pa_[x4]); } \
            pown[0] = pa_[0]; pown[1] = pa_[1]; \
            *(LAS f32x4*)(PART + bs_ * 16384 + (w * 2 + 0) * 1024 + lane * 16) = pa_[2]; *(LAS f32x4*)(PART + bs_ * 16384 + (w * 2 + 1) * 1024 + lane * 16) = pa_[3]; \
        } \
        poi[0] = oi0_; poi[1] = oi1_; pend = need_out_; \
        { bf16x8 va[2], kb[4][2]; f32x4 dk[4]; \
        _Pragma("unroll") for (int k2 = 0; k2 < 2; ++k2) va[k2] = *(const LAS bf16x8*)(VTs + (16 * vt4 + c15) * 72 + 32 * k2 + 8 * g); \
        _Pragma("unroll") for (int t4 = 0; t4 < 4; ++t4) { dk[t4] = *(const LAS f32x4*)(Dk + 16 * (4 * kq + t4) + 4 * g); _Pragma("unroll") for (int k2 = 0; k2 < 2; ++k2) kb[t4][k2] = *(const LAS bf16x8*)(KhT + (16 * (4 * kq + t4) + c15) * 72 + 32 * k2 + 8 * g); } \
        asm volatile("" ::: "memory"); \
        _Pragma("unroll") for (int t4 = 0; t4 < 4; ++t4) { \
            sacc[t4] = sacc[t4] * dk[t4]; \
            _Pragma("unroll") for (int k2 = 0; k2 < 2; ++k2) sacc[t4] = MFMA16(kb[t4][k2], va[k2], sacc[t4]); } } \
        if ((cidx) + 1 < 36) CH_PUT(RN, bs_ ^ 1);                             \
        LBAR(); \
    } while (0)
    ChRegs RA, RB;
    RA.rq[0] = RA.rq[1] = RB.rq[0] = RB.rq[1] = (u32x4){0u, 0u, 0u, 0u}; RA.oi[0] = RA.oi[1] = RB.oi[0] = RB.oi[1] = (u32x2){0u, 0u};
    f32x4 pown[2]; u32x2 poi[2]; bool pend = false;
    pown[0] = pown[1] = (f32x4){0.f, 0.f, 0.f, 0.f}; poi[0] = poi[1] = (u32x2){0u, 0u};
    CH_LOAD(RA, 0); CH_PUT(RA, 0); CH_LOAD(RB, 1);
    LBAR();
    for (int c2 = 0; c2 < 36; c2 += 2) {
        CH_STEP(c2, RA, RB);
        CH_STEP(c2 + 1, RB, RA);
    }
    if (pend) CH_FIN(35, 1);
#undef CH_LOAD
#undef CH_PUT
#undef CH_FIN
#undef CH_STEP
#undef CH_OROW
}
#undef GLA_POS

__device__ __forceinline__ int clampi(int v, int lo, int hi) { return v < lo ? lo : (v > hi ? hi : v); }
typedef short s16x4 __attribute__((ext_vector_type(4)));
#define ATT_TR(p) __builtin_bit_cast(u32x2, __builtin_amdgcn_ds_read_tr16_b64_v4i16((LAS s16x4*)(p)))
template <int NB, bool LOCAL>
__device__ __forceinline__ void attn_tile(const LAS bf16* Kt, const LAS bf16* Vt, const LAS float* bias_row, const bf16x8 (&qf)[2], int kb0, const int (&dco)[8], int c15, int g, float& m_run, float& l_run, f32x4 (&oacc)[4]) {
    f32x4 sc[NB];
    {
        bf16x8 kf[NB][2]; float bv[NB][4];
#pragma unroll
        for (int nb = 0; nb < NB; ++nb) {
#pragma unroll
            for (int s = 0; s < 2; ++s) kf[nb][s] = *(const LAS bf16x8*)(Kt + (kb0 + 16 * nb + c15) * 72 + 32 * s + 8 * g);
            if (LOCAL) {
#pragma unroll
                for (int rg = 0; rg < 4; ++rg) bv[nb][rg] = bias_row[dco[(4 * nb + rg) & 7]]; } }
        asm volatile("" ::: "memory");
#pragma unroll
        for (int nb = 0; nb < NB; ++nb) { sc[nb] = (f32x4){0.f, 0.f, 0.f, 0.f};
#pragma unroll
            for (int s = 0; s < 2; ++s) sc[nb] = MFMA16(kf[nb][s], qf[s], sc[nb]);
#pragma unroll
            for (int rg = 0; rg < 4; ++rg) sc[nb][rg] = sc[nb][rg] * 0.18033688011112042f + (LOCAL ? bv[nb][rg] : 0.f); }
    }
    float mt = -1e30f;
#pragma unroll
    for (int nb = 0; nb < NB; ++nb)
#pragma unroll
        for (int rg = 0; rg < 4; ++rg) mt = fmaxf(mt, sc[nb][rg]);
    mt = fmaxf(mt, __shfl_xor(mt, 16)); mt = fmaxf(mt, __shfl_xor(mt, 32));
    const float m_new = fmaxf(m_run, mt), alpha = __builtin_amdgcn_exp2f(m_run - m_new);
    m_run = m_new; float ps = 0.f;
#pragma unroll
    for (int nb = 0; nb < NB; ++nb)
#pragma unroll
        for (int rg = 0; rg < 4; ++rg) { const float p = __builtin_amdgcn_exp2f(sc[nb][rg] - m_new); sc[nb][rg] = p; ps += p; }
    l_run = l_run * alpha + ps;
    bf16x8 pf[NB / 2];
#pragma unroll
    for (int k2 = 0; k2 < NB / 2; ++k2) { u32x4 tt; tt.x = pk2(sc[2 * k2][0], sc[2 * k2][1]); tt.y = pk2(sc[2 * k2][2], sc[2 * k2][3]); tt.z = pk2(sc[2 * k2 + 1][0], sc[2 * k2 + 1][1]); tt.w = pk2(sc[2 * k2 + 1][2], sc[2 * k2 + 1][3]); pf[k2] = __builtin_bit_cast(bf16x8, tt); }
    {
        bf16x8 vf[4][NB / 2];
#pragma unroll
        for (int d = 0; d < 4; ++d)
#pragma unroll
            for (int k2 = 0; k2 < NB / 2; ++k2) { const LAS bf16* vp = Vt + (kb0 + 32 * k2 + 4 * g + (c15 >> 2)) * 80 + 16 * d + 4 * (c15 & 3);
                vf[d][k2] = mk8(ATT_TR(vp), ATT_TR(vp + 16 * 80)); }
        asm volatile("" ::: "memory");
#pragma unroll
        for (int d = 0; d < 4; ++d) { oacc[d] = oacc[d] * alpha;
#pragma unroll
            for (int k2 = 0; k2 < NB / 2; ++k2) oacc[d] = MFMA16(vf[d][k2], pf[k2], oacc[d]); }
    }
}
__device__ __forceinline__ void attn_unit(Frame& F, int l, int u) {
    const int tid = F.tid, lane = F.lane, w = F.wave, c15 = lane & 15, g = lane >> 4;
    LAS unsigned char* L = F.lds;
    LAS bf16* Ks = (LAS bf16*)L;
    LAS bf16* VTs = (LAS bf16*)(L + 18432);
    LAS float* rpbs = (LAS float*)(L + 38912);
    const bool isctx = u >= 1024;
    int b, h, r0 = 0, qb = 0;
    if (!isctx) { b = u >> 7; h = (u >> 4) & 7; r0 = (u & 15) * 2; } else { const int cu = u - 1024; b = cu >> 4; h = (cu >> 1) & 7; qb = cu & 1; }
    const int r = r0 + (w >> 2), cq = 16 * (w & 3) + c15;
    const int qrow = isctx ? NLAT + b * CTXL + qb * 128 + 16 * w + c15 : b * SEQ + r * 64 + cq;
    bf16x8 qf[2];
#pragma unroll
    for (int s = 0; s < 2; ++s) qf[s] = *(const bf16x8*)(W_U(F) + (size_t)qrow * NU + U_QA + h * 64 + 32 * s + 8 * g);
    int lo = 0, nloc = 0, rs = 0;
    if (!isctx) { lo = clampi(r0 - 4, 0, 24); nloc = clampi(r0 - 3, 0, 24) + 8 - lo; rs = clampi(r - 4, 0, 24); }
    const int ntiles = nloc + 4, cs0 = clampi(cq - 8, 0, 48), kb0 = clampi(16 * (w & 3) - 8, 0, 32);
    if (!isctx) for (int i = tid; i < 15 * 32; i += NTHR) { const int rr = i >> 5, cc2 = i & 31; rpbs[i] = cc2 < 31 ? F.rpb[((size_t)l * HA + h) * 465 + rr * 31 + cc2] * 1.4426950408889634f : -1e30f; }
    int dco[8];
#pragma unroll
    for (int e8 = 0; e8 < 8; ++e8) { const int ck = kb0 + 16 * (e8 >> 2) + 4 * g + (e8 & 3); dco[e8] = (ck >= cs0 && ck < cs0 + 16) ? clampi(ck - cq + 15, 0, 30) : 31; }
    const int key = tid >> 3, ch8 = (tid & 7) * 8;
#define ATT_ROW(t) ((t) < nloc ? b * SEQ + (lo + (t)) * 64 + key : NLAT + b * CTXL + ((t) - nloc) * 64 + key)
#define ATT_PUT(KR, VR, buf) do { *(LAS u32x4*)(Ks + (buf) * 4608 + key * 72 + ch8) = KR; *(LAS u32x4*)(VTs + (buf) * 5120 + key * 80 + ch8) = VR; } while (0)
#define ATT_LD(KR, VR, t) do { if ((t) < ntiles) { const bf16* rp_ = W_U(F) + (size_t)ATT_ROW(t) * NU + h * 64 + ch8; KR = *(const u32x4*)(rp_ + U_KA); VR = *(const u32x4*)(rp_ + U_VA); } } while (0)
#define ATT_STEP(t, KN, VN) do { if ((t) < ntiles) { const int buf = (t) & 1; const bool local = (t) < nloc; const int kr = lo + (t); \
        const bool active = !local || (kr >= rs && kr <= rs + 7); \
        if (active) { \
            if (local) attn_tile<2, true>(Ks + buf * 4608, VTs + buf * 5120, rpbs + (kr - r + 7) * 32, qf, kb0, dco, c15, g, m_run, l_run, oacc); \
            else attn_tile<4, false>(Ks + buf * 4608, VTs + buf * 5120, rpbs, qf, 0, dco, c15, g, m_run, l_run, oacc); \
        } \
        if ((t) + 1 < ntiles) ATT_PUT(KN, VN, buf ^ 1); \
        ATT_LD(KN, VN, (t) + 4); \
        LBAR(); } } while (0)
    u32x4 k0 = (u32x4){0u, 0u, 0u, 0u}, v0 = k0, k1 = k0, v1 = k0, k2 = k0, v2 = k0;
    ATT_LD(k0, v0, 0);
    ATT_PUT(k0, v0, 0);
    ATT_LD(k1, v1, 1); ATT_LD(k2, v2, 2); ATT_LD(k0, v0, 3);
    LBAR();
    float m_run = -1e30f, l_run = 0.f;
    f32x4 oacc[4];
#pragma unroll
    for (int d = 0; d < 4; ++d) oacc[d] = (f32x4){0.f, 0.f, 0.f, 0.f};
    for (int t3 = 0; t3 < ntiles; t3 += 3) {
        ATT_STEP(t3, k1, v1);
        ATT_STEP(t3 + 1, k2, v2);
        ATT_STEP(t3 + 2, k0, v0);
    }
#undef ATT_LD
#undef ATT_STEP
    float lt = l_run; lt += __shfl_xor(lt, 16); lt += __shfl_xor(lt, 32);
    const float inv = 1.0f / lt;
#pragma unroll
    for (int d = 0; d < 4; ++d) { u32x2 ov; ov.x = pk2(oacc[d][0] * inv, oacc[d][1] * inv); ov.y = pk2(oacc[d][2] * inv, oacc[d][3] * inv);
        *(u32x2*)(W_MIX(F) + (size_t)qrow * D + MIX_A + h * 64 + 16 * d + 4 * g) = ov; }
#undef ATT_ROW
#undef ATT_PUT
}

__device__ __forceinline__ void gmlp_unit(Frame& F, int l, int u) {
    const int tid = F.tid, lane = F.lane, w = F.wave, c15 = lane & 15, g = lane >> 4;
    LAS bf16* Wl = (LAS bf16*)F.lds;
    LAS bf16* VTl = (LAS bf16*)(F.lds + 34816);
    int rowbase, gg;
    if (u < 512) { const int b = u >> 6, n = (u >> 2) & 15; gg = u & 3; rowbase = b * SEQ + n * MIXC; } else { const int cu = u - 512, b = cu >> 3, n = (cu >> 2) & 1; gg = cu & 3; rowbase = NLAT + b * CTXL + n * MIXC; }
    {
        const int p = tid >> 2, q0 = (tid & 3) * 32; const float* wp = F.w_sp + (((size_t)l * GC + gg) * MIXC + p) * MIXC + q0;
#pragma unroll
        for (int j = 0; j < 4; ++j) { const f32x4 a = *(const f32x4*)(wp + 8 * j), b2 = *(const f32x4*)(wp + 8 * j + 4); u32x4 o; o.x = pk2(a[0], a[1]); o.y = pk2(a[2], a[3]); o.z = pk2(b2[0], b2[1]); o.w = pk2(b2[2], b2[3]); *(LAS u32x4*)(Wl + p * 136 + q0 + 8 * j) = o; }
    }
    {
        const int pos = tid >> 2, c0 = (tid & 3) * 32; const bf16* vp = W_U(F) + (size_t)(rowbase + pos) * NU + U_VC + gg * CG + c0;
        float xv[32];
#pragma unroll
        for (int j = 0; j < 4; ++j) { const u32x4 a = *(const u32x4*)(vp + 8 * j);
            xv[8 * j + 0] = gelu_tanh(bflo(a.x)); xv[8 * j + 1] = gelu_tanh(bfhi(a.x)); xv[8 * j + 2] = gelu_tanh(bflo(a.y)); xv[8 * j + 3] = gelu_tanh(bfhi(a.y));
            xv[8 * j + 4] = gelu_tanh(bflo(a.z)); xv[8 * j + 5] = gelu_tanh(bfhi(a.z)); xv[8 * j + 6] = gelu_tanh(bflo(a.w)); xv[8 * j + 7] = gelu_tanh(bfhi(a.w)); }
        float s = 0.f;
#pragma unroll
        for (int i = 0; i < 32; ++i) s += xv[i];
        s += __shfl_xor(s, 1); s += __shfl_xor(s, 2);
        const float mu = s * (1.0f / CG); float q = 0.f;
#pragma unroll
        for (int i = 0; i < 32; ++i) { const float d = xv[i] - mu; q += d * d; }
        q += __shfl_xor(q, 1); q += __shfl_xor(q, 2);
        const float rstd = 1.0f / sqrtf(q * (1.0f / CG) + EPS);
        const float* lg = F.ln_v_g + (size_t)l * (GC * CG) + gg * CG + c0; const float* lb = F.ln_v_b + (size_t)l * (GC * CG) + gg * CG + c0;
#pragma unroll
        for (int j = 0; j < 4; ++j) { float hh[8];
#pragma unroll
            for (int e = 0; e < 8; ++e) hh[e] = (xv[8 * j + e] - mu) * rstd * lg[8 * j + e] + lb[8 * j + e];
            u32x4 o; o.x = pk2(hh[0], hh[1]); o.y = pk2(hh[2], hh[3]); o.z = pk2(hh[4], hh[5]); o.w = pk2(hh[6], hh[7]);
            *(LAS u32x4*)(VTl + pos * 136 + c0 + 8 * j) = o; }
    }
    __syncthreads();
    {
        const int pos = 16 * w + c15, row = rowbase + pos;
        const float bsp = F.b_sp[((size_t)l * GC + gg) * MIXC + pos];
        bf16x8 wf[4];
#pragma unroll
        for (int ks = 0; ks < 4; ++ks) wf[ks] = *(const LAS bf16x8*)(Wl + pos * 136 + 32 * ks + 8 * g);
        u32x2 uu8[8];
#pragma unroll
        for (int cb = 0; cb < 8; ++cb) uu8[cb] = *(const u32x2*)(W_U(F) + (size_t)row * NU + U_UC + gg * CG + 16 * cb + 4 * g);
#pragma unroll
        for (int cb = 0; cb < 8; ++cb) { f32x4 acc = (f32x4){0.f, 0.f, 0.f, 0.f};
#pragma unroll
            for (int ks = 0; ks < 4; ++ks) { const LAS bf16* ap = VTl + (32 * ks + 8 * g + (c15 >> 2)) * 136 + 16 * cb + 4 * (c15 & 3); const bf16x8 a = mk8(ATT_TR(ap), ATT_TR(ap + 4 * 136)); acc = MFMA16(a, wf[ks], acc); }
            const int col = gg * CG + 16 * cb + 4 * g;
            const u32x2 uu = uu8[cb];
            u32x2 ov; ov.x = pk2(gelu_tanh(bflo(uu.x)) * (acc[0] + bsp), gelu_tanh(bfhi(uu.x)) * (acc[1] + bsp)); ov.y = pk2(gelu_tanh(bflo(uu.y)) * (acc[2] + bsp), gelu_tanh(bfhi(uu.y)) * (acc[3] + bsp));
            *(u32x2*)(W_MIX(F) + (size_t)row * D + MIX_C + col) = ov; }
    }
    __syncthreads();
}

#ifndef MK_REPMIX
#define MK_REPMIX 0u
#endif
__device__ __forceinline__ void p_mixers(Frame& F, int l) {
    for (int rep = 0; rep < 1 + (int)(MK_REPMIX & 1u); ++rep) { PpRegs R; int un = F.vcu; if (un < 2304) { pp_load_v(F, un, R); pp_load_w(F, l, un, R); pp_load_qk(F, un, R); } for (; un < 2304; un += F.G) { launder(F); gla_prepass(F, l, un, (un + F.G < 2304) ? un + F.G : un, R); } }
    const int na = (l == 0) ? 1152 : 1024, nc = (l == 0) ? 576 : 512;
    for (int rep = 0; rep < 1 + (int)((MK_REPMIX >> 1) & 1u); ++rep) { for (int u = F.vcu; u < na; u += F.G) attn_unit(F, l, u); }
    __syncthreads();
    for (int rep = 0; rep < 1 + (int)((MK_REPMIX >> 2) & 1u); ++rep) { for (int u = (F.vcu + F.G / 2) % F.G; u < nc; u += F.G) gmlp_unit(F, l, u); }
}
__device__ __forceinline__ void p_chains(Frame& F, int l) {
    for (int rep = 0; rep < 1 + (int)((MK_REPMIX >> 3) & 1u); ++rep) for (int ch = F.vcu; ch < 256; ch += F.G) { gla_chain(F, l, ch, rep + 1 < 1 + (int)((MK_REPMIX >> 3) & 1u)); __syncthreads(); }
}

__device__ __forceinline__ void p_glaout(Frame& F, int l) {
    const int gw = F.vcu * NWAVES + F.wave, NGW = F.G * NWAVES, lane = F.lane, nrows = (l == 0) ? NROW : NLAT;
    for (int row = gw; row < nrows; row += NGW) {
#pragma unroll
        for (int j = 0; j < 2; ++j) { const int idx = 512 * j + 8 * lane;
            const u32x4 a = __builtin_nontemporal_load((const u32x4*)(W_OB(F) + (size_t)row * 1024 + idx)), b2 = __builtin_nontemporal_load((const u32x4*)(W_OB(F) + ((size_t)NROW + row) * 1024 + idx));
            float o[8]; o[0] = bflo(a.x) + bflo(b2.x); o[1] = bfhi(a.x) + bfhi(b2.x); o[2] = bflo(a.y) + bflo(b2.y); o[3] = bfhi(a.y) + bfhi(b2.y); o[4] = bflo(a.z) + bflo(b2.z); o[5] = bfhi(a.z) + bfhi(b2.z); o[6] = bflo(a.w) + bflo(b2.w); o[7] = bfhi(a.w) + bfhi(b2.w);
            float ss = 0.f;
#pragma unroll
            for (int e = 0; e < 8; ++e) ss += o[e] * o[e];
#pragma unroll
            for (int s = 1; s < 32; s <<= 1) ss += __shfl_xor(ss, s);
            const float rn = 1.0f / sqrtf(ss * (1.0f / DVB) + EPS);
            const float* gp = F.g_gla + (size_t)l * 1024 + idx; const f32x4 g0 = *(const f32x4*)gp, g1 = *(const f32x4*)(gp + 4);
            const u32x4 gb = __builtin_nontemporal_load((const u32x4*)(W_U(F) + (size_t)row * NU + U_GB + idx));
            float r8[8];
            r8[0] = o[0] * rn * g0[0] * silu_f(bflo(gb.x)); r8[1] = o[1] * rn * g0[1] * silu_f(bfhi(gb.x)); r8[2] = o[2] * rn * g0[2] * silu_f(bflo(gb.y)); r8[3] = o[3] * rn * g0[3] * silu_f(bfhi(gb.y));
            r8[4] = o[4] * rn * g1[0] * silu_f(bflo(gb.z)); r8[5] = o[5] * rn * g1[1] * silu_f(bfhi(gb.z)); r8[6] = o[6] * rn * g1[2] * silu_f(bflo(gb.w)); r8[7] = o[7] * rn * g1[3] * silu_f(bfhi(gb.w));
            u32x4 ov; ov.x = pk2(r8[0], r8[1]); ov.y = pk2(r8[2], r8[3]); ov.z = pk2(r8[4], r8[5]); ov.w = pk2(r8[6], r8[7]);
            *(u32x4*)(W_MIX(F) + (size_t)row * D + MIX_B + idx) = ov; }
    }
}

struct PmRow { u32x4 y[4]; f32x4 x[8]; };
__device__ __forceinline__ void unpack8(const u32x4 a, float* o) { o[0] = bflo(a.x); o[1] = bfhi(a.x); o[2] = bflo(a.y); o[3] = bfhi(a.y); o[4] = bflo(a.z); o[5] = bfhi(a.z); o[6] = bflo(a.w); o[7] = bfhi(a.w); }
__device__ __forceinline__ void postmix_load_y(Frame& F, int row, PmRow& R) {
    const bf16* yp = W_Y(F) + (size_t)row * D + 8 * F.lane;
#pragma unroll
    for (int j = 0; j < 4; ++j) R.y[j] = __builtin_nontemporal_load((const u32x4*)(yp + 512 * j));
}
template <bool FIRST> __device__ __forceinline__ void postmix_load_x(Frame& F, int row, PmRow& R) {
    const int lane = F.lane;
    if constexpr (FIRST) { const float* xin = (row < NLAT ? F.x + (size_t)row * D : F.ctx + (size_t)(row - NLAT) * D) + 8 * lane;
#pragma unroll
        for (int j = 0; j < 4; ++j) { R.x[2 * j] = __builtin_nontemporal_load((const f32x4*)(xin + 512 * j)); R.x[2 * j + 1] = __builtin_nontemporal_load((const f32x4*)(xin + 512 * j + 4)); } }
    else { const bf16* xb = W_XB(F) + (size_t)row * D + 8 * lane;
#pragma unroll
        for (int j = 0; j < 4; ++j) R.x[j] = __builtin_bit_cast(f32x4, __builtin_nontemporal_load((const u32x4*)(xb + 512 * j))); }
}
template <bool FIRST> __device__ __forceinline__ void postmix_s1(Frame& F, int l, int row, const PmRow& R, const u32x4 (&c0p)[4], float (&xv)[32], bool dry) {
    const int lane = F.lane;
    float ss = 0.f;
#pragma unroll
    for (int j = 0; j < 4; ++j) { float y8[8]; unpack8(R.y[j], y8);
#pragma unroll
        for (int e = 0; e < 8; ++e) ss += y8[e] * y8[e]; }
    const float r1 = 1.0f / sqrtf(wave_sum(ss) * (1.0f / D) + EPS);
    bf16* xdst = dry ? (bf16*)(F.ws + WS_DUMMY) + (size_t)row * D : W_XB(F) + (size_t)row * D;
#pragma unroll
    for (int j = 0; j < 4; ++j) { float y8[8], c8[8], x8[8]; unpack8(R.y[j], y8); unpack8(c0p[j], c8);
        if constexpr (FIRST) { x8[0] = R.x[2 * j][0]; x8[1] = R.x[2 * j][1]; x8[2] = R.x[2 * j][2]; x8[3] = R.x[2 * j][3]; x8[4] = R.x[2 * j + 1][0]; x8[5] = R.x[2 * j + 1][1]; x8[6] = R.x[2 * j + 1][2]; x8[7] = R.x[2 * j + 1][3]; }
        else unpack8(__builtin_bit_cast(u32x4, R.x[j]), x8);
#pragma unroll
        for (int e = 0; e < 8; ++e) xv[8 * j + e] = x8[e] + c8[e] * (y8[e] * r1); }
    row_store_bf16(xdst, lane, xv);
}
__device__ __forceinline__ void postmix_s2(Frame& F, int row, const u32x4 (&c1p)[4], const u32x4 (&c2p)[4], float (&xv)[32]) {
    const int lane = F.lane;
    const float r2 = 1.0f / sqrtf(row_sumsq(xv) * (1.0f / D) + EPS);
#pragma unroll
    for (int j = 0; j < 4; ++j) { float c1[8], c2[8]; unpack8(c1p[j], c1); unpack8(c2p[j], c2);
#pragma unroll
        for (int e = 0; e < 8; ++e) xv[8 * j + e] = xv[8 * j + e] * r2 * c1[e] + c2[e]; }
    float am = 0.f;
#pragma unroll
    for (int i = 0; i < 32; ++i) am = fmaxf(am, fabsf(xv[i]));
    am = wave_max(am);
    const float scale = am > 0.f ? am * (1.0f / 127.0f) : 1.0f;
    row_store_i8(W_HQ(F) + (size_t)row * D, lane, xv, 1.0f / scale);
    if (lane == 0) W_HS(F)[row] = scale;
}
template <bool FIRST> __device__ __forceinline__ void p_postmix_t(Frame& F, int l, bool dry) {
    const int gw = F.vcu * NWAVES + F.wave, NGW = F.G * NWAVES, lane = F.lane, nrows = (l == 0) ? NROW : NLAT;
    LAS float* WR = (LAS float*)F.lds;
    for (int i = F.tid; i < D * 4; i += NTHR) { const int k = i >> 2, e4 = (i & 3) * 4; const f32x4 wv = *(const f32x4*)(F.w_router + ((size_t)l * D + k) * NE + e4);
        WR[(e4 + 0) * D + k] = wv[0]; WR[(e4 + 1) * D + k] = wv[1]; WR[(e4 + 2) * D + k] = wv[2]; WR[(e4 + 3) * D + k] = wv[3]; }
    __syncthreads();
    const int npair = nrows / 2, pbase = npair / NGW, prem = npair % NGW;
    const int p0 = gw * pbase + (gw < prem ? gw : prem), p1 = p0 + pbase + (gw < prem ? 1 : 0);
    PmRow RA, RB;
    if (p0 < p1) { postmix_load_y(F, 2 * p0, RA); postmix_load_x<FIRST>(F, 2 * p0, RA); postmix_load_y(F, 2 * p0 + 1, RB); if constexpr (!FIRST) postmix_load_x<FIRST>(F, 2 * p0 + 1, RB); }
    for (int p = p0; p < p1; ++p) {
        launder(F);
        const int row = 2 * p, row2 = row + 1; const bool has2 = true; const int lane = F.lane;
        float h0[32], h1[32];
        {
            const int m0 = row < NLAT ? row / SEQ : 8;
            u32x4 c0p[4], c1p[4], c2p[4]; const bf16* cva = W_CV(F) + ((size_t)l * 9 + m0) * 6 * D + 8 * lane;
#pragma unroll
            for (int j = 0; j < 4; ++j) c0p[j] = *(const u32x4*)(cva + 512 * j);
            if constexpr (FIRST) postmix_load_x<FIRST>(F, row2, RB);
            postmix_s1<FIRST>(F, l, row, RA, c0p, h0, dry);
            asm volatile("" ::: "memory");
#pragma unroll
            for (int j = 0; j < 4; ++j) { c1p[j] = *(const u32x4*)(cva + D + 512 * j); c2p[j] = *(const u32x4*)(cva + 2 * D + 512 * j); }
            postmix_s1<FIRST>(F, l, row2, RB, c0p, h1, dry);
            postmix_s2(F, row, c1p, c2p, h0);
            postmix_s2(F, row2, c1p, c2p, h1);
        }
        asm volatile("" ::: "memory");
        if (p + 1 < p1) { postmix_load_y(F, row + 2, RA); postmix_load_x<FIRST>(F, row + 2, RA); postmix_load_y(F, row + 3, RB); if constexpr (!FIRST) postmix_load_x<FIRST>(F, row + 3, RB); }
        asm volatile("" ::: "memory");
        float a0[16], a1[16];
#pragma unroll
        for (int e = 0; e < 16; ++e) { a0[e] = 0.f; a1[e] = 0.f; }
#pragma unroll
        for (int j = 0; j < 4; ++j) {
#pragma unroll
            for (int e = 0; e < 16; ++e) { const LAS float* wp = WR + e * D + 512 * j + 8 * lane; const f32x4 wa = *(const LAS f32x4*)wp, wb = *(const LAS f32x4*)(wp + 4);
                a0[e] += h0[8 * j] * wa[0] + h0[8 * j + 1] * wa[1] + h0[8 * j + 2] * wa[2] + h0[8 * j + 3] * wa[3] + h0[8 * j + 4] * wb[0] + h0[8 * j + 5] * wb[1] + h0[8 * j + 6] * wb[2] + h0[8 * j + 7] * wb[3];
                a1[e] += h1[8 * j] * wa[0] + h1[8 * j + 1] * wa[1] + h1[8 * j + 2] * wa[2] + h1[8 * j + 3] * wa[3] + h1[8 * j + 4] * wb[0] + h1[8 * j + 5] * wb[1] + h1[8 * j + 6] * wb[2] + h1[8 * j + 7] * wb[3];
                if ((e & 1) == 1) asm volatile("" ::: "memory"); }
        }
        float mx0 = -1e30f, mx1 = -1e30f;
#pragma unroll
        for (int e = 0; e < 16; ++e) { a0[e] = wave_sum(a0[e]); a1[e] = wave_sum(a1[e]); mx0 = fmaxf(mx0, a0[e]); mx1 = fmaxf(mx1, a1[e]); }
        float s0 = 0.f, s1 = 0.f;
#pragma unroll
        for (int e = 0; e < 16; ++e) { a0[e] = __expf(a0[e] - mx0); a1[e] = __expf(a1[e] - mx1); s0 += a0[e]; s1 += a1[e]; }
        float val = 0.f;
#pragma unroll
        for (int e = 0; e < 16; ++e) { if ((lane & 15) == e) val = (lane < 16) ? a0[e] / s0 : a1[e] / s1; }
        if (lane < 16) W_AFF(F)[(size_t)row * NE + lane] = val;
        else if (lane < 32 && has2) W_AFF(F)[(size_t)row2 * NE + (lane & 15)] = val;
    }
}

__device__ __forceinline__ void p_postmix(Frame& F, int l, bool dry) { if (l == 0) p_postmix_t<true>(F, l, dry); else p_postmix_t<false>(F, l, dry); }

__device__ __forceinline__ int block_excl_scan(int v, LAS int* tmp, int lane, int wave, int& total) {
    int inc = v;
#pragma unroll
    for (int o = 1; o < 64; o <<= 1) { const int t = __shfl_up(inc, o); if (lane >= o) inc += t; }
    if (lane == 63) tmp[wave] = inc;
    __syncthreads();
    int base = 0, tot = 0;
#pragma unroll
    for (int ww = 0; ww < 8; ++ww) { const int t = tmp[ww]; tot += t; if (ww < wave) base += t; }
    __syncthreads();
    total = tot; return base + inc - v;
}
__device__ __forceinline__ void p_topk(Frame& F, int l) {
    const int tid = F.tid, lane = F.lane, wave = F.wave;
    LAS int* hist = (LAS int*)F.lds;
    LAS int* misc = (LAS int*)(F.lds + 1024);
    LAS int* stmp = (LAS int*)(F.lds + 1152);
    LAS int* list = (LAS int*)(F.lds + 2048);
    const int nsets = (l == 0) ? 256 : 128, ME = (l == 0) ? ME0 : ME1;
    for (int s = F.vcu; s < nsets; s += F.G) {
        const bool isctx = s >= 128; const int ss = isctx ? s - 128 : s, b = ss >> 4, e = ss & 15;
        const int n = isctx ? CTXL : SEQ, cap = isctx ? CAPC : CAPL, base = isctx ? NLAT + b * CTXL : b * SEQ, slot0 = isctx ? NB * CAPL + b * CAPC : b * CAPL;
        unsigned bits[4];
#pragma unroll
        for (int c = 0; c < 4; ++c) { const int i = 4 * tid + c; bits[c] = (i < n) ? __builtin_bit_cast(unsigned, W_AFF(F)[(size_t)(base + i) * NE + e]) : 0u; }
        unsigned prefix = 0u; int krem = cap;
        for (int pass = 0; pass < 4; ++pass) {
            const int shift = 24 - 8 * pass;
            if (tid < 256) hist[tid] = 0;
            __syncthreads();
#pragma unroll
            for (int c = 0; c < 4; ++c) { const int i = 4 * tid + c; if (i < n && (pass == 0 || (bits[c] >> (shift + 8)) == prefix)) __hip_atomic_fetch_add(&hist[(bits[c] >> shift) & 255u], 1, __ATOMIC_RELAXED, __HIP_MEMORY_SCOPE_WORKGROUP); }
            __syncthreads();
            if (wave == 0) {
                const int h0 = hist[4 * lane], h1 = hist[4 * lane + 1], h2 = hist[4 * lane + 2], h3 = hist[4 * lane + 3];
                const int tot = h0 + h1 + h2 + h3; int suf = tot;
#pragma unroll
                for (int o = 1; o < 64; o <<= 1) { const int t = __shfl_down(suf, o); if (lane + o < 64) suf += t; }
                const int above = suf - tot;
                if (above < krem && krem <= suf) {
                    int a = above, bin, cnt_above;
                    if (a + h3 >= krem) { bin = 3; cnt_above = a; } else { a += h3;
                        if (a + h2 >= krem) { bin = 2; cnt_above = a; } else { a += h2;
                            if (a + h1 >= krem) { bin = 1; cnt_above = a; } else { a += h1; bin = 0; cnt_above = a; } } }
                    misc[0] = 4 * lane + bin; misc[1] = cnt_above;
                }
            }
            __syncthreads();
            prefix = (prefix << 8) | (unsigned)misc[0]; krem -= misc[1];
            __syncthreads();
        }
        int neq = 0;
#pragma unroll
        for (int c = 0; c < 4; ++c) { const int i = 4 * tid + c; if (i < n && bits[c] == prefix) ++neq; }
        int tot_eq; int eqr = block_excl_scan(neq, stmp, lane, wave, tot_eq);
        bool sel[4]; int nsel = 0;
#pragma unroll
        for (int c = 0; c < 4; ++c) { const int i = 4 * tid + c; bool s2 = false; if (i < n) { if (bits[c] > prefix) s2 = true; else if (bits[c] == prefix) { s2 = eqr < krem; ++eqr; } } sel[c] = s2; nsel += s2 ? 1 : 0; }
        int tot_sel; int slot = block_excl_scan(nsel, stmp, lane, wave, tot_sel);
#pragma unroll
        for (int c = 0; c < 4; ++c) { const int i = 4 * tid + c; if (i < n) { int v = -1; if (sel[c]) { if (slot < cap) { list[slot] = i; v = slot0 + slot; } ++slot; } W_TSLOT(F)[(size_t)(base + i) * NE + e] = v; } }
        __syncthreads();
        for (int sl0 = wave; sl0 < cap; sl0 += 4 * NWAVES) {
            u32x4 cr[4][2]; float cs4[4]; int tk[4];
#pragma unroll
            for (int j = 0; j < 4; ++j) { tk[j] = list[sl0 + j * NWAVES]; const signed char* src = W_HQ(F) + (size_t)(base + tk[j]) * D; cr[j][0] = *(const u32x4*)(src + 16 * lane); cr[j][1] = *(const u32x4*)(src + 1024 + 16 * lane); cs4[j] = W_HS(F)[base + tk[j]]; }
#pragma unroll
            for (int j = 0; j < 4; ++j) { const int sl = sl0 + j * NWAVES; signed char* dst = W_XSQ(F) + ((size_t)e * ME + slot0 + sl) * D; *(u32x4*)(dst + 16 * lane) = cr[j][0]; *(u32x4*)(dst + 1024 + 16 * lane) = cr[j][1];
                if (lane == 0) W_XSS(F)[(size_t)e * ME + slot0 + sl] = cs4[j]; }
        }
        __syncthreads();
    }
}

__device__ __forceinline__ void p_actq(Frame& F, int l) {
    const int gw = F.vcu * NWAVES + F.wave, NGW = F.G * NWAVES, lane = F.lane, nrows = NE * ((l == 0) ? ME0 : ME1);
    for (int row = gw; row < nrows; row += 2 * NGW) {
        const int row2 = (row + NGW < nrows) ? row + NGW : row;
        float v[32], v2[32]; row_load_bf16_nt(W_ACT(F) + (size_t)row * FF, lane, v); row_load_bf16_nt(W_ACT(F) + (size_t)row2 * FF, lane, v2);
        const float t1 = W_TM(F)[(size_t)row * 64 + lane], t2 = W_TM(F)[(size_t)row2 * 64 + lane];
        const float am = wave_max(t1), am2 = wave_max(t2);
        const float scale = am > 0.f ? am * (1.0f / 127.0f) : 1.0f, scale2 = am2 > 0.f ? am2 * (1.0f / 127.0f) : 1.0f;
        row_store_i8(W_ACTQ(F) + (size_t)row * FF, lane, v, 1.0f / scale); row_store_i8(W_ACTQ(F) + (size_t)row2 * FF, lane, v2, 1.0f / scale2);
        if (lane == 0) { W_ACTS(F)[row] = scale; W_ACTS(F)[row2] = scale2; }
    }
}

__device__ __forceinline__ void p_combine(Frame& F, int l, bool dry) {
    const int gw = F.vcu * NWAVES + F.wave, NGW = F.G * NWAVES, lane = F.lane, nrows = (l == 0) ? NROW : NLAT, ME = (l == 0) ? ME0 : ME1;
    for (int row = gw; row < nrows; row += NGW) {
        const int m = row < NLAT ? row / SEQ : 8;
        float acc[32];
#pragma unroll
        for (int i = 0; i < 32; ++i) acc[i] = 0.f;
        {
            const int sl16 = (lane < NE) ? W_TSLOT(F)[(size_t)row * NE + lane] : -1; const float gt16 = (lane < NE) ? W_AFF(F)[(size_t)row * NE + lane] : 0.f;
            unsigned long long msk = __ballot(sl16 >= 0);
            while (msk) {
                int ee[4]; int ns = 0;
#pragma unroll
                for (int j = 0; j < 4; ++j) { ee[j] = msk ? (int)__builtin_ctzll(msk) : 0; if (msk) { ++ns; msk &= msk - 1; } }
                u32x4 yr[4][4]; float gg[4];
#pragma unroll
                for (int j = 0; j < 4; ++j) if (j < ns) {
                    const int slot = __builtin_amdgcn_readlane(sl16, ee[j]); gg[j] = __builtin_bit_cast(float, __builtin_amdgcn_readlane(__builtin_bit_cast(int, gt16), ee[j]));
                    const bf16* yp = W_XS(F) + ((size_t)ee[j] * ME + slot) * D + 8 * lane;
#pragma unroll
                    for (int q = 0; q < 4; ++q) yr[j][q] = __builtin_nontemporal_load((const u32x4*)(yp + 512 * q)); }
#pragma unroll
                for (int j = 0; j < 4; ++j) if (j < ns) {
#pragma unroll
                    for (int q = 0; q < 4; ++q) { const u32x4 a = yr[j][q];
                        acc[8 * q + 0] += gg[j] * bflo(a.x); acc[8 * q + 1] += gg[j] * bfhi(a.x); acc[8 * q + 2] += gg[j] * bflo(a.y); acc[8 * q + 3] += gg[j] * bfhi(a.y);
                        acc[8 * q + 4] += gg[j] * bflo(a.z); acc[8 * q + 5] += gg[j] * bfhi(a.z); acc[8 * q + 6] += gg[j] * bflo(a.w); acc[8 * q + 7] += gg[j] * bfhi(a.w); } }
            }
        }
        const float r1 = 1.0f / sqrtf(row_sumsq(acc) * (1.0f / D) + EPS);
        float xv[32], c3[32];
        row_load_bf16_nt(W_XB(F) + (size_t)row * D, lane, xv); row_load_bf16(W_CV(F) + (((size_t)l * 9 + m) * 6 + 3) * D, lane, c3);
#pragma unroll
        for (int i = 0; i < 32; ++i) xv[i] = xv[i] + c3[i] * (acc[i] * r1);
        if (l + 1 < DEPTH) row_store_bf16(dry ? (bf16*)(F.ws + WS_DUMMY) + (size_t)row * D : W_XB(F) + (size_t)row * D, lane, xv);
        else row_store_f32(dry ? (float*)(F.ws + WS_DUMMY) + (size_t)(row & 8191) * D : F.out + (size_t)row * D, lane, xv);
        if (l + 1 < DEPTH) prenorm_row_cv(F, l + 1, m, xv, row);
    }
}
struct Args { const float* in[24]; float* out; unsigned char* ws; int ph_lo, ph_hi; };
constexpr int NPHASE = 2 + 11 * DEPTH;
__global__ void __launch_bounds__(NTHR, 2) mk_fwd(Args args) {
    extern __shared__ __attribute__((aligned(16))) unsigned char lds_raw[];
    Frame F;
    F.lds = (LAS unsigned char*)lds_raw;
    F.tid = threadIdx.x; F.lane = F.tid & 63; F.wave = __builtin_amdgcn_readfirstlane(F.tid >> 6);
    F.G = gridDim.x; { const int bx = blockIdx.x; F.vcu = (F.G % 8 == 0) ? (bx % 8) * (F.G / 8) + bx / 8 : bx; }
    F.x = args.in[0]; F.c = args.in[1]; F.ctx = args.in[2]; F.c_ctx = args.in[3]; F.w_ada = args.in[4]; F.b_ada = args.in[5]; F.g_pre_mix = args.in[6]; F.g_post_mix = args.in[7];
    F.g_pre_ffn = args.in[8]; F.g_post_ffn = args.in[9]; F.w_in = args.in[10]; F.w_dec = args.in[11]; F.b_dec = args.in[12]; F.rpb = args.in[13]; F.g_gla = args.in[14]; F.ln_v_g = args.in[15];
    F.ln_v_b = args.in[16]; F.w_sp = args.in[17]; F.b_sp = args.in[18]; F.w_out = args.in[19]; F.w_router = args.in[20]; F.w_gate = args.in[21]; F.w_up = args.in[22]; F.w_down = args.in[23];
    F.out = args.out;
    unsigned char* ws = args.ws;
    F.ws = ws;

    const int lo = args.ph_lo, hi = args.ph_hi;
    unsigned* ctl = (unsigned*)(ws + WS_CTL);
    if (F.tid < 16) ((LAS unsigned*)(F.lds + LDS_XB))[F.tid] = 0u;
    __syncthreads();
    XcdBarrier bar; bar.bar = (unsigned*)(ws + WS_CTL) + CW_BAR; bar.x = 0; bar.st = nullptr;
    if (hi - lo > 1) bar = xcd_barrier_post((unsigned*)(ws + WS_CTL) + CW_BAR, (volatile LAS unsigned*)(F.lds + LDS_XB));
#ifndef MK_MASK
#define MK_MASK 0xFFFFFFFFu
#endif
#define PH(b) ((MK_MASK >> (b)) & 1u)
#ifndef MK_REP
#define MK_REP 0u
#endif
#define NREP(b) (1 + (int)((MK_REP >> (b)) & 1u))
#define REPBAR(b, rep) do { if ((rep) + 1 < NREP(b)) xcd_barrier(bar); } while (0)
#define IN(k) (lo <= (k) && (k) < hi)
#define SEAM(k) do { if (IN(k) && IN((k) + 1)) xcd_barrier(bar); } while (0)

    if (PH(0) && IN(0)) { for (int rep = 0; rep < NREP(0); ++rep) { launder(F); p0a(F); REPBAR(0, rep); } } SEAM(0);
    if (PH(1) && IN(1)) { for (int rep = 0; rep < NREP(1); ++rep) { launder(F); p0b(F); REPBAR(1, rep); } } SEAM(1);
    for (int l = 0; l < DEPTH; ++l) {
        const int pb = 2 + 11 * l;
        if (PH(2) && IN(pb + 0)) {
          for (int rep = 0; rep < NREP(2); ++rep) {
            launder(F);
            pg8::Gemm g{(const pg8::bf16_t*)W_HQ(F), (const pg8::bf16_t*)(F.ws + WS_WIN + (size_t)l * NU * D), NROW, NU, D / 2};
            constexpr int GG = 237;
            unsigned* sig = ctl + CW_SIG + 64 * (pb + 0);
            if ((int)blockIdx.x < GG || F.G != 256) {
                pg8::GroupedOrder S; S.init(1, NROW / 256, NU / 256, F.G == 256 ? GG : F.G, (int)blockIdx.x, sig);
                pg8::EpiStoreI8 E{W_U(F), NU, NU / 256, W_HS(F), W_SIN(F) + (size_t)l * NU};
                pg8::gemm_phase<pg8::EpiStoreI8, pg8::GroupedOrder, true, true>(F.lds, g, S, E, F.tid);
            } else bg_loop(F, ctl, sig, BG_TOTAL);
            REPBAR(2, rep); }
        } SEAM(pb + 0);
        if (PH(3) && IN(pb + 1)) { for (int rep = 0; rep < NREP(3); ++rep) { launder(F); p_mixers(F, l); REPBAR(3, rep); } } SEAM(pb + 1);
        if (PH(11) && IN(pb + 2)) { for (int rep = 0; rep < NREP(11); ++rep) { launder(F); p_chains(F, l); REPBAR(11, rep); } } SEAM(pb + 2);
        if (PH(4) && IN(pb + 3)) { for (int rep = 0; rep < NREP(4); ++rep) { launder(F); p_glaout(F, l); REPBAR(4, rep); } } SEAM(pb + 3);
        if (PH(5) && IN(pb + 4)) {
          for (int rep = 0; rep < NREP(5); ++rep) {
            launder(F);
            const int M = (l == 0) ? NROW : NLAT;
            pg8::Gemm g{W_MIX(F), W_WOUT(F) + (size_t)l * D * D, M, D, D};
            const int GG = (l == 0) ? 192 : 256;
            unsigned* sig = ctl + CW_SIG + 64 * (pb + 4);
            if ((int)blockIdx.x < GG || F.G != 256) {
                pg8::GroupedOrder S; S.init(1, M / 256, D / 256, F.G == 256 ? GG : F.G, (int)blockIdx.x, sig);
                pg8::EpiStore E{W_Y(F), D, D / 256};
                pg8::gemm_phase<pg8::EpiStore, pg8::GroupedOrder, true, true>(F.lds, g, S, E, F.tid);
            } else bg_loop(F, ctl, sig, BG_TOTAL);
            REPBAR(5, rep); }
        } SEAM(pb + 4);
        if (PH(6) && IN(pb + 5)) { if (MK_REPMIX & 16u) { launder(F); p_postmix(F, l, true); xcd_barrier(bar); } launder(F); p_postmix(F, l, false); } SEAM(pb + 5);
        if (PH(7) && IN(pb + 6)) { for (int rep = 0; rep < NREP(7); ++rep) { launder(F); p_topk(F, l); launder(F); bg_loop(F, ctl, nullptr, l == 0 ? BG_A : BG_TOTAL); REPBAR(7, rep); } } SEAM(pb + 6);
        if (PH(8) && IN(pb + 7)) {
          for (int rep = 0; rep < NREP(8); ++rep) {
            launder(F);
            const int ME = (l == 0) ? ME0 : ME1;
            pg8::Gemm g{(const pg8::bf16_t*)W_XSQ(F), (const pg8::bf16_t*)((F).ws + WS_W1 + (size_t)l * NE * (2 * FF) * D), NE * ME, NE * 2 * FF, D / 2};
            pg8::GroupedOrder S; S.init(NE, ME / 256, 2 * FF / 256, F.G, (int)blockIdx.x);
            pg8::EpiSwiGLUI8 E{W_ACT(F), FF, 2 * FF / 256, W_XSS(F), W_S1(F) + (size_t)l * NE * (2 * FF), W_TM(F)};
            pg8::gemm_phase<pg8::EpiSwiGLUI8, pg8::GroupedOrder, true, true>(F.lds, g, S, E, F.tid); REPBAR(8, rep); }
        } SEAM(pb + 7);
        if (PH(12) && IN(pb + 8)) { launder(F); p_actq(F, l); } SEAM(pb + 8);
        if (PH(9) && IN(pb + 9)) {
          for (int rep = 0; rep < NREP(9); ++rep) {
            launder(F);
            const int ME = (l == 0) ? ME0 : ME1;
            pg8::Gemm g{(const pg8::bf16_t*)W_ACTQ(F), (const pg8::bf16_t*)((F).ws + WS_W2 + (size_t)l * NE * D * FF), NE * ME, NE * D, FF / 2};
            const int GG = (l == 0) ? 231 : 256;
            unsigned* sig = ctl + CW_SIG + 64 * (pb + 9);
            if ((int)blockIdx.x < GG || F.G != 256) {
                pg8::GroupedOrder S; S.init(NE, ME / 256, D / 256, F.G == 256 ? GG : F.G, (int)blockIdx.x, sig);
                pg8::EpiStoreI8 E{W_XS(F), D, D / 256, W_ACTS(F), W_S2(F) + (size_t)l * NE * D};
                pg8::gemm_phase<pg8::EpiStoreI8, pg8::GroupedOrder, true, true>(F.lds, g, S, E, F.tid);
            } else bg_loop(F, ctl, sig, BG_TOTAL);
            REPBAR(9, rep); }
        } SEAM(pb + 9);
        if (PH(10) && IN(pb + 10)) { if (MK_REPMIX & 32u) { launder(F); p_combine(F, l, true); xcd_barrier(bar); } launder(F); p_combine(F, l, false); if (l == 0) { launder(F); bg_loop(F, ctl, nullptr, BG_B); } } SEAM(pb + 10);
    }
#undef IN
#undef SEAM
}

extern "C" void kernel_launch(void* const* d_in, const int* in_sizes, int n_in, void* d_out, int out_size, void* d_ws, size_t ws_size, hipStream_t stream) {
    static int grid = 0;
    if (grid == 0) {
        if (n_in != 24 || out_size != NLAT * D || ws_size < WS_END2) { fprintf(stderr, "kernel_launch: unexpected shapes (n_in %d out %d ws %zu)\n", n_in, out_size, ws_size); grid = -1; return; }
        int dev = 0, cus = 0, per_cu = 0;
        if (hipGetDevice(&dev) != hipSuccess || hipDeviceGetAttribute(&cus, hipDeviceAttributeMultiprocessorCount, dev) != hipSuccess) { grid = -1; return; }
        if (hipFuncSetAttribute((const void*)mk_fwd, hipFuncAttributeMaxDynamicSharedMemorySize, LDS_BYTES) != hipSuccess) { fprintf(stderr, "kernel_launch: hipFuncSetAttribute failed\n"); grid = -1; return; }
        if (hipOccupancyMaxActiveBlocksPerMultiprocessor(&per_cu, (const void*)mk_fwd, NTHR, LDS_BYTES) != hipSuccess || per_cu < 1) { fprintf(stderr, "kernel_launch: occupancy query says %d\n", per_cu); }
        (void)hipGetLastError();
        grid = cus;
    }
    if (grid < 0) return;
    if (hipMemsetAsync((char*)d_ws + WS_CTL, 0, CTL_ZERO_BYTES, stream) != hipSuccess) return;
    Args a{};
    for (int i = 0; i < 24; ++i) a.in[i] = (const float*)d_in[i];
    a.out = (float*)d_out; a.ws = (unsigned char*)d_ws;
#if MK_N_LAUNCHES == 1
    a.ph_lo = 0; a.ph_hi = NPHASE;
    hipLaunchKernelGGL(mk_fwd, dim3(grid), dim3(NTHR), LDS_BYTES, stream, a);
#else
    for (int p = 0; p < NPHASE; ++p) { a.ph_lo = p; a.ph_hi = p + 1; hipLaunchKernelGGL(mk_fwd, dim3(grid), dim3(NTHR), LDS_BYTES, stream, a); }
#endif
}
```

```cpp
#include <hip/hip_runtime.h>
#include <cstdio>
#include <cstdint>

#ifndef MK_N_LAUNCHES
#define MK_N_LAUNCHES 1
#endif

namespace pg8 {
#define PG8_LAS __attribute__((address_space(3)))
typedef unsigned short bf16_t;
typedef short bf16x8 __attribute__((ext_vector_type(8)));
typedef float f32x4 __attribute__((ext_vector_type(4)));
typedef unsigned u32x4 __attribute__((ext_vector_type(4)));
constexpr int BM = 256, BK = 64, HALF = 128, HTB = HALF * BK * 2  , STAGE_BYTES = 8 * HTB, NXCD = 8, WGM = 8;

__host__ __device__ __forceinline__ int lds_byte(int r, int c) { const int st = (r >> 4) * 2 + (c >> 5), rr = r & 15, cc = c & 31, ob = rr * 64 + cc * 2; return st * 1024 + (ob ^ (((ob >> 9) & 1) << 5)); }
__host__ __device__ __forceinline__ void stage_rc(int b, int& R, int& C) { const int st = b / 1024, sb = b % 1024, swz = sb ^ (((sb >> 9) & 1) << 5); R = (st >> 1) * 16 + swz / 64; C = (st & 1) * 32 + (swz % 64) / 2; }
__host__ __device__ __forceinline__ int perm32(int rho) { const int n = rho >> 4, i = rho & 15; return 8 * (i >> 2) + 4 * n + (i & 3); }

struct Unit { int pm, pn, last; };
struct Gemm { const bf16_t* A; const bf16_t* Bt; int M, N, K; };

typedef __bf16 hwbf16x2_t __attribute__((ext_vector_type(2))); typedef float f32x2_cv __attribute__((ext_vector_type(2)));
__device__ __forceinline__ unsigned cvt_pk_bf16(float lo, float hi) { const f32x2_cv v = {lo, hi}; const hwbf16x2_t b = __builtin_convertvector(v, hwbf16x2_t); return __builtin_bit_cast(unsigned, b); }
typedef float f32x2 __attribute__((ext_vector_type(2)));
typedef int i32x4 __attribute__((ext_vector_type(4)));
__device__ __forceinline__ f32x4 mma16(bf16x8 a, bf16x8 b, f32x4 c) { return __builtin_amdgcn_mfma_f32_16x16x32_bf16(a, b, c, 0, 0, 0); }
__device__ __forceinline__ i32x4 mma16(bf16x8 a, bf16x8 b, i32x4 c) { return __builtin_amdgcn_mfma_i32_16x16x64_i8(__builtin_bit_cast(i32x4, a), __builtin_bit_cast(i32x4, b), c, 0, 0, 0); }
__device__ __forceinline__ void tile_of(int wgid, int nM, int nN, int& pm, int& pn) {
    const int nwg = nM * nN;
    { const int q = nwg / NXCD, r = nwg % NXCD, xcd = wgid % NXCD, off = wgid / NXCD; wgid = (xcd < r ? xcd * (q + 1) : r * (q + 1) + (xcd - r) * q) + off; }
    const int nig = WGM * nN, gid = wgid / nig, fm = gid * WGM, gsz = (nM - fm) < WGM ? (nM - fm) : WGM;
    pm = fm + ((wgid % nig) % gsz); pn = (wgid % nig) / gsz;
}
struct GroupedOrder {
    int mM, mN, per, total, G, c; unsigned* sig;
    __device__ __forceinline__ void init(int E, int mM_, int mN_, int G_, int c_, unsigned* sig_ = nullptr) { mM = mM_; mN = mN_; per = mM * mN; total = E * per; G = G_; c = c_; sig = sig_; }
    __device__ __forceinline__ bool next(int i, Unit& u) const {
        const long L = (long)i * G + c; if (L >= total) return false;
        const int e = (int)(L / per), l = (int)(L % per); int pm, pn; tile_of(l, mM, mN, pm, pn);
        u.pm = e * mM + pm; u.pn = e * mN + pn; u.last = (i == (total + G - 1) / G - 1) ? 1 : 0; return true;
    }
    __device__ __forceinline__ void a_ready(const Unit& u) const { if (sig && u.last && threadIdx.x == 0) __hip_atomic_store(sig, 1u, __ATOMIC_RELAXED, __HIP_MEMORY_SCOPE_AGENT); }
    __device__ __forceinline__ void done(const Unit&) const {}
};
__device__ __forceinline__ float xmax16(float v) { const auto r = __builtin_amdgcn_permlane16_swap(__builtin_bit_cast(unsigned, v), __builtin_bit_cast(unsigned, v), false, false); return fmaxf(__builtin_bit_cast(float, r[0]), __builtin_bit_cast(float, r[1])); }
__device__ __forceinline__ float xmax32(float v) { const auto r = __builtin_amdgcn_permlane32_swap(__builtin_bit_cast(unsigned, v), __builtin_bit_cast(unsigned, v), false, false); return fmaxf(__builtin_bit_cast(float, r[0]), __builtin_bit_cast(float, r[1])); }
__device__ __forceinline__ float xsum16(float v) { const auto r = __builtin_amdgcn_permlane16_swap(__builtin_bit_cast(unsigned, v), __builtin_bit_cast(unsigned, v), false, false); return __builtin_bit_cast(float, r[0]) + __builtin_bit_cast(float, r[1]); }
__device__ __forceinline__ float xsum32(float v) { const auto r = __builtin_amdgcn_permlane32_swap(__builtin_bit_cast(unsigned, v), __builtin_bit_cast(unsigned, v), false, false); return __builtin_bit_cast(float, r[0]) + __builtin_bit_cast(float, r[1]); }
__device__ __forceinline__ float silu_f(float x) { return x * __builtin_amdgcn_rcpf(1.0f + __expf(-x)); }
struct EpiStore {
    static constexpr bool PERM = true, AFTER_DRAIN = false; typedef f32x4 acc_t;
    bf16_t* O; int ldc; int nN;
    __device__ __forceinline__ void operator()(const f32x4 (&acc)[2][2][4][2], const Unit& u, int wr, int wc, int fr, int fq) const {
        const int row0 = u.pm * BM + wr * 64 + fr, col0 = (u.pn % nN) * BM + wc * 32 + 8 * fq;
#pragma unroll
        for (int ai = 0; ai < 2; ++ai)
#pragma unroll
            for (int m = 0; m < 4; ++m) { bf16_t* rowp = O + (size_t)(row0 + ai * HALF + m * 16) * ldc + col0;
#pragma unroll
                for (int bj = 0; bj < 2; ++bj) { const f32x4 v0 = acc[ai][bj][m][0], v1 = acc[ai][bj][m][1];
                    u32x4 w; w.x = cvt_pk_bf16(v0[0], v0[1]); w.y = cvt_pk_bf16(v0[2], v0[3]); w.z = cvt_pk_bf16(v1[0], v1[1]); w.w = cvt_pk_bf16(v1[2], v1[3]);
                    *(u32x4*)(rowp + bj * HALF) = w; } }
    }
};
struct EpiSwiGLU {
    static constexpr bool PERM = true, AFTER_DRAIN = false; typedef f32x4 acc_t;
    bf16_t* O; int ldc; int nN;
    __device__ __forceinline__ void operator()(const f32x4 (&acc)[2][2][4][2], const Unit& u, int wr, int wc, int fr, int fq) const {
        const int row0 = u.pm * BM + wr * 64 + fr, col0 = (u.pn % nN) * HALF + wc * 32 + 8 * fq;
#pragma unroll
        for (int ai = 0; ai < 2; ++ai)
#pragma unroll
            for (int m = 0; m < 4; ++m) { bf16_t* rowp = O + (size_t)(row0 + ai * HALF + m * 16) * ldc + col0;
                f32x4 a0 = acc[ai][0][m][0], a1 = acc[ai][0][m][1]; const f32x4 b0 = acc[ai][1][m][0], b1 = acc[ai][1][m][1];
#pragma unroll
                for (int j = 0; j < 4; ++j) { a0[j] = silu_f(a0[j]) * b0[j]; a1[j] = silu_f(a1[j]) * b1[j]; }
                u32x4 w; w.x = cvt_pk_bf16(a0[0], a0[1]); w.y = cvt_pk_bf16(a0[2], a0[3]); w.z = cvt_pk_bf16(a1[0], a1[1]); w.w = cvt_pk_bf16(a1[2], a1[3]);
                *(u32x4*)rowp = w; }
    }
};
struct EpiStoreI8 {
    static constexpr bool PERM = true, AFTER_DRAIN = false; typedef i32x4 acc_t;
    bf16_t* O; int ldc; int nN; const float* sa; const float* sb;
    __device__ __forceinline__ void operator()(const i32x4 (&acc)[2][2][4][2], const Unit& u, int wr, int wc, int fr, int fq) const {
        const int row0 = u.pm * BM + wr * 64 + fr, col0 = (u.pn % nN) * BM + wc * 32 + 8 * fq; const float* sbp = sb + (size_t)u.pn * BM + wc * 32 + 8 * fq;
        f32x4 bs[2][2];
#pragma unroll
        for (int bj = 0; bj < 2; ++bj) { bs[bj][0] = *(const f32x4*)(sbp + bj * HALF); bs[bj][1] = *(const f32x4*)(sbp + bj * HALF + 4); }
#pragma unroll
        for (int ai = 0; ai < 2; ++ai)
#pragma unroll
            for (int m = 0; m < 4; ++m) { const int row = row0 + ai * HALF + m * 16; const float as = sa[row]; bf16_t* rowp = O + (size_t)row * ldc + col0;
#pragma unroll
                for (int bj = 0; bj < 2; ++bj) { const i32x4 i0 = acc[ai][bj][m][0], i1 = acc[ai][bj][m][1]; f32x4 v0, v1;
#pragma unroll
                    for (int j = 0; j < 4; ++j) { v0[j] = (float)i0[j] * as * bs[bj][0][j]; v1[j] = (float)i1[j] * as * bs[bj][1][j]; }
                    u32x4 w; w.x = cvt_pk_bf16(v0[0], v0[1]); w.y = cvt_pk_bf16(v0[2], v0[3]); w.z = cvt_pk_bf16(v1[0], v1[1]); w.w = cvt_pk_bf16(v1[2], v1[3]);
                    *(u32x4*)(rowp + bj * HALF) = w; } }
    }
};
struct EpiSwiGLUI8 {
    static constexpr bool PERM = true, AFTER_DRAIN = false; typedef i32x4 acc_t;
    bf16_t* O; int ldc; int nN; const float* sa; const float* sb; float* TM;
    __device__ __forceinline__ void operator()(const i32x4 (&acc)[2][2][4][2], const Unit& u, int wr, int wc, int fr, int fq) const {
        const int pnl = u.pn % nN, row0 = u.pm * BM + wr * 64 + fr, col0 = pnl * HALF + wc * 32 + 8 * fq; const float* sbp = sb + (size_t)u.pn * BM + wc * 32 + 8 * fq;
        f32x4 bs[2][2];
#pragma unroll
        for (int bj = 0; bj < 2; ++bj) { bs[bj][0] = *(const f32x4*)(sbp + bj * HALF); bs[bj][1] = *(const f32x4*)(sbp + bj * HALF + 4); }
#pragma unroll
        for (int ai = 0; ai < 2; ++ai)
#pragma unroll
            for (int m = 0; m < 4; ++m) { const int row = row0 + ai * HALF + m * 16; const float as = sa[row]; bf16_t* rowp = O + (size_t)row * ldc + col0;
                const i32x4 g0 = acc[ai][0][m][0], g1 = acc[ai][0][m][1], u0 = acc[ai][1][m][0], u1 = acc[ai][1][m][1]; f32x4 a0, a1; float mx = 0.f;
#pragma unroll
                for (int j = 0; j < 4; ++j) { a0[j] = silu_f((float)g0[j] * as * bs[0][0][j]) * ((float)u0[j] * as * bs[1][0][j]); a1[j] = silu_f((float)g1[j] * as * bs[0][1][j]) * ((float)u1[j] * as * bs[1][1][j]);
                    mx = fmaxf(mx, fmaxf(fabsf(a0[j]), fabsf(a1[j]))); }
                u32x4 w; w.x = cvt_pk_bf16(a0[0], a0[1]); w.y = cvt_pk_bf16(a0[2], a0[3]); w.z = cvt_pk_bf16(a1[0], a1[1]); w.w = cvt_pk_bf16(a1[2], a1[3]);
                *(u32x4*)rowp = w;
                mx = fmaxf(mx, __shfl_xor(mx, 16)); mx = fmaxf(mx, __shfl_xor(mx, 32));
                if (fq == 0) TM[(size_t)row * 64 + pnl * 4 + wc] = mx; }
    }
};
template <class Epi, class Sched, bool ALIGN_EPI = false, bool SP2 = false>
__device__ __forceinline__ void gemm_phase(PG8_LAS unsigned char* lds, const Gemm g, const Sched& S, const Epi& E, int tid_in) {
    int tid_l = tid_in; asm volatile("" : "+v"(tid_l)); const int tid = tid_l, wid = __builtin_amdgcn_readfirstlane(tid >> 6), lane = tid & 63, wr = wid >> 2, wc = wid & 3, fr = lane & 15, fq = lane >> 4;
    const int K = g.K, nt = K / BK;
    unsigned voffA[2], voffB[2];
#pragma unroll
    for (int i = 0; i < 2; ++i) { int R, C; stage_rc(tid * 16 + i * 8192, R, C); const int Rb = Epi::PERM ? ((R & ~31) + perm32(R & 31)) : R;
        voffA[i] = (unsigned)(R * K + C) * 2u; voffB[i] = (unsigned)(Rb * K + C) * 2u; }
    const size_t kstep = (size_t)(BK * 2);
    const size_t hstep = (size_t)HALF * K * 2;
    const size_t tstep = 2 * hstep;
    const unsigned ldsw = (unsigned)wid * 1024u;
    const int aoff = lds_byte(wr * 64 + fr, fq * 8), boff = lds_byte(wc * 32 + fr, fq * 8);
#define PG8_SA(b, h) (((b) * 2 + (h)) * HTB)
#define PG8_SB(b, h) ((4 + (b) * 2 + (h)) * HTB)
#define PG8_STAGE(bufoff, gbase, voff) do { _Pragma("unroll") for (int _i = 0; _i < 2; ++_i) \
        __builtin_amdgcn_global_load_lds((const unsigned*)((const char*)(gbase) + (voff)[_i]), (PG8_LAS unsigned*)(lds + (bufoff) + ldsw + _i * 8192), 16, 0, 0); } while (0)
#define PG8_LDA(dst, b, h) do { _Pragma("unroll") for (int m = 0; m < 4; ++m) _Pragma("unroll") for (int k = 0; k < 2; ++k) dst[m][k] = *(const PG8_LAS bf16x8*)(lds + PG8_SA(b, h) + aoff + m * 2048 + k * 1024); } while (0)
#define PG8_LDB(dst, b, h) do { _Pragma("unroll") for (int n = 0; n < 2; ++n) _Pragma("unroll") for (int k = 0; k < 2; ++k) dst[n][k] = *(const PG8_LAS bf16x8*)(lds + PG8_SB(b, h) + boff + n * 2048 + k * 1024); } while (0)
#define PG8_MMA(ai, bj, At, Bt) do { __builtin_amdgcn_s_setprio(1); _Pragma("unroll") for (int m = 0; m < 4; ++m) _Pragma("unroll") for (int n = 0; n < 2; ++n) _Pragma("unroll") for (int k = 0; k < 2; ++k) \
        acc[ai][bj][m][n] = mma16(Bt[n][k], At[m][k], acc[ai][bj][m][n]); __builtin_amdgcn_s_setprio(0); } while (0)
#define PG8_WAIT_V(n) asm volatile("s_waitcnt vmcnt(" #n ")" ::: "memory")
#define PG8_WAIT_L(n) asm volatile("s_waitcnt lgkmcnt(" #n ")" ::: "memory")
#define PG8_BAR __builtin_amdgcn_s_barrier()
#define PG8_SCHED __builtin_amdgcn_sched_barrier(0)
    Unit cur, nxt; int ui = 0;
    if (!S.next(0, cur)) return;
    typename Epi::acc_t acc[2][2][4][2];
#pragma unroll
    for (int a = 0; a < 2; ++a)
#pragma unroll
        for (int b = 0; b < 2; ++b)
#pragma unroll
            for (int m = 0; m < 4; ++m)
#pragma unroll
                for (int n = 0; n < 2; ++n) acc[a][b][m][n] = (typename Epi::acc_t){0, 0, 0, 0};
    bf16x8 At[4][2], B0[2][2], B1[2][2];
    const char* cA = (const char*)g.A + (size_t)cur.pm * tstep; const char* cB = (const char*)g.Bt + (size_t)cur.pn * tstep;
    S.a_ready(cur);
    if constexpr (SP2) {
        PG8_STAGE(PG8_SB(0, 0), cB, voffB); PG8_STAGE(PG8_SB(0, 1), cB + hstep, voffB); PG8_STAGE(PG8_SA(0, 0), cA, voffA); PG8_STAGE(PG8_SA(0, 1), cA + hstep, voffA);
        if (wr == 1) PG8_BAR;
        PG8_WAIT_V(2); PG8_BAR;
        PG8_STAGE(PG8_SB(1, 0), cB + kstep, voffB); PG8_STAGE(PG8_SA(1, 0), cA + kstep, voffA); PG8_STAGE(PG8_SB(1, 1), cB + hstep + kstep, voffB);
        PG8_WAIT_V(6); PG8_BAR;
    } else {
        PG8_STAGE(PG8_SB(0, 0), cB, voffB); PG8_STAGE(PG8_SA(0, 0), cA, voffA); PG8_STAGE(PG8_SB(0, 1), cB + hstep, voffB); PG8_STAGE(PG8_SA(0, 1), cA + hstep, voffA);
        if (wr == 1) PG8_BAR;
        PG8_WAIT_V(4); PG8_BAR;
        PG8_STAGE(PG8_SB(1, 0), cB + kstep, voffB); PG8_STAGE(PG8_SA(1, 0), cA + kstep, voffA); PG8_STAGE(PG8_SB(1, 1), cB + hstep + kstep, voffB);
        PG8_WAIT_V(6); PG8_BAR;
    }
    for (;;) {
        const bool has_next = S.next(ui + 1, nxt);
        const char* nA = has_next ? (const char*)g.A + (size_t)nxt.pm * tstep : cA; const char* nB = has_next ? (const char*)g.Bt + (size_t)nxt.pn * tstep : cB;
        for (int t = 0; t < nt; t += 2) {
            const bool last = (t == nt - 2);
            const char* a1 = cA + (size_t)(t + 1) * kstep;
            const char* a2 = last ? nA : cA + (size_t)(t + 2) * kstep; const char* b2 = last ? nB : cB + (size_t)(t + 2) * kstep;
            const char* a3 = a2 + kstep; const char* b3 = b2 + kstep;
            if (last && has_next) S.a_ready(nxt);
            if constexpr (SP2) {
            PG8_LDB(B0, 0, 0); PG8_LDB(B1, 0, 1); PG8_SCHED; PG8_LDA(At, 0, 0); PG8_STAGE(PG8_SA(1, 1), a1 + hstep, voffA);
            PG8_WAIT_V(8); PG8_WAIT_L(0); PG8_BAR; PG8_MMA(0, 0, At, B0); PG8_MMA(0, 1, At, B1); PG8_BAR; PG8_SCHED;
            PG8_LDA(At, 0, 1); PG8_STAGE(PG8_SB(0, 0), b2, voffB); PG8_STAGE(PG8_SB(0, 1), b2 + hstep, voffB); PG8_STAGE(PG8_SA(0, 0), a2, voffA);
            PG8_WAIT_V(8); PG8_WAIT_L(0); PG8_BAR; PG8_MMA(1, 0, At, B0); PG8_MMA(1, 1, At, B1); PG8_BAR; PG8_SCHED;
            PG8_LDB(B0, 1, 0); PG8_LDB(B1, 1, 1); PG8_SCHED; PG8_LDA(At, 1, 0); PG8_STAGE(PG8_SA(0, 1), a2 + hstep, voffA);
            PG8_WAIT_V(8); PG8_WAIT_L(0); PG8_BAR; PG8_MMA(0, 0, At, B0); PG8_MMA(0, 1, At, B1); PG8_BAR; PG8_SCHED;
            PG8_LDA(At, 1, 1); PG8_STAGE(PG8_SB(1, 0), b3, voffB); PG8_STAGE(PG8_SB(1, 1), b3 + hstep, voffB); PG8_STAGE(PG8_SA(1, 0), a3, voffA);
            PG8_WAIT_V(8); PG8_WAIT_L(0); PG8_BAR; PG8_MMA(1, 0, At, B0); PG8_MMA(1, 1, At, B1); PG8_BAR; PG8_SCHED;
            } else {
            PG8_LDB(B0, 0, 0); PG8_SCHED; PG8_LDA(At, 0, 0); PG8_STAGE(PG8_SA(1, 1), a1 + hstep, voffA);
            PG8_WAIT_L(8); PG8_BAR; PG8_WAIT_L(0); PG8_MMA(0, 0, At, B0); PG8_BAR; PG8_SCHED;
            PG8_LDB(B1, 0, 1); PG8_STAGE(PG8_SB(0, 0), b2, voffB);
            PG8_BAR; PG8_WAIT_L(0); PG8_MMA(0, 1, At, B1); PG8_BAR;
            PG8_LDA(At, 0, 1); PG8_STAGE(PG8_SA(0, 0), a2, voffA);
            PG8_BAR; PG8_WAIT_L(0); PG8_MMA(1, 0, At, B0); PG8_BAR; PG8_SCHED;
            PG8_STAGE(PG8_SB(0, 1), b2 + hstep, voffB);
            PG8_WAIT_V(6); PG8_BAR; PG8_MMA(1, 1, At, B1); PG8_BAR;
            PG8_LDB(B0, 1, 0); PG8_SCHED; PG8_LDA(At, 1, 0); PG8_STAGE(PG8_SA(0, 1), a2 + hstep, voffA);
            PG8_WAIT_L(8); PG8_BAR; PG8_WAIT_L(0); PG8_MMA(0, 0, At, B0); PG8_BAR; PG8_SCHED;
            PG8_LDB(B1, 1, 1); PG8_STAGE(PG8_SB(1, 0), b3, voffB);
            PG8_BAR; PG8_WAIT_L(0); PG8_MMA(0, 1, At, B1); PG8_BAR;
            PG8_LDA(At, 1, 1); PG8_STAGE(PG8_SA(1, 0), a3, voffA);
            PG8_BAR; PG8_WAIT_L(0); PG8_MMA(1, 0, At, B0); PG8_BAR; PG8_SCHED;
            PG8_STAGE(PG8_SB(1, 1), b3 + hstep, voffB);
            PG8_WAIT_V(6); PG8_BAR; PG8_MMA(1, 1, At, B1); PG8_BAR;
            }
        }
        if constexpr (ALIGN_EPI) { if (wr == 0) PG8_BAR; }
        if constexpr (!Epi::AFTER_DRAIN) { E(acc, cur, wr, wc, fr, fq); S.done(cur); }
        if (!has_next) break;
#pragma unroll
        for (int a = 0; a < 2; ++a)
#pragma unroll
            for (int b = 0; b < 2; ++b)
#pragma unroll
                for (int m = 0; m < 4; ++m)
#pragma unroll
                    for (int n = 0; n < 2; ++n) acc[a][b][m][n] = (typename Epi::acc_t){0, 0, 0, 0};
        cur = nxt; cA = nA; cB = nB; ++ui;
        if constexpr (ALIGN_EPI) { if (wr == 1) PG8_BAR; }
    }
    PG8_WAIT_V(0);
    if constexpr (!ALIGN_EPI) { if (wr == 0) PG8_BAR; }
    PG8_BAR;
    if constexpr (Epi::AFTER_DRAIN) { E.fused(acc, cur, wr, wc, fr, fq, lds, wid, lane); S.done(cur); }
#undef PG8_SA
#undef PG8_SB
#undef PG8_STAGE
#undef PG8_LDA
#undef PG8_LDB
#undef PG8_MMA
#undef PG8_WAIT_V
#undef PG8_WAIT_L
#undef PG8_BAR
#undef PG8_SCHED
}
}
#define LAS __attribute__((address_space(3)))
typedef unsigned short bf16;
typedef short bf16x8 __attribute__((ext_vector_type(8)));
typedef short bf16x4 __attribute__((ext_vector_type(4)));
typedef float f32x4 __attribute__((ext_vector_type(4)));
typedef float f32x2 __attribute__((ext_vector_type(2)));
typedef unsigned u32x4 __attribute__((ext_vector_type(4)));
typedef unsigned u32x2 __attribute__((ext_vector_type(2)));

constexpr int D = 2048, NB = 8, SEQ = 2048, CTXL = 256, DEPTH = 2, GRIDW = 64;
constexpr int NLAT = NB * SEQ, NCTX = NB * CTXL, NROW = NLAT + NCTX;
constexpr int HA = 8, DHA = 64, HB = 4, DKB = 128, DVB = 256, DECR = 16, GC = 4, CG = 128, MIXC = 128;
constexpr int NE = 16, FF = 2048, CAPL = 256, CAPC = 32;
constexpr int N_IN = 5664, NU = 5888;
constexpr int U_QA = 0, U_KA = 512, U_VA = 1024, U_KB = 1536, U_VB = 2048, U_QB = 3072, U_GB = 3584, U_UC = 4608, U_VC = 5120, U_DEC = 5632;
constexpr int MIX_A = 0, MIX_B = 512, MIX_C = 1536;
constexpr float EPS = 1e-6f;
constexpr int ME0 = NB * CAPL + NB * CAPC, ME1 = NB * CAPL;

constexpr size_t MiB = 1u << 20;
constexpr size_t WS_CTL = 0, CTL_ZERO_BYTES = 65536;
constexpr size_t WS_MOD = 1 * MiB;
constexpr size_t WS_ROPE = 2 * MiB;
constexpr size_t WS_CV = WS_ROPE + 65536;
constexpr size_t WS_AFF = 3 * MiB;
constexpr size_t WS_TSLOT = 5 * MiB;
constexpr size_t WS_GD = 6656 * 1024;
constexpr size_t WS_WIN = 8 * MiB;
constexpr size_t WS_SIN = WS_WIN + 24 * MiB;
constexpr size_t WS_WOUT = 54 * MiB;
constexpr size_t WS_W1 = 70 * MiB;
constexpr size_t WS_S1 = WS_W1 + 256 * MiB;
constexpr size_t WS_W2 = 582 * MiB;
constexpr size_t WS_S2 = WS_W2 + 128 * MiB;
constexpr size_t WS_H = 838 * MiB;
constexpr size_t WS_HS = WS_H + 36 * MiB;
constexpr size_t WS_XC = 910 * MiB;
constexpr size_t WS_R1 = 926 * MiB;
constexpr size_t WS_R2 = 1133 * MiB;
constexpr size_t WS_XSS = WS_R2 + 72 * MiB;
constexpr size_t WS_TM = WS_R1 + 144 * MiB;
constexpr size_t WS_ACTS = WS_TM + 9 * MiB;
constexpr size_t WS_ACTQ = 1349 * MiB;
constexpr size_t WS_GQ = WS_R2, WS_GK = WS_R2 + 36 * MiB, WS_GV = WS_R2 + 72 * MiB;
constexpr size_t WS_MIX = 1277 * MiB;
constexpr size_t WS_OB = 1349 * MiB;
constexpr size_t WS_END = 1421 * MiB;
constexpr size_t WS_DUMMY = WS_END;
constexpr size_t WS_XB = WS_END + 72 * MiB;
constexpr size_t WS_END2 = WS_XB + 72 * MiB;
static_assert((size_t)DEPTH * NU * D * 2 <= 46 * MiB && (size_t)NROW * NU * 2 <= 207 * MiB && (size_t)NE * ME0 * D * 2 <= 144 * MiB && (size_t)NROW * D * 2 <= 72 * MiB, "ws map");
constexpr int CW_TMO = 0, CW_BAR = 4096, CW_BG = 8192, CW_SIG = 8256;

constexpr int LDS_BYTES = 147456, NWAVES = 8, NTHR = 512;
constexpr int LDS_XB = 147456 - 64;

using pg8::silu_f; using pg8::xmax16; using pg8::xmax32; using pg8::xsum16; using pg8::xsum32;
typedef __bf16 hwbf16x2 __attribute__((ext_vector_type(2)));
__device__ __forceinline__ unsigned pk2(float lo, float hi) { const f32x2 v = {lo, hi}; const hwbf16x2 b = __builtin_convertvector(v, hwbf16x2); return __builtin_bit_cast(unsigned, b); }
__device__ __forceinline__ unsigned f2bf(float f) { return pk2(f, 0.f) & 0xffffu; }
__device__ __forceinline__ float bf2f(unsigned b) { return __builtin_bit_cast(float, b << 16); }
__device__ __forceinline__ float bflo(unsigned w) { return __builtin_bit_cast(float, w << 16); }
__device__ __forceinline__ float bfhi(unsigned w) { return __builtin_bit_cast(float, w & 0xffff0000u); }
template <int CTRL, int ROWMASK> __device__ __forceinline__ float dpp_f(float old, float v) { return __builtin_bit_cast(float, __builtin_amdgcn_update_dpp(__builtin_bit_cast(int, old), __builtin_bit_cast(int, v), CTRL, ROWMASK, 0xf, false)); }
__device__ __forceinline__ float wave_sum(float v) {
    v += dpp_f<0xB1, 0xf>(0.f, v); v += dpp_f<0x4E, 0xf>(0.f, v); v += dpp_f<0x141, 0xf>(0.f, v); v += dpp_f<0x140, 0xf>(0.f, v);
    v += dpp_f<0x142, 0xa>(0.f, v); v += dpp_f<0x143, 0xc>(0.f, v);
    return __builtin_bit_cast(float, __builtin_amdgcn_readlane(__builtin_bit_cast(int, v), 63));
}
__device__ __forceinline__ float gelu_tanh(float x) { const float u = 0.7978845608028654f * (x + 0.044715f * x * x * x); const float e = __expf(2.0f * u); return 0.5f * x * (2.0f - 2.0f * __builtin_amdgcn_rcpf(1.0f + e)); }
__device__ __forceinline__ float log_sigmoid(float z) { return fminf(z, 0.0f) - __logf(1.0f + __expf(-fabsf(z))); }
#define LDS_WAIT() asm volatile("s_waitcnt lgkmcnt(0)" ::: "memory")

__device__ __forceinline__ void row_load_f32(const float* p, int lane, float (&v)[32]) {
#pragma unroll
    for (int j = 0; j < 4; ++j) { const f32x4 a = *(const f32x4*)(p + 512 * j + 8 * lane), b = *(const f32x4*)(p + 512 * j + 8 * lane + 4);
        v[8 * j + 0] = a[0]; v[8 * j + 1] = a[1]; v[8 * j + 2] = a[2]; v[8 * j + 3] = a[3]; v[8 * j + 4] = b[0]; v[8 * j + 5] = b[1]; v[8 * j + 6] = b[2]; v[8 * j + 7] = b[3]; }
}
__device__ __forceinline__ void row_load_f32_nt(const float* p, int lane, float (&v)[32]) {
#pragma unroll
    for (int j = 0; j < 4; ++j) { const f32x4 a = __builtin_nontemporal_load((const f32x4*)(p + 512 * j + 8 * lane)), b = __builtin_nontemporal_load((const f32x4*)(p + 512 * j + 8 * lane + 4));
        v[8 * j + 0] = a[0]; v[8 * j + 1] = a[1]; v[8 * j + 2] = a[2]; v[8 * j + 3] = a[3]; v[8 * j + 4] = b[0]; v[8 * j + 5] = b[1]; v[8 * j + 6] = b[2]; v[8 * j + 7] = b[3]; }
}
__device__ __forceinline__ void row_load_bf16_nt(const bf16* p, int lane, float (&v)[32]) {
#pragma unroll
    for (int j = 0; j < 4; ++j) { const u32x4 a = __builtin_nontemporal_load((const u32x4*)(p + 512 * j + 8 * lane));
        v[8 * j + 0] = bflo(a.x); v[8 * j + 1] = bfhi(a.x); v[8 * j + 2] = bflo(a.y); v[8 * j + 3] = bfhi(a.y); v[8 * j + 4] = bflo(a.z); v[8 * j + 5] = bfhi(a.z); v[8 * j + 6] = bflo(a.w); v[8 * j + 7] = bfhi(a.w); }
}
__device__ __forceinline__ void row_store_f32(float* p, int lane, const float (&v)[32]) {
#pragma unroll
    for (int j = 0; j < 4; ++j) { __builtin_nontemporal_store((f32x4){v[8 * j], v[8 * j + 1], v[8 * j + 2], v[8 * j + 3]}, (f32x4*)(p + 512 * j + 8 * lane)); __builtin_nontemporal_store((f32x4){v[8 * j + 4], v[8 * j + 5], v[8 * j + 6], v[8 * j + 7]}, (f32x4*)(p + 512 * j + 8 * lane + 4)); }
}
__device__ __forceinline__ void row_load_bf16(const bf16* p, int lane, float (&v)[32]) {
#pragma unroll
    for (int j = 0; j < 4; ++j) { const u32x4 a = *(const u32x4*)(p + 512 * j + 8 * lane);
        v[8 * j + 0] = bflo(a.x); v[8 * j + 1] = bfhi(a.x); v[8 * j + 2] = bflo(a.y); v[8 * j + 3] = bfhi(a.y); v[8 * j + 4] = bflo(a.z); v[8 * j + 5] = bfhi(a.z); v[8 * j + 6] = bflo(a.w); v[8 * j + 7] = bfhi(a.w); }
}
__device__ __forceinline__ void row_store_bf16(bf16* p, int lane, const float (&v)[32]) {
#pragma unroll
    for (int j = 0; j < 4; ++j) { u32x4 a; a.x = pk2(v[8 * j], v[8 * j + 1]); a.y = pk2(v[8 * j + 2], v[8 * j + 3]); a.z = pk2(v[8 * j + 4], v[8 * j + 5]); a.w = pk2(v[8 * j + 6], v[8 * j + 7]); __builtin_nontemporal_store(a, (u32x4*)(p + 512 * j + 8 * lane)); }
}
__device__ __forceinline__ float row_sumsq(const float (&v)[32]) { float s = 0.f;
#pragma unroll
    for (int i = 0; i < 32; ++i) s += v[i] * v[i];
    return wave_sum(s); }

#define XB_TMO      128
#define XB_XCNT(j)  (256  + 64 * (j))
#define XB_XSUB(j)  (1280 + 64 * (j))
#define XB_XGEN(j)  (2304 + 64 * (j))
#define XB_TOP      3328
#define XB_TOPGEN   3392
#define XCD_BAR_WORDS 3456
#define XB_SPIN_CAP (1u << 18)
#define LAS __attribute__((address_space(3)))

__device__ __forceinline__ unsigned xb_ld(unsigned* p)              { return __hip_atomic_load(p, __ATOMIC_RELAXED, __HIP_MEMORY_SCOPE_AGENT); }
__device__ __forceinline__ unsigned xb_add(unsigned* p, unsigned v) { return __hip_atomic_fetch_add(p, v, __ATOMIC_RELAXED, __HIP_MEMORY_SCOPE_AGENT); }
__device__ __forceinline__ unsigned xb_xcc_id() { return (unsigned)__builtin_amdgcn_s_getreg((3 << 11) | 20) & 0xFu; }
#define XB_SPIN(cond, bar) do { unsigned _sp = 0; while (cond) { __builtin_amdgcn_s_sleep(1); \
    if ((++_sp & 255u) == 0u) { if (xb_ld(&(bar)[XB_TMO])) break; if (_sp > XB_SPIN_CAP) { atomicAdd(&(bar)[XB_TMO], 1u); break; } } } } while (0)

struct XcdBarrier {
    unsigned* bar; unsigned x;
    volatile LAS unsigned* st;
};

__device__ __forceinline__ XcdBarrier xcd_barrier_post(unsigned* bar, volatile LAS unsigned* st) {
    XcdBarrier b; b.bar = bar; b.x = xb_xcc_id(); b.st = st;
    if (threadIdx.x == 0) (void)xb_add(&bar[XB_XCNT(b.x)], 1u);
    return b;
}
__device__ __forceinline__ void xcd_barrier_complete(unsigned* bar, unsigned x, unsigned& nloc, unsigned& nx) {
    const unsigned G = gridDim.x * gridDim.y * gridDim.z;
    unsigned sum, cnt, mine, sp = 0u;
    for (;;) {
        sum = 0u; cnt = 0u; mine = 0u;
#pragma unroll
        for (unsigned j = 0; j < 16; ++j) { const unsigned c = xb_ld(&bar[XB_XCNT(j)]); sum += c; cnt += (c > 0u) ? 1u : 0u; mine = (j == x) ? c : mine; }
        if (sum == G) break;
        __builtin_amdgcn_s_sleep(1);
        if ((++sp & 255u) == 0u) { if (xb_ld(&bar[XB_TMO])) break; if (sp > XB_SPIN_CAP) { atomicAdd(&bar[XB_TMO], 1u); break; } }
    }
    nloc = mine > 0u ? mine : 1u; nx = cnt > 0u ? cnt : 1u;
}

__device__ __forceinline__ void xcd_barrier(const XcdBarrier& b) {
    asm volatile("s_waitcnt vmcnt(0)" ::: "memory");
    __syncthreads();
    if (threadIdx.x == 0) {
        unsigned* bar = b.bar;
        __builtin_amdgcn_s_waitcnt(0);
        unsigned nloc = b.st[0], nx = b.st[1];
        if (nloc == 0u) { xcd_barrier_complete(bar, b.x, nloc, nx); b.st[0] = nloc; b.st[1] = nx; }
        const unsigned old = xb_add(&bar[XB_XSUB(b.x)], 1u);
        const unsigned gen = old / nloc;
        if (old + 1u == (gen + 1u) * nloc) {
            __builtin_amdgcn_fence(__ATOMIC_RELEASE, "agent");
            asm volatile("s_waitcnt vmcnt(0)" ::: "memory");
            const unsigned og = xb_add(&bar[XB_TOP], 1u);
            const unsigned tg = og / nx;
            if (og + 1u == (tg + 1u) * nx) xb_add(&bar[XB_TOPGEN], 1u);
            else XB_SPIN(xb_ld(&bar[XB_TOPGEN]) == tg, bar);
            __builtin_amdgcn_fence(__ATOMIC_ACQUIRE, "agent");
            xb_add(&bar[XB_XGEN(b.x)], 1u);
            asm volatile("s_waitcnt vmcnt(0)" ::: "memory");
        } else {
            XB_SPIN(xb_ld(&bar[XB_XGEN(b.x)]) == gen, bar);
            __builtin_amdgcn_fence(__ATOMIC_ACQUIRE, "agent");
            asm volatile("s_waitcnt vmcnt(0)" ::: "memory");
        }
    }
    __syncthreads();
}

struct Frame {
    LAS unsigned char* lds;
    int tid, lane, wave, vcu, G;
    const float *x, *c, *ctx, *c_ctx, *w_ada, *b_ada, *g_pre_mix, *g_post_mix, *g_pre_ffn, *g_post_ffn, *w_in, *w_dec, *b_dec, *rpb, *g_gla, *ln_v_g, *ln_v_b, *w_sp, *b_sp, *w_out, *w_router, *w_gate, *w_up, *w_down;
    float* out; unsigned char* ws;
};

#define W_MOD(F) ((float*)((F).ws + WS_MOD))
#define W_ROPE(F) ((float*)((F).ws + WS_ROPE))
#define W_CV(F) ((bf16*)((F).ws + WS_CV))
#define W_AFF(F) ((float*)((F).ws + WS_AFF))
#define W_XC(F) ((float*)((F).ws + WS_XC))
#define W_XB(F) ((bf16*)((F).ws + WS_XB))
#define W_TSLOT(F) ((int*)((F).ws + WS_TSLOT))
#define W_WIN(F) ((bf16*)((F).ws + WS_WIN))
#define W_WOUT(F) ((bf16*)((F).ws + WS_WOUT))
#define W_W1(F) ((bf16*)((F).ws + WS_W1))
#define W_W2(F) ((bf16*)((F).ws + WS_W2))
#define W_H(F) ((bf16*)((F).ws + WS_H))
#define W_U(F) ((bf16*)((F).ws + WS_R1))
#define W_Y(F) ((bf16*)((F).ws + WS_R1))
#define W_ACT(F) ((bf16*)((F).ws + WS_R1))
#define W_XS(F) ((bf16*)((F).ws + WS_R2))
#define W_MIX(F) ((bf16*)((F).ws + WS_MIX))
#define W_OB(F) ((bf16*)((F).ws + WS_OB))
#define W_SIN(F) ((float*)((F).ws + WS_SIN))
#define W_S1(F) ((float*)((F).ws + WS_S1))
#define W_S2(F) ((float*)((F).ws + WS_S2))
#define W_HQ(F) ((signed char*)((F).ws + WS_H))
#define W_HS(F) ((float*)((F).ws + WS_HS))
#define W_XSQ(F) ((signed char*)((F).ws + WS_R2))
#define W_XSS(F) ((float*)((F).ws + WS_XSS))
#define W_TM(F) ((float*)((F).ws + WS_TM))
#define W_ACTS(F) ((float*)((F).ws + WS_ACTS))
#define W_ACTQ(F) ((signed char*)((F).ws + WS_ACTQ))
__device__ __forceinline__ void launder(Frame& F) {
    int wv = F.wave; asm volatile("" : "+s"(wv)); F.wave = wv;
    unsigned ones = ~0u; asm volatile("" : "+s"(ones));
    int t = wv * 64 + (int)__builtin_amdgcn_mbcnt_hi(ones, __builtin_amdgcn_mbcnt_lo(ones, 0u)); asm volatile("" : "+v"(t)); F.tid = t; F.lane = t & 63;
    int v = F.vcu; asm volatile("" : "+s"(v)); F.vcu = v;
    __attribute__((address_space(1))) unsigned char* w = (__attribute__((address_space(1))) unsigned char*)F.ws; asm volatile("" : "+s"(w)); F.ws = (unsigned char*)w;
}

__device__ __forceinline__ float wave_max(float v) {
    v = fmaxf(v, dpp_f<0xB1, 0xf>(v, v)); v = fmaxf(v, dpp_f<0x4E, 0xf>(v, v)); v = fmaxf(v, dpp_f<0x141, 0xf>(v, v)); v = fmaxf(v, dpp_f<0x140, 0xf>(v, v));
    v = fmaxf(v, dpp_f<0x142, 0xa>(v, v)); v = fmaxf(v, dpp_f<0x143, 0xc>(v, v));
    return __builtin_bit_cast(float, __builtin_amdgcn_readlane(__builtin_bit_cast(int, v), 63));
}
__device__ __forceinline__ unsigned pack4_i8(float a, float b, float c, float d) { return ((unsigned)(int)a & 0xffu) | (((unsigned)(int)b & 0xffu) << 8) | (((unsigned)(int)c & 0xffu) << 16) | (((unsigned)(int)d & 0xffu) << 24); }
__device__ __forceinline__ unsigned q4_i8(float a, float b, float c, float d, float inv) {
    const unsigned x0 = __builtin_bit_cast(unsigned, fmaf(a, inv, 12582912.f)), x1 = __builtin_bit_cast(unsigned, fmaf(b, inv, 12582912.f)), x2 = __builtin_bit_cast(unsigned, fmaf(c, inv, 12582912.f)), x3 = __builtin_bit_cast(unsigned, fmaf(d, inv, 12582912.f));
    return __builtin_amdgcn_perm(x1, x0, 0x0c0c0400u) | __builtin_amdgcn_perm(x3, x2, 0x04000c0cu);
}
__device__ __forceinline__ void row_store_i8(signed char* p, int lane, const float (&v)[32], float inv) {
#pragma unroll
    for (int j = 0; j < 4; ++j) { u32x2 o; o.x = q4_i8(v[8 * j], v[8 * j + 1], v[8 * j + 2], v[8 * j + 3], inv); o.y = q4_i8(v[8 * j + 4], v[8 * j + 5], v[8 * j + 6], v[8 * j + 7], inv);
        __builtin_nontemporal_store(o, (u32x2*)(p + 512 * j + 8 * lane)); }
}

#define LBAR() do { asm volatile("s_waitcnt lgkmcnt(0)" ::: "memory"); __builtin_amdgcn_s_barrier(); asm volatile("" ::: "memory"); } while (0)
__device__ __forceinline__ int dest_row(int mode, int n) {
    if (mode == 1) return n < 3072 ? n : (n < 3104 ? U_DEC + (n - 3072) : n - 32);
    if (mode == 2) return ((n >> 7) << 8) + (n & 127);
    if (mode == 3) return ((n >> 7) << 8) + 128 + (n & 127);
    return n;
}
constexpr int IN_ITEMS = (N_IN + 63) / 64;
constexpr int BG_IN0 = IN_ITEMS, BG_A = BG_IN0 + NE * 3 * 32, BG_B = BG_A + IN_ITEMS, BG_TOTAL = BG_B + NE * 3 * 32;
__device__ __forceinline__ unsigned pkbf(float lo, float hi) { unsigned r; asm volatile("v_cvt_pk_bf16_f32 %0, %1, %2" : "=v"(r) : "v"(lo), "v"(hi)); return r; }
__device__ __forceinline__ void strip_item(Frame& F, int id) {
    const int lane = F.lane, n16 = lane & 15, kq = lane >> 4;
    LAS float* cm = (LAS float*)(F.lds); LAS unsigned* qb = (LAS unsigned*)(F.lds + 2048);
    const int l = id >= BG_A ? 1 : 0, idl = l ? id - BG_A : id; const bool isin = idl < IN_ITEMS; const int itm = isin ? idl : idl - IN_ITEMS;
    const int mi = itm >> 5, n0 = isin ? itm * 64 : (itm & 31) * 64, e = mi / 3, which = isin ? 3 : mi % 3; const size_t le = (size_t)l * NE + e;
    const float* W = isin ? F.w_in + (size_t)l * D * N_IN : (which == 0 ? F.w_gate + le * D * FF : (which == 1 ? F.w_up + le * D * FF : F.w_down + le * FF * D));
    const int mode = isin ? 1 : (which == 0 ? 2 : (which == 1 ? 3 : 0)), pitch = isin ? N_IN : D, N = isin ? N_IN : D;
    signed char* dq = isin ? (signed char*)(F.ws + WS_WIN) + (size_t)l * NU * D : (which == 2 ? (signed char*)(F.ws + WS_W2) + le * D * FF : (signed char*)(F.ws + WS_W1) + le * (2 * FF) * D);
    float* ds = isin ? W_SIN(F) + (size_t)l * NU : (which == 2 ? W_S2(F) + le * D : W_S1(F) + le * (2 * FF));
    const bool colok = (n0 + 4 * n16) < N;
    const float* src = W + (size_t)(256 * F.wave + 4 * kq) * pitch + n0 + 4 * n16;
    unsigned pk[16][4][2];
#pragma unroll
    for (int hb = 0; hb < 4; ++hb) {
        f32x4 t[4][4];
#pragma unroll
        for (int j = 0; j < 4; ++j)
#pragma unroll
            for (int e4 = 0; e4 < 4; ++e4) t[j][e4] = colok ? __builtin_nontemporal_load((const f32x4*)(src + (size_t)(16 * (4 * hb + j) + e4) * pitch)) : (f32x4){0.f, 0.f, 0.f, 0.f};
#pragma unroll
        for (int j = 0; j < 4; ++j) {
#pragma unroll
            for (int e4 = 0; e4 < 4; ++e4) { pk[4 * hb + j][e4][0] = pkbf(t[j][e4][0], t[j][e4][1]); pk[4 * hb + j][e4][1] = pkbf(t[j][e4][2], t[j][e4][3]); }
            asm volatile("" : "+v"(pk[4 * hb + j][0][0]), "+v"(pk[4 * hb + j][0][1]), "+v"(pk[4 * hb + j][1][0]), "+v"(pk[4 * hb + j][1][1]), "+v"(pk[4 * hb + j][2][0]), "+v"(pk[4 * hb + j][2][1]), "+v"(pk[4 * hb + j][3][0]), "+v"(pk[4 * hb + j][3][1]) :: "memory");
        }
    }
    typedef unsigned short u16x2 __attribute__((ext_vector_type(2)));
    u16x2 m01 = {0, 0}, m23 = {0, 0};
#pragma unroll
    for (int j = 0; j < 16; ++j)
#pragma unroll
        for (int e4 = 0; e4 < 4; ++e4) { m01 = __builtin_elementwise_max(m01, __builtin_bit_cast(u16x2, pk[j][e4][0] & 0x7fff7fffu)); m23 = __builtin_elementwise_max(m23, __builtin_bit_cast(u16x2, pk[j][e4][1] & 0x7fff7fffu)); }
    float mx[4] = {bf2f(m01[0]), bf2f(m01[1]), bf2f(m23[0]), bf2f(m23[1])};
#pragma unroll
    for (int c = 0; c < 4; ++c) { mx[c] = fmaxf(mx[c], __shfl_xor(mx[c], 16)); mx[c] = fmaxf(mx[c], __shfl_xor(mx[c], 32)); }
    if (lane < 16) *(LAS f32x4*)(cm + F.wave * 64 + 4 * lane) = (f32x4){mx[0], mx[1], mx[2], mx[3]};
#pragma unroll
    for (int j = 0; j < 16; ++j)
        asm volatile("" : "+v"(pk[j][0][0]), "+v"(pk[j][0][1]), "+v"(pk[j][1][0]), "+v"(pk[j][1][1]), "+v"(pk[j][2][0]), "+v"(pk[j][2][1]), "+v"(pk[j][3][0]), "+v"(pk[j][3][1]));
    LBAR();
    f32x4 cmx = (f32x4){0.f, 0.f, 0.f, 0.f};
#pragma unroll
    for (int w = 0; w < 8; ++w) { const f32x4 c4 = *(const LAS f32x4*)(cm + w * 64 + 4 * n16); cmx = __builtin_elementwise_max(cmx, c4); }
    float sc[4], iv[4];
#pragma unroll
    for (int c = 0; c < 4; ++c) { sc[c] = cmx[c] > 0.f ? cmx[c] * (1.0f / 127.0f) : 1.0f; iv[c] = 1.0f / sc[c]; }
    if (F.tid < 16 && colok) {
#pragma unroll
        for (int c = 0; c < 4; ++c) ds[dest_row(mode, n0 + 4 * F.tid + c)] = sc[c]; }
    const int sw = (n16 >> 1);
#pragma unroll
    for (int j = 0; j < 16; ++j) {
        unsigned o[4];
#pragma unroll
        for (int c = 0; c < 4; ++c) { unsigned x[4];
#pragma unroll
            for (int e4 = 0; e4 < 4; ++e4) { const unsigned wv = pk[j][e4][c >> 1]; const float xf = (c & 1) ? bfhi(wv) : bflo(wv); x[e4] = __builtin_bit_cast(unsigned, fmaf(xf, iv[c], 12582912.f)); }
            o[c] = __builtin_amdgcn_perm(x[1], x[0], 0x0c0c0400u) | __builtin_amdgcn_perm(x[3], x[2], 0x04000c0cu); }
        const int idx4 = (16 * F.wave + j) ^ sw;
#pragma unroll
        for (int c = 0; c < 4; ++c) qb[(4 * n16 + c) * 516 + 4 * idx4 + kq] = o[c];
    }
    LBAR();
#pragma unroll
    for (int q16 = 0; q16 < 16; ++q16) { const int p = F.tid + 512 * q16, n = p >> 7, c16 = p & 127;
        if (n0 + n < N) __builtin_nontemporal_store(*(const LAS u32x4*)(qb + n * 516 + 4 * (c16 ^ (n >> 3))), (u32x4*)(dq + (size_t)dest_row(mode, n0 + n) * D + 16 * c16)); }
    LBAR();
}
__device__ __forceinline__ void bg_loop(Frame& F, unsigned* ctl, const unsigned* sig, int limit) {
    LAS int* flag = (LAS int*)(F.lds + 140000);
    unsigned* head = ctl + CW_BG;
    __syncthreads();
    for (;;) {
        if (F.tid == 0) { int idx = -1;
            const bool stop = sig && __hip_atomic_load(sig, __ATOMIC_RELAXED, __HIP_MEMORY_SCOPE_AGENT) != 0u;
            if (!stop && (int)__hip_atomic_load(head, __ATOMIC_RELAXED, __HIP_MEMORY_SCOPE_AGENT) + BG_IN0 < limit) { idx = (int)__hip_atomic_fetch_add(head, 1u, __ATOMIC_RELAXED, __HIP_MEMORY_SCOPE_AGENT) + BG_IN0; if (idx >= BG_TOTAL) idx = -1; }
            *flag = idx; }
        __syncthreads();
        const int idx = *flag;
        __syncthreads();
        if (idx < 0) break;
        strip_item(F, idx);
    }
}
#ifndef MK_REPP0
#define MK_REPP0 0u
#endif
__device__ __forceinline__ void transpose_item(const float* W, int N, int k0, int n0, bf16* dst, int mode, LAS float* scr, int lane) {
    const bool nok = (n0 + lane) < N;
    const float* src = W + (size_t)k0 * N + n0 + lane;
#pragma unroll 8
    for (int i = 0; i < 64; ++i) scr[i * 65 + lane] = nok ? __builtin_nontemporal_load(src + (size_t)i * N) : 0.f;
    LDS_WAIT();
    const int c = lane & 7;
#pragma unroll
    for (int j = 0; j < 8; ++j) { const int nl = (lane >> 3) + 8 * j, n = n0 + nl; const LAS float* s = scr + (8 * c) * 65 + nl;
        u32x4 o; o.x = pk2(s[0 * 65], s[1 * 65]); o.y = pk2(s[2 * 65], s[3 * 65]); o.z = pk2(s[4 * 65], s[5 * 65]); o.w = pk2(s[6 * 65], s[7 * 65]);
        if (n < N) *(u32x4*)(dst + (size_t)dest_row(mode, n) * D + k0 + 8 * c) = o; }
    LDS_WAIT();
}
__device__ __forceinline__ void p0a(Frame& F) {
    const int gw = F.vcu * NWAVES + F.wave, NGW = F.G * NWAVES, lane = F.lane;
    for (int rep0 = 0; rep0 < 1 + (int)(MK_REPP0 & 1u); ++rep0) {
        LAS float* red = (LAS float*)F.lds;
        for (int it = F.vcu; it < DEPTH * 96; it += F.G) {
            const int l = it / 96, n0 = (it % 96) * 128;
            float acc[9][2];
#pragma unroll
            for (int r = 0; r < 9; ++r) { acc[r][0] = 0.f; acc[r][1] = 0.f; }
            for (int kb = 0; kb < 4; ++kb) {
                const int k0 = 256 * F.wave + 64 * kb;
                float sv[9];
#pragma unroll
                for (int r = 0; r < 8; ++r) sv[r] = silu_f(F.c[r * D + k0 + lane]);
                sv[8] = silu_f(F.c_ctx[k0 + lane]);
                const float* wp = F.w_ada + ((size_t)l * D + k0) * (6 * D) + n0 + 2 * lane;
#pragma unroll 4
                for (int kk = 0; kk < 64; ++kk) {
                    const f32x2 wv = __builtin_nontemporal_load((const f32x2*)(wp + (size_t)kk * (6 * D)));
#pragma unroll
                    for (int r = 0; r < 9; ++r) { const float s = __builtin_bit_cast(float, __builtin_amdgcn_readlane(__builtin_bit_cast(int, sv[r]), kk)); acc[r][0] += s * wv.x; acc[r][1] += s * wv.y; }
                }
            }
#pragma unroll
            for (int r = 0; r < 9; ++r) { red[(F.wave * 9 + r) * 128 + 2 * lane] = acc[r][0]; red[(F.wave * 9 + r) * 128 + 2 * lane + 1] = acc[r][1]; }
            __syncthreads();
            for (int o = F.tid; o < 9 * 128; o += NTHR) { const int r = o >> 7, col = o & 127; float s = 0.f;
#pragma unroll
                for (int w = 0; w < 8; ++w) s += red[(w * 9 + r) * 128 + col];
                W_MOD(F)[((size_t)l * 9 + r) * (6 * D) + n0 + col] = s + F.b_ada[(size_t)l * 6 * D + n0 + col]; }
            __syncthreads();
        }
    }
    {
        const int gid = (F.vcu * NTHR + F.tid);
        if (gid < 64 * 32) {
            const int pos = gid >> 5, f = gid & 31;
            double inv = 1.0; for (int i = 0; i < f; ++i) inv *= 0.74989420933245582730;
            const double xa = (double)pos * inv;
            const double q = __builtin_rint(xa * 0.63661977236758134308);
            double y = __builtin_fma(-q, 1.57079632679489655800, xa); y = __builtin_fma(-q, 6.12323399573676603587e-17, y);
            const double y2 = y * y;
            double sn = -1.0 / 1307674368000.0; sn = sn * y2 + 1.0 / 6227020800.0; sn = sn * y2 - 1.0 / 39916800.0; sn = sn * y2 + 1.0 / 362880.0; sn = sn * y2 - 1.0 / 5040.0; sn = sn * y2 + 1.0 / 120.0; sn = sn * y2 - 1.0 / 6.0; sn = sn * y2 + 1.0; sn *= y;
            double cs = 1.0 / 20922789888000.0; cs = cs * y2 - 1.0 / 87178291200.0; cs = cs * y2 + 1.0 / 479001600.0; cs = cs * y2 - 1.0 / 3628800.0; cs = cs * y2 + 1.0 / 40320.0; cs = cs * y2 - 1.0 / 720.0; cs = cs * y2 + 1.0 / 24.0; cs = cs * y2 - 0.5; cs = cs * y2 + 1.0;
            const int qi = ((int)q) & 3;
            const double c2 = (qi == 0) ? cs : (qi == 1) ? -sn : (qi == 2) ? -cs : sn;
            const double s2 = (qi == 0) ? sn : (qi == 1) ? cs : (qi == 2) ? -sn : -cs;
            W_ROPE(F)[gid] = (float)c2; W_ROPE(F)[2048 + gid] = (float)s2;
        }
    }
    {
        const int per = (NU - N_IN) * D / 16;
        for (int i = F.vcu * NTHR + F.tid; i < DEPTH * per; i += F.G * NTHR) { const int l = i / per, r = i % per;
            *(u32x4*)((signed char*)(F.ws + WS_WIN) + ((size_t)l * NU + N_IN) * D + (size_t)r * 16) = (u32x4){0u, 0u, 0u, 0u}; }
        for (int i = F.vcu * NTHR + F.tid; i < DEPTH * (NU - N_IN); i += F.G * NTHR) W_SIN(F)[(size_t)(i / (NU - N_IN)) * NU + N_IN + i % (NU - N_IN)] = 1.0f;
    }
    for (int rep1 = 0; rep1 < 1 + (int)((MK_REPP0 >> 1) & 1u); ++rep1) {
        LAS float* scr = (LAS float*)(F.lds + F.wave * 16640);
        constexpr int I_OUT = 32 * 32;
        for (int it = gw; it < DEPTH * I_OUT; it += NGW) {
            const int l = it / I_OUT, r = it % I_OUT;
            transpose_item(F.w_out + (size_t)l * D * D, D, (r >> 5) * 64, (r & 31) * 64, W_WOUT(F) + (size_t)l * D * D, 0, scr, lane);
        }
    }
    __syncthreads();
    for (int it = F.G - 1 - F.vcu; it < IN_ITEMS; it += F.G) strip_item(F, it);
    if (MK_REPP0 & 4u) { for (int it = F.vcu; it < BG_TOTAL; it += F.G) strip_item(F, it); }
    __syncthreads();
}

__device__ __forceinline__ void prenorm_row(Frame& F, int l, int m, const float (&xv)[32], int row) {
    const float r = 1.0f / sqrtf(row_sumsq(xv) * (1.0f / D) + EPS);
    const float* g = F.g_pre_mix + (size_t)l * D; const float* mod = W_MOD(F) + ((size_t)l * 9 + m) * (6 * D);
    float gv[32], shv[32], scv[32], hv[32];
    row_load_f32(g, F.lane, gv); row_load_f32(mod, F.lane, shv); row_load_f32(mod + D, F.lane, scv);
#pragma unroll
    for (int i = 0; i < 32; ++i) hv[i] = xv[i] * r * gv[i] * (1.0f + scv[i]) + shv[i];
    float am = 0.f;
#pragma unroll
    for (int i = 0; i < 32; ++i) am = fmaxf(am, fabsf(hv[i]));
    am = wave_max(am);
    const float scale = am > 0.f ? am * (1.0f / 127.0f) : 1.0f;
    row_store_i8(W_HQ(F) + (size_t)row * D, F.lane, hv, 1.0f / scale);
    if (F.lane == 0) W_HS(F)[row] = scale;
}
__device__ __forceinline__ void prenorm_row_cv(Frame& F, int l, int m, const float (&xv)[32], int row) {
    const bf16* cv = W_CV(F) + ((size_t)l * 9 + m) * 6 * D;
    float c4[32], c5[32], hv[32];
    row_load_bf16(cv + 4 * D, F.lane, c4); row_load_bf16(cv + 5 * D, F.lane, c5);
    const float r = 1.0f / sqrtf(row_sumsq(xv) * (1.0f / D) + EPS);
#pragma unroll
    for (int i = 0; i < 32; ++i) hv[i] = xv[i] * r * c4[i] + c5[i];
    float am = 0.f;
#pragma unroll
    for (int i = 0; i < 32; ++i) am = fmaxf(am, fabsf(hv[i]));
    am = wave_max(am);
    const float scale = am > 0.f ? am * (1.0f / 127.0f) : 1.0f;
    row_store_i8(W_HQ(F) + (size_t)row * D, F.lane, hv, 1.0f / scale);
    if (F.lane == 0) W_HS(F)[row] = scale;
}
__device__ __forceinline__ void p0b(Frame& F) {
    const int gw = F.vcu * NWAVES + F.wave, NGW = F.G * NWAVES;
    for (int i = F.vcu * NTHR + F.tid; i < DEPTH * 9 * (D / 8); i += F.G * NTHR) {
        const int lm = i / (D / 8), k0 = (i % (D / 8)) * 8, l = lm / 9; const float* mod = W_MOD(F) + (size_t)lm * (6 * D);
        bf16* cv = W_CV(F) + (size_t)lm * 6 * D + k0;
        float o[6][8];
#pragma unroll
        for (int e = 0; e < 8; ++e) { const int k = k0 + e;
            o[0][e] = mod[2 * D + k] * F.g_post_mix[(size_t)l * D + k]; o[1][e] = F.g_pre_ffn[(size_t)l * D + k] * (1.0f + mod[4 * D + k]); o[2][e] = mod[3 * D + k];
            o[3][e] = mod[5 * D + k] * F.g_post_ffn[(size_t)l * D + k]; o[4][e] = F.g_pre_mix[(size_t)l * D + k] * (1.0f + mod[D + k]); o[5][e] = mod[k]; }
#pragma unroll
        for (int v = 0; v < 6; ++v) { u32x4 w; w.x = pk2(o[v][0], o[v][1]); w.y = pk2(o[v][2], o[v][3]); w.z = pk2(o[v][4], o[v][5]); w.w = pk2(o[v][6], o[v][7]); *(u32x4*)(cv + (size_t)v * D) = w; }
    }
    for (int row = gw; row < NROW; row += 2 * NGW) {
        const int row2 = (row + NGW < NROW) ? row + NGW : row;
        const float* xp = row < NLAT ? F.x + (size_t)row * D : F.ctx + (size_t)(row - NLAT) * D; const int m = row < NLAT ? row / SEQ : 8;
        const float* xp2 = row2 < NLAT ? F.x + (size_t)row2 * D : F.ctx + (size_t)(row2 - NLAT) * D; const int m2 = row2 < NLAT ? row2 / SEQ : 8;
        float xv[32], xv2[32]; row_load_f32_nt(xp, F.lane, xv); row_load_f32_nt(xp2, F.lane, xv2);
        prenorm_row(F, 0, m, xv, row);
        prenorm_row(F, 0, m2, xv2, row2);
    }
}

#define MFMA16(a, b, c) __builtin_amdgcn_mfma_f32_16x16x32_bf16((a), (b), (c), 0, 0, 0)
typedef short s16x4 __attribute__((ext_vector_type(4)));
#define ATT_TR(p) __builtin_bit_cast(u32x2, __builtin_amdgcn_ds_read_tr16_b64_v4i16((LAS s16x4*)(p)))
__device__ __forceinline__ bf16x8 mk8(u32x2 lo, u32x2 hi) { u32x4 t; t.x = lo.x; t.y = lo.y; t.z = hi.x; t.w = hi.y; return __builtin_bit_cast(bf16x8, t); }
#define GLA_POS(i) (dir ? (nseg - 1 - (64 * cc + (i))) : (64 * cc + (i)))
struct PpIdx { int dir, h, cc, nseg, rowbase; bool lat; };
__device__ __forceinline__ PpIdx pp_idx(int un) { PpIdx I; const int cidx = un % 36, bhd = un / 36; I.dir = bhd & 1; I.h = (bhd >> 1) & 3; const int b = bhd >> 3; I.lat = cidx >= 4; I.cc = I.lat ? cidx - 4 : cidx; I.nseg = I.lat ? SEQ : CTXL; I.rowbase = I.lat ? b * SEQ : NLAT + b * CTXL; return I; }
#define PP_POS(I, i) ((I).dir ? ((I).nseg - 1 - (64 * (I).cc + (i))) : (64 * (I).cc + (i)))
struct PpRegs { u32x4 dec[4]; u32x4 vr[4]; unsigned short qraw[16], kraw[16]; float wd[8]; float bd; };
__device__ __forceinline__ void pp_load_v(Frame& F, int un, PpRegs& R) {
    const PpIdx I = pp_idx(un); const int tid = F.tid; const bf16* U = W_U(F);
    { const int c15 = tid & 15, g1 = (tid >> 4) & 1;
#pragma unroll
      for (int it = 0; it < 4; ++it) R.dec[it] = *(const u32x4*)(U + (size_t)(I.rowbase + PP_POS(I, 16 * it + c15)) * NU + U_DEC + I.dir * 16 + 8 * g1); }
    { const int j = tid >> 3, c8 = (tid & 7) * 8;
      const bf16* vp = U + (size_t)(I.rowbase + PP_POS(I, j)) * NU + U_VB + I.h * 256 + c8;
#pragma unroll
      for (int q = 0; q < 4; ++q) R.vr[q] = *(const u32x4*)(vp + 64 * q); }
}
__device__ __forceinline__ void pp_load_w(Frame& F, int l, int un, PpRegs& R) {
    const PpIdx I = pp_idx(un); const int ch = I.h * 128 + 16 * F.wave + (F.tid & 15), g1 = (F.tid >> 4) & 1;
#pragma unroll
    for (int r = 0; r < 8; ++r) R.wd[r] = F.w_dec[(((size_t)l * 2 + I.dir) * DECR + 8 * g1 + r) * 512 + ch];
    R.bd = F.b_dec[((size_t)l * 2 + I.dir) * 512 + ch];
}
__device__ __forceinline__ void pp_load_qk(Frame& F, int un, PpRegs& R) {
    const PpIdx I = pp_idx(un); const int k = F.tid & 127, ip = F.tid >> 7; const bf16* U = W_U(F);
#pragma unroll
    for (int ii = 0; ii < 16; ++ii) { const bf16* rp = U + (size_t)(I.rowbase + PP_POS(I, 16 * ip + ii)) * NU; R.qraw[ii] = rp[U_QB + I.h * 128 + k]; R.kraw[ii] = rp[U_KB + I.h * 128 + k]; }
}
__device__ __forceinline__ void gla_prepass(Frame& F, int l, int un, int unx, PpRegs& R) {
    const int cidx = un % 36, bhd = un / 36, dir = bhd & 1, h = (bhd >> 1) & 3, b = bhd >> 3;
    const int tid = F.tid, lane = F.lane, w = F.wave, c15 = lane & 15, g = lane >> 4;
    LAS unsigned char* L = F.lds;
    LAS bf16* Qt = (LAS bf16*)(L);
    LAS bf16* Kt = (LAS bf16*)(L + 20480);
    LAS bf16* VT = (LAS bf16*)(L + 40960);
    LAS float* PS = (LAS float*)(L + 75776);
    LAS float* ZL = (LAS float*)(L + 77824);
    LAS bf16* Kh = (LAS bf16*)(L + 111616);
    const bool lat = cidx >= 4; const int cc = lat ? cidx - 4 : cidx, nseg = lat ? SEQ : CTXL, rowbase = lat ? b * SEQ : NLAT + b * CTXL;
    const bool need_out = lat || (l == 0);
    const int k = tid & 127, ip = tid >> 7;
    bf16* GQ = (bf16*)(F.ws + WS_GQ) + (size_t)un * 8192; bf16* GK = (bf16*)(F.ws + WS_GK) + (size_t)un * 8192; float* GD = (float*)(F.ws + WS_GD) + (size_t)un * 128;
    float rcs[16], rsn[16];
    { const float* COS = W_ROPE(F); const float* SIN = COS + 2048;
#pragma unroll
      for (int ii = 0; ii < 16; ++ii) { const int pos = GLA_POS(16 * ip + ii), pp = (k < 64) ? (pos >> 6) : (pos & 63); rcs[ii] = COS[pp * 32 + (k & 31)]; rsn[ii] = SIN[pp * 32 + (k & 31)]; } }
    {
        const int j = tid >> 3, c8 = (tid & 7) * 8;
#pragma unroll
        for (int q = 0; q < 4; ++q) *(LAS u32x4*)(VT + j * 272 + 64 * q + c8) = R.vr[q];
    }
    {
        u32x4 bw;
        { float ws_[8];
#pragma unroll
          for (int j = 0; j < 8; ++j) { const float wv = R.wd[j]; const float hj = bflo(pk2(wv, wv)); ws_[j] = (g >= 2) ? wv - hj : wv; }
          bw.x = pk2(ws_[0], ws_[1]); bw.y = pk2(ws_[2], ws_[3]); bw.z = pk2(ws_[4], ws_[5]); bw.w = pk2(ws_[6], ws_[7]); }
        const bf16x8 bop = __builtin_bit_cast(bf16x8, bw); const float bdv = R.bd;
#pragma unroll
        for (int it = 0; it < 4; ++it) {
            const f32x4 z4 = MFMA16(__builtin_bit_cast(bf16x8, R.dec[it]), bop, ((f32x4){bdv, bdv, bdv, bdv}));
#pragma unroll
            for (int rg = 0; rg < 4; ++rg) { const float z = z4[rg];
                const float e = __builtin_amdgcn_exp2f(fabsf(z) * -1.4426950408889634f);
                ZL[(16 * it + 4 * g + rg) * 132 + 16 * w + c15] = (fminf(z, 0.0f) * 1.4426950408889634f - __builtin_amdgcn_logf(1.0f + e)) * (1.0f / 16.0f); }
        }
    }
    asm volatile("" ::: "memory");
    pp_load_v(F, unx, R);
    pp_load_w(F, l, unx, R);
    LBAR();
    float bloc[16]; float run = 0.f;
#pragma unroll
    for (int ii = 0; ii < 16; ++ii) { run += ZL[(16 * ip + ii) * 132 + k]; bloc[ii] = run; }
    PS[ip * 128 + k] = run;
    LBAR();
    {
        float off = 0.f, btot = 0.f;
#pragma unroll
        for (int p = 0; p < 4; ++p) { const float s = PS[p * 128 + k]; btot += s; if (p < ip) off += s; }
        const float etot = __builtin_amdgcn_exp2f(btot);
        if (ip == 0) GD[k] = etot;
        float qs_[16], kt_[16];
        float qpart[16], kpart[16];
        if (lat) {
#pragma unroll
            for (int ii = 0; ii < 16; ++ii) { qpart[ii] = __shfl_xor(bf2f(R.qraw[ii]), 32); kpart[ii] = __shfl_xor(bf2f(R.kraw[ii]), 32); }
            asm volatile("" ::: "memory");
        }
#pragma unroll
        for (int ii = 0; ii < 16; ++ii) {
            const int i = 16 * ip + ii; const float bb = bloc[ii] + off;
            float qv = bf2f(R.qraw[ii]), kv = bf2f(R.kraw[ii]);
            if (lat) {
                const float cs = rcs[ii], sn = rsn[ii];
                const float qo = qpart[ii], ko = kpart[ii];
                qv = qv * cs + ((k & 32) ? qo : -qo) * sn; kv = kv * cs + ((k & 32) ? ko : -ko) * sn;
            }
            const float eb = __builtin_amdgcn_exp2f(bb), kt = kv * __builtin_amdgcn_rcpf(eb);
            qs_[ii] = qv * 0.08838834764831845f * eb; kt_[ii] = kt;
        }
        u32x4 q0, q1, t0, t1, w0, w1;
        q0.x = pk2(qs_[0], qs_[1]); q0.y = pk2(qs_[2], qs_[3]); q0.z = pk2(qs_[4], qs_[5]); q0.w = pk2(qs_[6], qs_[7]); q1.x = pk2(qs_[8], qs_[9]); q1.y = pk2(qs_[10], qs_[11]); q1.z = pk2(qs_[12], qs_[13]); q1.w = pk2(qs_[14], qs_[15]);
        t0.x = pk2(kt_[0], kt_[1]); t0.y = pk2(kt_[2], kt_[3]); t0.z = pk2(kt_[4], kt_[5]); t0.w = pk2(kt_[6], kt_[7]); t1.x = pk2(kt_[8], kt_[9]); t1.y = pk2(kt_[10], kt_[11]); t1.z = pk2(kt_[12], kt_[13]); t1.w = pk2(kt_[14], kt_[15]);
        w0.x = pk2(kt_[0] * etot, kt_[1] * etot); w0.y = pk2(kt_[2] * etot, kt_[3] * etot); w0.z = pk2(kt_[4] * etot, kt_[5] * etot); w0.w = pk2(kt_[6] * etot, kt_[7] * etot);
        w1.x = pk2(kt_[8] * etot, kt_[9] * etot); w1.y = pk2(kt_[10] * etot, kt_[11] * etot); w1.z = pk2(kt_[12] * etot, kt_[13] * etot); w1.w = pk2(kt_[14] * etot, kt_[15] * etot);
        *(LAS u32x4*)(Qt + k * 80 + 16 * ip) = q0; *(LAS u32x4*)(Qt + k * 80 + 16 * ip + 8) = q1;
        *(LAS u32x4*)(Kt + k * 80 + 16 * ip) = t0; *(LAS u32x4*)(Kt + k * 80 + 16 * ip + 8) = t1;
        *(LAS u32x4*)(Kh + k * 80 + 16 * ip) = w0; *(LAS u32x4*)(Kh + k * 80 + 16 * ip + 8) = w1;
    }
    asm volatile("" ::: "memory");
    pp_load_qk(F, unx, R);
    LBAR();
    {
#pragma unroll
        for (int q = 0; q < 2; ++q) { const int p = tid + 512 * q; *(u32x4*)(GK + p * 8) = *(const LAS u32x4*)(Kh + (p >> 3) * 80 + (p & 7) * 8); }
    }
    if (need_out) {
        {
#pragma unroll
            for (int q = 0; q < 2; ++q) { const int p = tid + 512 * q; *(u32x4*)(GQ + p * 8) = *(const LAS u32x4*)(Qt + (p >> 3) * 80 + (p & 7) * 8); }
        }
        const int ib = w & 3, vh = w >> 2;
        const int trr = (4 * g + (c15 >> 2)) * 80 + 4 * (c15 & 3);
        bf16x8 qf[4];
#pragma unroll
        for (int ks = 0; ks < 4; ++ks) { const LAS bf16* qp = Qt + 32 * ks * 80 + trr + 16 * ib; qf[ks] = mk8(ATT_TR(qp), ATT_TR(qp + 16 * 80)); }
        f32x4 at[4];
#pragma unroll
        for (int jb = 0; jb < 4; ++jb) { at[jb] = (f32x4){0.f, 0.f, 0.f, 0.f};
#pragma unroll
            for (int ks = 0; ks < 4; ++ks) { const LAS bf16* kp = Kt + 32 * ks * 80 + trr + 16 * jb; const bf16x8 a = mk8(ATT_TR(kp), ATT_TR(kp + 16 * 80)); at[jb] = MFMA16(a, qf[ks], at[jb]); }
#pragma unroll
            for (int rg = 0; rg < 4; ++rg) if (16 * jb + 4 * g + rg > 16 * ib + c15) at[jb][rg] = 0.f; }
        bf16x8 pf[2];
#pragma unroll
        for (int k2 = 0; k2 < 2; ++k2) { u32x4 t; t.x = pk2(at[2 * k2][0], at[2 * k2][1]); t.y = pk2(at[2 * k2][2], at[2 * k2][3]); t.z = pk2(at[2 * k2 + 1][0], at[2 * k2 + 1][1]); t.w = pk2(at[2 * k2 + 1][2], at[2 * k2 + 1][3]); pf[k2] = __builtin_bit_cast(bf16x8, t); }
        bf16* op = W_OB(F) + ((size_t)dir * NROW + rowbase + GLA_POS(16 * ib + c15)) * (HB * DVB) + h * 256 + 4 * g;
#pragma unroll
        for (int vt = 0; vt < 8; ++vt) { const int vtile = 8 * vh + vt; f32x4 o = (f32x4){0.f, 0.f, 0.f, 0.f};
#pragma unroll
            for (int k2 = 0; k2 < 2; ++k2) { const LAS bf16* vp = VT + (32 * k2 + 4 * g + (c15 >> 2)) * 272 + 16 * vtile + 4 * (c15 & 3); o = MFMA16(mk8(ATT_TR(vp), ATT_TR(vp + 16 * 272)), pf[k2], o); }
            u32x2 ov; ov.x = pk2(o[0], o[1]); ov.y = pk2(o[2], o[3]);
            *(u32x2*)(op + 16 * vtile) = ov; }
    }
    LBAR();
}
struct ChRegs { u32x4 rq[2], rk[2], rv; u32x2 oi[2]; };
__device__ __forceinline__ void gla_chain(Frame& F, int l, int ch, bool dry) {
    const int b = ch >> 5, h = (ch >> 3) & 3, dir = (ch >> 2) & 1, vs = ch & 3;
    const int tid = F.tid, lane = F.lane, w = F.wave, c15 = lane & 15, g = lane >> 4;
    LAS unsigned char* L = F.lds;
    constexpr int BUFB = 46080;
    LAS float* DKall = (LAS float*)(L + 2 * BUFB + 32768);
    LAS unsigned char* PART = L + 2 * BUFB;
    const int un0 = (((b * 4 + h) * 2) + dir) * 36;
    const bf16* GQ = (const bf16*)(F.ws + WS_GQ) + (size_t)un0 * 8192; const bf16* GK = (const bf16*)(F.ws + WS_GK) + (size_t)un0 * 8192;
    const bf16* UV = W_U(F) + U_VB + h * 256 + vs * 64 + (tid & 7) * 8; const float* GD = (const float*)(F.ws + WS_GD) + (size_t)un0 * 128;
    const int vt4 = w & 3, kq = w >> 2;
    bf16* OBd = W_OB(F) + (size_t)dir * NROW * (HB * DVB) + h * 256 + vs * 64 + 16 * vt4 + 4 * g;
    bf16* OBs = dry ? (bf16*)(F.ws + WS_DUMMY) + (size_t)dir * NROW * (HB * DVB) + h * 256 + vs * 64 + 16 * vt4 + 4 * g : OBd;
    f32x4 sacc[4];
#pragma unroll
    for (int t = 0; t < 4; ++t) sacc[t] = (f32x4){0.f, 0.f, 0.f, 0.f};
    for (int i = tid; i < 36 * 128; i += NTHR) DKall[i] = GD[i];
#define CH_ROWP(c, p) (((c) >= 4 ? b * SEQ : NLAT + b * CTXL) + (dir ? (((c) >= 4 ? SEQ : CTXL) - 1 - (64 * ((c) >= 4 ? (c) - 4 : (c)) + (p))) : (64 * ((c) >= 4 ? (c) - 4 : (c)) + (p))))
#define CH_OROW(c, it) CH_ROWP(c, 16 * (it) + c15)
#define CH_LOAD(R, c) do { const bool no_ = (c) >= 4 || l == 0; \
        _Pragma("unroll") for (int q_ = 0; q_ < 2; ++q_) { const int p_ = tid + 512 * q_; if (no_) R.rq[q_] = *(const u32x4*)(GQ + (size_t)(c) * 8192 + p_ * 8); R.rk[q_] = *(const u32x4*)(GK + (size_t)(c) * 8192 + p_ * 8); } \
        R.rv = *(const u32x4*)(UV + (size_t)CH_ROWP(c, tid >> 3) * NU);                                   \
        if (no_) { R.oi[0] = *(const u32x2*)(OBd + (size_t)CH_OROW(c, 2 * kq) * (HB * DVB)); R.oi[1] = *(const u32x2*)(OBd + (size_t)CH_OROW(c, 2 * kq + 1) * (HB * DVB)); } } while (0)
#define CH_PUT(R, bs) do { LAS unsigned char* B_ = L + (bs) * BUFB; \
        _Pragma("unroll") for (int q_ = 0; q_ < 2; ++q_) { const int p_ = tid + 512 * q_; *(LAS u32x4*)((LAS bf16*)B_ + (p_ >> 3) * 72 + (p_ & 7) * 8) = R.rq[q_]; *(LAS u32x4*)((LAS bf16*)(B_ + 18432) + (p_ >> 3) * 72 + (p_ & 7) * 8) = R.rk[q_]; } \
        *(LAS u32x4*)((LAS bf16*)(B_ + 36864) + (tid >> 3) * 72 + (tid & 7) * 8) = R.rv; } while (0)
#define CH_FIN(cp, par) do { \
        const f32x4 pp0_ = *(const LAS f32x4*)(PART + (par) * 16384 + ((w ^ 4) * 2 + 0) * 1024 + lane * 16), pp1_ = *(const LAS f32x4*)(PART + (par) * 16384 + ((w ^ 4) * 2 + 1) * 1024 + lane * 16); \
        { const f32x4 o = pown[0] + pp0_; u32x2 ov; ov.x = pk2(o[0] + bflo(poi[0].x), o[1] + bfhi(poi[0].x)); ov.y = pk2(o[2] + bflo(poi[0].y), o[3] + bfhi(poi[0].y)); *(u32x2*)(OBs + (size_t)CH_OROW(cp, 2 * kq) * (HB * DVB)) = ov; } \
        { const f32x4 o = pown[1] + pp1_; u32x2 ov; ov.x = pk2(o[0] + bflo(poi[1].x), o[1] + bfhi(poi[1].x)); ov.y = pk2(o[2] + bflo(poi[1].y), o[3] + bfhi(poi[1].y)); *(u32x2*)(OBs + (size_t)CH_OROW(cp, 2 * kq + 1) * (HB * DVB)) = ov; } } while (0)
#define CH_STEP(cidx, RC, RN) do { \
        const bool need_out_ = (cidx) >= 4 || l == 0; const int bs_ = (cidx) & 1; \
        LAS unsigned char* B = L + bs_ * BUFB; \
        const LAS bf16* Qt = (const LAS bf16*)B; const LAS bf16* KhT = (const LAS bf16*)(B + 18432); const LAS bf16* VTs = (const LAS bf16*)(B + 36864); const LAS float* Dk = DKall + (cidx) * 128; \
        if (pend) CH_FIN((cidx) - 1, bs_ ^ 1);                                \
        const u32x2 oi0_ = RC.oi[0], oi1_ = RC.oi[1];                       \
        if ((cidx) + 2 < 36) CH_LOAD(RC, (cidx) + 2);                         \
        if (need_out_) {                                                      \
            bf16x8 sop[2], qop[4][2]; \
            _Pragma("unroll") for (int k2 = 0; k2 < 2; ++k2) { u32x4 t_; t_.x = pk2(sacc[2 * k2][0], sacc[2 * k2][1]); t_.y = pk2(sacc[2 * k2][2], sacc[2 * k2][3]); t_.z = pk2(sacc[2 * k2 + 1][0], sacc[2 * k2 + 1][1]); t_.w = pk2(sacc[2 * k2 + 1][2], sacc[2 * k2 + 1][3]); sop[k2] = __builtin_bit_cast(bf16x8, t_); } \
            _Pragma("unroll") for (int x4 = 0; x4 < 4; ++x4) { const int it_ = (x4 < 2) ? 2 * kq + x4 : 2 * (1 - kq) + (x4 - 2);     \
                _Pragma("unroll") for (int k2 = 0; k2 < 2; ++k2) { const LAS bf16* qp_ = Qt + (16 * (4 * kq + 2 * k2) + 4 * g + (c15 >> 2)) * 72 + 16 * it_ + 4 * (c15 & 3); qop[x4][k2] = mk8(ATT_TR(qp_), ATT_TR(qp_ + 16 * 72)); } } \
            asm volatile("" ::: "memory"); \
            f32x4 pa_[4]; \
            _Pragma("unroll") for (int x4 = 0; x4 < 4; ++x4) { pa_[x4] = MFMA16(sop[0], qop[x4][0], ((f32x4){0.f, 0.f, 0.f, 0.f})); pa_[x4] = MFMA16(sop[1], qop[x4][1], pa_[x4]); } \
            pown[0] = pa_[0]; pown[1] = pa_[1]; \
            *(LAS f32x4*)(PART + bs_ * 16384 + (w * 2 + 0) * 1024 + lane * 16) = pa_[2]; *(LAS f32x4*)(PART + bs_ * 16384 + (w * 2 + 1) * 1024 + lane * 16) = pa_[3]; \
        } \
        poi[0] = oi0_; poi[1] = oi1_; pend = need_out_; \
        { bf16x8 va[2], kb[4][2]; f32x4 dk[4]; \
        _Pragma("unroll") for (int k2 = 0; k2 < 2; ++k2) { const LAS bf16* vp_ = VTs + (32 * k2 + 8 * g + (c15 >> 2)) * 72 + 16 * vt4 + 4 * (c15 & 3); va[k2] = mk8(ATT_TR(vp_), ATT_TR(vp_ + 4 * 72)); }     \
        _Pragma("unroll") for (int t4 = 0; t4 < 4; ++t4) { dk[t4] = *(const LAS f32x4*)(Dk + 16 * (4 * kq + t4) + 4 * g); _Pragma("unroll") for (int k2 = 0; k2 < 2; ++k2) kb[t4][k2] = *(const LAS bf16x8*)(KhT + (16 * (4 * kq + t4) + c15) * 72 + 32 * k2 + 8 * g); } \
        asm volatile("" ::: "memory"); \
        _Pragma("unroll") for (int t4 = 0; t4 < 4; ++t4) { \
            sacc[t4] = sacc[t4] * dk[t4]; \
            _Pragma("unroll") for (int k2 = 0; k2 < 2; ++k2) sacc[t4] = MFMA16(kb[t4][k2], va[k2], sacc[t4]); } } \
        if ((cidx) + 1 < 36) CH_PUT(RN, bs_ ^ 1);                             \
        LBAR(); \
    } while (0)
    ChRegs RA, RB;
    RA.rq[0] = RA.rq[1] = RB.rq[0] = RB.rq[1] = (u32x4){0u, 0u, 0u, 0u}; RA.oi[0] = RA.oi[1] = RB.oi[0] = RB.oi[1] = (u32x2){0u, 0u};
    f32x4 pown[2]; u32x2 poi[2]; bool pend = false;
    pown[0] = pown[1] = (f32x4){0.f, 0.f, 0.f, 0.f}; poi[0] = poi[1] = (u32x2){0u, 0u};
    CH_LOAD(RA, 0); CH_PUT(RA, 0); CH_LOAD(RB, 1);
    LBAR();
    for (int c2 = 0; c2 < 36; c2 += 2) {
        CH_STEP(c2, RA, RB);
        CH_STEP(c2 + 1, RB, RA);
    }
    if (pend) CH_FIN(35, 1);
#undef CH_LOAD
#undef CH_PUT
#undef CH_FIN
#undef CH_STEP
#undef CH_OROW
#undef CH_ROWP
}
#undef GLA_POS

__device__ __forceinline__ int clampi(int v, int lo, int hi) { return v < lo ? lo : (v > hi ? hi : v); }
template <int NB, bool LOCAL>
__device__ __forceinline__ void attn_tile(const LAS bf16* Kt, const LAS bf16* Vt, const LAS float* bias_row, const bf16x8 (&qf)[2], int kb0, const int (&dco)[8], int c15, int g, float& m_run, float& l_run, f32x4 (&oacc)[4]) {
    f32x4 sc[NB];
    {
        bf16x8 kf[NB][2]; float bv[NB][4];
#pragma unroll
        for (int nb = 0; nb < NB; ++nb) {
#pragma unroll
            for (int s = 0; s < 2; ++s) kf[nb][s] = *(const LAS bf16x8*)(Kt + (kb0 + 16 * nb + c15) * 72 + 32 * s + 8 * g);
            if (LOCAL) {
#pragma unroll
                for (int rg = 0; rg < 4; ++rg) bv[nb][rg] = bias_row[dco[(4 * nb + rg) & 7]]; } }
        asm volatile("" ::: "memory");
#pragma unroll
        for (int nb = 0; nb < NB; ++nb) { sc[nb] = (f32x4){0.f, 0.f, 0.f, 0.f};
#pragma unroll
            for (int s = 0; s < 2; ++s) sc[nb] = MFMA16(kf[nb][s], qf[s], sc[nb]);
#pragma unroll
            for (int rg = 0; rg < 4; ++rg) sc[nb][rg] = sc[nb][rg] * 0.18033688011112042f + (LOCAL ? bv[nb][rg] : 0.f); }
    }
    float mt = -1e30f;
#pragma unroll
    for (int nb = 0; nb < NB; ++nb)
#pragma unroll
        for (int rg = 0; rg < 4; ++rg) mt = fmaxf(mt, sc[nb][rg]);
    mt = fmaxf(mt, __shfl_xor(mt, 16)); mt = fmaxf(mt, __shfl_xor(mt, 32));
    const float m_new = fmaxf(m_run, mt), alpha = __builtin_amdgcn_exp2f(m_run - m_new);
    m_run = m_new; float ps = 0.f;
#pragma unroll
    for (int nb = 0; nb < NB; ++nb)
#pragma unroll
        for (int rg = 0; rg < 4; ++rg) { const float p = __builtin_amdgcn_exp2f(sc[nb][rg] - m_new); sc[nb][rg] = p; ps += p; }
    l_run = l_run * alpha + ps;
    bf16x8 pf[NB / 2];
#pragma unroll
    for (int k2 = 0; k2 < NB / 2; ++k2) { u32x4 tt; tt.x = pk2(sc[2 * k2][0], sc[2 * k2][1]); tt.y = pk2(sc[2 * k2][2], sc[2 * k2][3]); tt.z = pk2(sc[2 * k2 + 1][0], sc[2 * k2 + 1][1]); tt.w = pk2(sc[2 * k2 + 1][2], sc[2 * k2 + 1][3]); pf[k2] = __builtin_bit_cast(bf16x8, tt); }
    {
        bf16x8 vf[4][NB / 2];
#pragma unroll
        for (int d = 0; d < 4; ++d)
#pragma unroll
            for (int k2 = 0; k2 < NB / 2; ++k2) { const LAS bf16* vp = Vt + (kb0 + 32 * k2 + 4 * g + (c15 >> 2)) * 80 + 16 * d + 4 * (c15 & 3);
                vf[d][k2] = mk8(ATT_TR(vp), ATT_TR(vp + 16 * 80)); }
        asm volatile("" ::: "memory");
#pragma unroll
        for (int d = 0; d < 4; ++d) { oacc[d] = oacc[d] * alpha;
#pragma unroll
            for (int k2 = 0; k2 < NB / 2; ++k2) oacc[d] = MFMA16(vf[d][k2], pf[k2], oacc[d]); }
    }
}
__device__ __forceinline__ void attn_unit(Frame& F, int l, int u) {
    const int tid = F.tid, lane = F.lane, w = F.wave, c15 = lane & 15, g = lane >> 4;
    LAS unsigned char* L = F.lds;
    LAS bf16* Ks = (LAS bf16*)L;
    LAS bf16* VTs = (LAS bf16*)(L + 18432);
    LAS float* rpbs = (LAS float*)(L + 38912);
    const bool isctx = u >= 1024;
    int b, h, r0 = 0, qb = 0;
    if (!isctx) { b = u >> 7; h = (u >> 4) & 7; r0 = (u & 15) * 2; } else { const int cu = u - 1024; b = cu >> 4; h = (cu >> 1) & 7; qb = cu & 1; }
    const int r = r0 + (w >> 2), cq = 16 * (w & 3) + c15;
    const int qrow = isctx ? NLAT + b * CTXL + qb * 128 + 16 * w + c15 : b * SEQ + r * 64 + cq;
    bf16x8 qf[2];
#pragma unroll
    for (int s = 0; s < 2; ++s) qf[s] = *(const bf16x8*)(W_U(F) + (size_t)qrow * NU + U_QA + h * 64 + 32 * s + 8 * g);
    int lo = 0, nloc = 0, rs = 0;
    if (!isctx) { lo = clampi(r0 - 4, 0, 24); nloc = clampi(r0 - 3, 0, 24) + 8 - lo; rs = clampi(r - 4, 0, 24); }
    const int ntiles = nloc + 4, cs0 = clampi(cq - 8, 0, 48), kb0 = clampi(16 * (w & 3) - 8, 0, 32);
    if (!isctx) for (int i = tid; i < 15 * 32; i += NTHR) { const int rr = i >> 5, cc2 = i & 31; rpbs[i] = cc2 < 31 ? F.rpb[((size_t)l * HA + h) * 465 + rr * 31 + cc2] * 1.4426950408889634f : -1e30f; }
    int dco[8];
#pragma unroll
    for (int e8 = 0; e8 < 8; ++e8) { const int ck = kb0 + 16 * (e8 >> 2) + 4 * g + (e8 & 3); dco[e8] = (ck >= cs0 && ck < cs0 + 16) ? clampi(ck - cq + 15, 0, 30) : 31; }
    const int key = tid >> 3, ch8 = (tid & 7) * 8;
#define ATT_ROW(t) ((t) < nloc ? b * SEQ + (lo + (t)) * 64 + key : NLAT + b * CTXL + ((t) - nloc) * 64 + key)
#define ATT_PUT(KR, VR, buf) do { *(LAS u32x4*)(Ks + (buf) * 4608 + key * 72 + ch8) = KR; *(LAS u32x4*)(VTs + (buf) * 5120 + key * 80 + ch8) = VR; } while (0)
#define ATT_LD(KR, VR, t) do { if ((t) < ntiles) { const bf16* rp_ = W_U(F) + (size_t)ATT_ROW(t) * NU + h * 64 + ch8; KR = *(const u32x4*)(rp_ + U_KA); VR = *(const u32x4*)(rp_ + U_VA); } } while (0)
#define ATT_STEP(t, KN, VN) do { if ((t) < ntiles) { const int buf = (t) & 1; const bool local = (t) < nloc; const int kr = lo + (t); \
        const bool active = !local || (kr >= rs && kr <= rs + 7); \
        if (active) { \
            if (local) attn_tile<2, true>(Ks + buf * 4608, VTs + buf * 5120, rpbs + (kr - r + 7) * 32, qf, kb0, dco, c15, g, m_run, l_run, oacc); \
            else attn_tile<4, false>(Ks + buf * 4608, VTs + buf * 5120, rpbs, qf, 0, dco, c15, g, m_run, l_run, oacc); \
        } \
        if ((t) + 1 < ntiles) ATT_PUT(KN, VN, buf ^ 1); \
        ATT_LD(KN, VN, (t) + 4); \
        LBAR(); } } while (0)
    u32x4 k0 = (u32x4){0u, 0u, 0u, 0u}, v0 = k0, k1 = k0, v1 = k0, k2 = k0, v2 = k0;
    ATT_LD(k0, v0, 0);
    ATT_PUT(k0, v0, 0);
    ATT_LD(k1, v1, 1); ATT_LD(k2, v2, 2); ATT_LD(k0, v0, 3);
    LBAR();
    float m_run = -1e30f, l_run = 0.f;
    f32x4 oacc[4];
#pragma unroll
    for (int d = 0; d < 4; ++d) oacc[d] = (f32x4){0.f, 0.f, 0.f, 0.f};
    for (int t3 = 0; t3 < ntiles; t3 += 3) {
        ATT_STEP(t3, k1, v1);
        ATT_STEP(t3 + 1, k2, v2);
        ATT_STEP(t3 + 2, k0, v0);
    }
#undef ATT_LD
#undef ATT_STEP
    float lt = l_run; lt += __shfl_xor(lt, 16); lt += __shfl_xor(lt, 32);
    const float inv = 1.0f / lt;
#pragma unroll
    for (int d = 0; d < 4; ++d) { u32x2 ov; ov.x = pk2(oacc[d][0] * inv, oacc[d][1] * inv); ov.y = pk2(oacc[d][2] * inv, oacc[d][3] * inv);
        *(u32x2*)(W_MIX(F) + (size_t)qrow * D + MIX_A + h * 64 + 16 * d + 4 * g) = ov; }
#undef ATT_ROW
#undef ATT_PUT
}

__device__ __forceinline__ void gmlp_unit(Frame& F, int l, int u) {
    const int tid = F.tid, lane = F.lane, w = F.wave, c15 = lane & 15, g = lane >> 4;
    LAS bf16* Wl = (LAS bf16*)F.lds;
    LAS bf16* VTl = (LAS bf16*)(F.lds + 34816);
    int rowbase, gg;
    if (u < 512) { const int b = u >> 6, n = (u >> 2) & 15; gg = u & 3; rowbase = b * SEQ + n * MIXC; } else { const int cu = u - 512, b = cu >> 3, n = (cu >> 2) & 1; gg = cu & 3; rowbase = NLAT + b * CTXL + n * MIXC; }
    {
        const int p = tid >> 2, q0 = (tid & 3) * 32; const float* wp = F.w_sp + (((size_t)l * GC + gg) * MIXC + p) * MIXC + q0;
#pragma unroll
        for (int j = 0; j < 4; ++j) { const f32x4 a = *(const f32x4*)(wp + 8 * j), b2 = *(const f32x4*)(wp + 8 * j + 4); u32x4 o; o.x = pk2(a[0], a[1]); o.y = pk2(a[2], a[3]); o.z = pk2(b2[0], b2[1]); o.w = pk2(b2[2], b2[3]); *(LAS u32x4*)(Wl + p * 136 + q0 + 8 * j) = o; }
    }
    {
        const int pos = tid >> 2, c0 = (tid & 3) * 32; const bf16* vp = W_U(F) + (size_t)(rowbase + pos) * NU + U_VC + gg * CG + c0;
        float xv[32];
#pragma unroll
        for (int j = 0; j < 4; ++j) { const u32x4 a = *(const u32x4*)(vp + 8 * j);
            xv[8 * j + 0] = gelu_tanh(bflo(a.x)); xv[8 * j + 1] = gelu_tanh(bfhi(a.x)); xv[8 * j + 2] = gelu_tanh(bflo(a.y)); xv[8 * j + 3] = gelu_tanh(bfhi(a.y));
            xv[8 * j + 4] = gelu_tanh(bflo(a.z)); xv[8 * j + 5] = gelu_tanh(bfhi(a.z)); xv[8 * j + 6] = gelu_tanh(bflo(a.w)); xv[8 * j + 7] = gelu_tanh(bfhi(a.w)); }
        float s = 0.f;
#pragma unroll
        for (int i = 0; i < 32; ++i) s += xv[i];
        s += __shfl_xor(s, 1); s += __shfl_xor(s, 2);
        const float mu = s * (1.0f / CG); float q = 0.f;
#pragma unroll
        for (int i = 0; i < 32; ++i) { const float d = xv[i] - mu; q += d * d; }
        q += __shfl_xor(q, 1); q += __shfl_xor(q, 2);
        const float rstd = 1.0f / sqrtf(q * (1.0f / CG) + EPS);
        const float* lg = F.ln_v_g + (size_t)l * (GC * CG) + gg * CG + c0; const float* lb = F.ln_v_b + (size_t)l * (GC * CG) + gg * CG + c0;
#pragma unroll
        for (int j = 0; j < 4; ++j) { float hh[8];
#pragma unroll
            for (int e = 0; e < 8; ++e) hh[e] = (xv[8 * j + e] - mu) * rstd * lg[8 * j + e] + lb[8 * j + e];
            u32x4 o; o.x = pk2(hh[0], hh[1]); o.y = pk2(hh[2], hh[3]); o.z = pk2(hh[4], hh[5]); o.w = pk2(hh[6], hh[7]);
            *(LAS u32x4*)(VTl + pos * 136 + c0 + 8 * j) = o; }
    }
    __syncthreads();
    {
        const int pos = 16 * w + c15, row = rowbase + pos;
        const float bsp = F.b_sp[((size_t)l * GC + gg) * MIXC + pos];
        bf16x8 wf[4];
#pragma unroll
        for (int ks = 0; ks < 4; ++ks) wf[ks] = *(const LAS bf16x8*)(Wl + pos * 136 + 32 * ks + 8 * g);
        u32x2 uu8[8];
#pragma unroll
        for (int cb = 0; cb < 8; ++cb) uu8[cb] = *(const u32x2*)(W_U(F) + (size_t)row * NU + U_UC + gg * CG + 16 * cb + 4 * g);
#pragma unroll
        for (int cb = 0; cb < 8; ++cb) { f32x4 acc = (f32x4){0.f, 0.f, 0.f, 0.f};
#pragma unroll
            for (int ks = 0; ks < 4; ++ks) { const LAS bf16* ap = VTl + (32 * ks + 8 * g + (c15 >> 2)) * 136 + 16 * cb + 4 * (c15 & 3); const bf16x8 a = mk8(ATT_TR(ap), ATT_TR(ap + 4 * 136)); acc = MFMA16(a, wf[ks], acc); }
            const int col = gg * CG + 16 * cb + 4 * g;
            const u32x2 uu = uu8[cb];
            u32x2 ov; ov.x = pk2(gelu_tanh(bflo(uu.x)) * (acc[0] + bsp), gelu_tanh(bfhi(uu.x)) * (acc[1] + bsp)); ov.y = pk2(gelu_tanh(bflo(uu.y)) * (acc[2] + bsp), gelu_tanh(bfhi(uu.y)) * (acc[3] + bsp));
            *(u32x2*)(W_MIX(F) + (size_t)row * D + MIX_C + col) = ov; }
    }
    __syncthreads();
}

#ifndef MK_REPMIX
#define MK_REPMIX 0u
#endif
__device__ __forceinline__ void p_mixers(Frame& F, int l) {
    for (int rep = 0; rep < 1 + (int)(MK_REPMIX & 1u); ++rep) { PpRegs R; int un = F.vcu; if (un < 2304) { pp_load_v(F, un, R); pp_load_w(F, l, un, R); pp_load_qk(F, un, R); } for (; un < 2304; un += F.G) { launder(F); gla_prepass(F, l, un, (un + F.G < 2304) ? un + F.G : un, R); } }
    const int na = (l == 0) ? 1152 : 1024, nc = (l == 0) ? 576 : 512;
    for (int rep = 0; rep < 1 + (int)((MK_REPMIX >> 1) & 1u); ++rep) { for (int u = F.vcu; u < na; u += F.G) attn_unit(F, l, u); }
    __syncthreads();
    for (int rep = 0; rep < 1 + (int)((MK_REPMIX >> 2) & 1u); ++rep) { for (int u = (F.vcu + F.G / 2) % F.G; u < nc; u += F.G) gmlp_unit(F, l, u); }
}
__device__ __forceinline__ void p_chains(Frame& F, int l) {
    for (int rep = 0; rep < 1 + (int)((MK_REPMIX >> 3) & 1u); ++rep) for (int ch = F.vcu; ch < 256; ch += F.G) { gla_chain(F, l, ch, rep + 1 < 1 + (int)((MK_REPMIX >> 3) & 1u)); __syncthreads(); }
}

__device__ __forceinline__ void p_glaout(Frame& F, int l) {
    const int gw = F.vcu * NWAVES + F.wave, NGW = F.G * NWAVES, lane = F.lane, nrows = (l == 0) ? NROW : NLAT;
    for (int row = gw; row < nrows; row += NGW) {
#pragma unroll
        for (int j = 0; j < 2; ++j) { const int idx = 512 * j + 8 * lane;
            const u32x4 a = __builtin_nontemporal_load((const u32x4*)(W_OB(F) + (size_t)row * 1024 + idx)), b2 = __builtin_nontemporal_load((const u32x4*)(W_OB(F) + ((size_t)NROW + row) * 1024 + idx));
            float o[8]; o[0] = bflo(a.x) + bflo(b2.x); o[1] = bfhi(a.x) + bfhi(b2.x); o[2] = bflo(a.y) + bflo(b2.y); o[3] = bfhi(a.y) + bfhi(b2.y); o[4] = bflo(a.z) + bflo(b2.z); o[5] = bfhi(a.z) + bfhi(b2.z); o[6] = bflo(a.w) + bflo(b2.w); o[7] = bfhi(a.w) + bfhi(b2.w);
            float ss = 0.f;
#pragma unroll
            for (int e = 0; e < 8; ++e) ss += o[e] * o[e];
#pragma unroll
            for (int s = 1; s < 32; s <<= 1) ss += __shfl_xor(ss, s);
            const float rn = 1.0f / sqrtf(ss * (1.0f / DVB) + EPS);
            const float* gp = F.g_gla + (size_t)l * 1024 + idx; const f32x4 g0 = *(const f32x4*)gp, g1 = *(const f32x4*)(gp + 4);
            const u32x4 gb = __builtin_nontemporal_load((const u32x4*)(W_U(F) + (size_t)row * NU + U_GB + idx));
            float r8[8];
            r8[0] = o[0] * rn * g0[0] * silu_f(bflo(gb.x)); r8[1] = o[1] * rn * g0[1] * silu_f(bfhi(gb.x)); r8[2] = o[2] * rn * g0[2] * silu_f(bflo(gb.y)); r8[3] = o[3] * rn * g0[3] * silu_f(bfhi(gb.y));
            r8[4] = o[4] * rn * g1[0] * silu_f(bflo(gb.z)); r8[5] = o[5] * rn * g1[1] * silu_f(bfhi(gb.z)); r8[6] = o[6] * rn * g1[2] * silu_f(bflo(gb.w)); r8[7] = o[7] * rn * g1[3] * silu_f(bfhi(gb.w));
            u32x4 ov; ov.x = pk2(r8[0], r8[1]); ov.y = pk2(r8[2], r8[3]); ov.z = pk2(r8[4], r8[5]); ov.w = pk2(r8[6], r8[7]);
            *(u32x4*)(W_MIX(F) + (size_t)row * D + MIX_B + idx) = ov; }
    }
}

struct PmRow { u32x4 y[4]; f32x4 x[8]; };
__device__ __forceinline__ void unpack8(const u32x4 a, float* o) { o[0] = bflo(a.x); o[1] = bfhi(a.x); o[2] = bflo(a.y); o[3] = bfhi(a.y); o[4] = bflo(a.z); o[5] = bfhi(a.z); o[6] = bflo(a.w); o[7] = bfhi(a.w); }
__device__ __forceinline__ void postmix_load_y(Frame& F, int row, PmRow& R) {
    const bf16* yp = W_Y(F) + (size_t)row * D + 8 * F.lane;
#pragma unroll
    for (int j = 0; j < 4; ++j) R.y[j] = __builtin_nontemporal_load((const u32x4*)(yp + 512 * j));
}
template <bool FIRST> __device__ __forceinline__ void postmix_load_x(Frame& F, int row, PmRow& R) {
    const int lane = F.lane;
    if constexpr (FIRST) { const float* xin = (row < NLAT ? F.x + (size_t)row * D : F.ctx + (size_t)(row - NLAT) * D) + 8 * lane;
#pragma unroll
        for (int j = 0; j < 4; ++j) { R.x[2 * j] = __builtin_nontemporal_load((const f32x4*)(xin + 512 * j)); R.x[2 * j + 1] = __builtin_nontemporal_load((const f32x4*)(xin + 512 * j + 4)); } }
    else { const bf16* xb = W_XB(F) + (size_t)row * D + 8 * lane;
#pragma unroll
        for (int j = 0; j < 4; ++j) R.x[j] = __builtin_bit_cast(f32x4, __builtin_nontemporal_load((const u32x4*)(xb + 512 * j))); }
}
template <bool FIRST> __device__ __forceinline__ void postmix_s1(Frame& F, int l, int row, const PmRow& R, const u32x4 (&c0p)[4], float (&xv)[32], bool dry) {
    const int lane = F.lane;
    float ss = 0.f;
#pragma unroll
    for (int j = 0; j < 4; ++j) { float y8[8]; unpack8(R.y[j], y8);
#pragma unroll
        for (int e = 0; e < 8; ++e) ss += y8[e] * y8[e]; }
    const float r1 = 1.0f / sqrtf(wave_sum(ss) * (1.0f / D) + EPS);
    bf16* xdst = dry ? (bf16*)(F.ws + WS_DUMMY) + (size_t)row * D : W_XB(F) + (size_t)row * D;
#pragma unroll
    for (int j = 0; j < 4; ++j) { float y8[8], c8[8], x8[8]; unpack8(R.y[j], y8); unpack8(c0p[j], c8);
        if constexpr (FIRST) { x8[0] = R.x[2 * j][0]; x8[1] = R.x[2 * j][1]; x8[2] = R.x[2 * j][2]; x8[3] = R.x[2 * j][3]; x8[4] = R.x[2 * j + 1][0]; x8[5] = R.x[2 * j + 1][1]; x8[6] = R.x[2 * j + 1][2]; x8[7] = R.x[2 * j + 1][3]; }
        else unpack8(__builtin_bit_cast(u32x4, R.x[j]), x8);
#pragma unroll
        for (int e = 0; e < 8; ++e) xv[8 * j + e] = x8[e] + c8[e] * (y8[e] * r1); }
    row_store_bf16(xdst, lane, xv);
}
__device__ __forceinline__ void postmix_s2(Frame& F, int row, const u32x4 (&c1p)[4], const u32x4 (&c2p)[4], float (&xv)[32]) {
    const int lane = F.lane;
    const float r2 = 1.0f / sqrtf(row_sumsq(xv) * (1.0f / D) + EPS);
#pragma unroll
    for (int j = 0; j < 4; ++j) { float c1[8], c2[8]; unpack8(c1p[j], c1); unpack8(c2p[j], c2);
#pragma unroll
        for (int e = 0; e < 8; ++e) xv[8 * j + e] = xv[8 * j + e] * r2 * c1[e] + c2[e]; }
    float am = 0.f;
#pragma unroll
    for (int i = 0; i < 32; ++i) am = fmaxf(am, fabsf(xv[i]));
    am = wave_max(am);
    const float scale = am > 0.f ? am * (1.0f / 127.0f) : 1.0f;
    row_store_i8(W_HQ(F) + (size_t)row * D, lane, xv, 1.0f / scale);
    if (lane == 0) W_HS(F)[row] = scale;
}
template <bool FIRST> __device__ __forceinline__ void p_postmix_t(Frame& F, int l, bool dry) {
    const int gw = F.vcu * NWAVES + F.wave, NGW = F.G * NWAVES, lane = F.lane, nrows = (l == 0) ? NROW : NLAT;
    LAS float* WR = (LAS float*)F.lds;
    for (int i = F.tid; i < D * 4; i += NTHR) { const int k = i >> 2, e4 = (i & 3) * 4; const f32x4 wv = *(const f32x4*)(F.w_router + ((size_t)l * D + k) * NE + e4);
        WR[(e4 + 0) * D + k] = wv[0]; WR[(e4 + 1) * D + k] = wv[1]; WR[(e4 + 2) * D + k] = wv[2]; WR[(e4 + 3) * D + k] = wv[3]; }
    __syncthreads();
    const int npair = nrows / 2, pbase = npair / NGW, prem = npair % NGW;
    const int p0 = gw * pbase + (gw < prem ? gw : prem), p1 = p0 + pbase + (gw < prem ? 1 : 0);
    PmRow RA, RB;
    if (p0 < p1) { postmix_load_y(F, 2 * p0, RA); postmix_load_x<FIRST>(F, 2 * p0, RA); postmix_load_y(F, 2 * p0 + 1, RB); if constexpr (!FIRST) postmix_load_x<FIRST>(F, 2 * p0 + 1, RB); }
    for (int p = p0; p < p1; ++p) {
        launder(F);
        const int row = 2 * p, row2 = row + 1; const bool has2 = true; const int lane = F.lane;
        float h0[32], h1[32];
        {
            const int m0 = row < NLAT ? row / SEQ : 8;
            u32x4 c0p[4], c1p[4], c2p[4]; const bf16* cva = W_CV(F) + ((size_t)l * 9 + m0) * 6 * D + 8 * lane;
#pragma unroll
            for (int j = 0; j < 4; ++j) c0p[j] = *(const u32x4*)(cva + 512 * j);
            if constexpr (FIRST) postmix_load_x<FIRST>(F, row2, RB);
            postmix_s1<FIRST>(F, l, row, RA, c0p, h0, dry);
            asm volatile("" ::: "memory");
#pragma unroll
            for (int j = 0; j < 4; ++j) { c1p[j] = *(const u32x4*)(cva + D + 512 * j); c2p[j] = *(const u32x4*)(cva + 2 * D + 512 * j); }
            postmix_s1<FIRST>(F, l, row2, RB, c0p, h1, dry);
            postmix_s2(F, row, c1p, c2p, h0);
            postmix_s2(F, row2, c1p, c2p, h1);
        }
        asm volatile("" ::: "memory");
        if (p + 1 < p1) { postmix_load_y(F, row + 2, RA); postmix_load_x<FIRST>(F, row + 2, RA); postmix_load_y(F, row + 3, RB); if constexpr (!FIRST) postmix_load_x<FIRST>(F, row + 3, RB); }
        asm volatile("" ::: "memory");
        float a0[16], a1[16];
#pragma unroll
        for (int e = 0; e < 16; ++e) { a0[e] = 0.f; a1[e] = 0.f; }
#pragma unroll
        for (int j = 0; j < 4; ++j) {
#pragma unroll
            for (int e = 0; e < 16; ++e) { const LAS float* wp = WR + e * D + 512 * j + 8 * lane; const f32x4 wa = *(const LAS f32x4*)wp, wb = *(const LAS f32x4*)(wp + 4);
                a0[e] += h0[8 * j] * wa[0] + h0[8 * j + 1] * wa[1] + h0[8 * j + 2] * wa[2] + h0[8 * j + 3] * wa[3] + h0[8 * j + 4] * wb[0] + h0[8 * j + 5] * wb[1] + h0[8 * j + 6] * wb[2] + h0[8 * j + 7] * wb[3];
                a1[e] += h1[8 * j] * wa[0] + h1[8 * j + 1] * wa[1] + h1[8 * j + 2] * wa[2] + h1[8 * j + 3] * wa[3] + h1[8 * j + 4] * wb[0] + h1[8 * j + 5] * wb[1] + h1[8 * j + 6] * wb[2] + h1[8 * j + 7] * wb[3];
                if ((e & 1) == 1) asm volatile("" ::: "memory"); }
        }
        float mx0 = -1e30f, mx1 = -1e30f;
#pragma unroll
        for (int e = 0; e < 16; ++e) { a0[e] = wave_sum(a0[e]); a1[e] = wave_sum(a1[e]); mx0 = fmaxf(mx0, a0[e]); mx1 = fmaxf(mx1, a1[e]); }
        float s0 = 0.f, s1 = 0.f;
#pragma unroll
        for (int e = 0; e < 16; ++e) { a0[e] = __expf(a0[e] - mx0); a1[e] = __expf(a1[e] - mx1); s0 += a0[e]; s1 += a1[e]; }
        float val = 0.f;
#pragma unroll
        for (int e = 0; e < 16; ++e) { if ((lane & 15) == e) val = (lane < 16) ? a0[e] / s0 : a1[e] / s1; }
        if (lane < 16) W_AFF(F)[(size_t)row * NE + lane] = val;
        else if (lane < 32 && has2) W_AFF(F)[(size_t)row2 * NE + (lane & 15)] = val;
    }
}

__device__ __forceinline__ void p_postmix(Frame& F, int l, bool dry) { if (l == 0) p_postmix_t<true>(F, l, dry); else p_postmix_t<false>(F, l, dry); }

__device__ __forceinline__ int block_excl_scan(int v, LAS int* tmp, int lane, int wave, int& total) {
    int inc = v;
#pragma unroll
    for (int o = 1; o < 64; o <<= 1) { const int t = __shfl_up(inc, o); if (lane >= o) inc += t; }
    if (lane == 63) tmp[wave] = inc;
    __syncthreads();
    int base = 0, tot = 0;
#pragma unroll
    for (int ww = 0; ww < 8; ++ww) { const int t = tmp[ww]; tot += t; if (ww < wave) base += t; }
    __syncthreads();
    total = tot; return base + inc - v;
}
__device__ __forceinline__ void p_topk(Frame& F, int l) {
    const int tid = F.tid, lane = F.lane, wave = F.wave;
    LAS int* hist = (LAS int*)F.lds;
    LAS int* misc = (LAS int*)(F.lds + 1024);
    LAS int* stmp = (LAS int*)(F.lds + 1152);
    LAS int* list = (LAS int*)(F.lds + 2048);
    const int nsets = (l == 0) ? 256 : 128, ME = (l == 0) ? ME0 : ME1;
    for (int s = F.vcu; s < nsets; s += F.G) {
        const bool isctx = s >= 128; const int ss = isctx ? s - 128 : s, b = ss >> 4, e = ss & 15;
        const int n = isctx ? CTXL : SEQ, cap = isctx ? CAPC : CAPL, base = isctx ? NLAT + b * CTXL : b * SEQ, slot0 = isctx ? NB * CAPL + b * CAPC : b * CAPL;
        unsigned bits[4];
#pragma unroll
        for (int c = 0; c < 4; ++c) { const int i = 4 * tid + c; bits[c] = (i < n) ? __builtin_bit_cast(unsigned, W_AFF(F)[(size_t)(base + i) * NE + e]) : 0u; }
        unsigned prefix = 0u; int krem = cap;
        for (int pass = 0; pass < 4; ++pass) {
            const int shift = 24 - 8 * pass;
            if (tid < 256) hist[tid] = 0;
            __syncthreads();
#pragma unroll
            for (int c = 0; c < 4; ++c) { const int i = 4 * tid + c; if (i < n && (pass == 0 || (bits[c] >> (shift + 8)) == prefix)) __hip_atomic_fetch_add(&hist[(bits[c] >> shift) & 255u], 1, __ATOMIC_RELAXED, __HIP_MEMORY_SCOPE_WORKGROUP); }
            __syncthreads();
            if (wave == 0) {
                const int h0 = hist[4 * lane], h1 = hist[4 * lane + 1], h2 = hist[4 * lane + 2], h3 = hist[4 * lane + 3];
                const int tot = h0 + h1 + h2 + h3; int suf = tot;
#pragma unroll
                for (int o = 1; o < 64; o <<= 1) { const int t = __shfl_down(suf, o); if (lane + o < 64) suf += t; }
                const int above = suf - tot;
                if (above < krem && krem <= suf) {
                    int a = above, bin, cnt_above;
                    if (a + h3 >= krem) { bin = 3; cnt_above = a; } else { a += h3;
                        if (a + h2 >= krem) { bin = 2; cnt_above = a; } else { a += h2;
                            if (a + h1 >= krem) { bin = 1; cnt_above = a; } else { a += h1; bin = 0; cnt_above = a; } } }
                    misc[0] = 4 * lane + bin; misc[1] = cnt_above;
                }
            }
            __syncthreads();
            prefix = (prefix << 8) | (unsigned)misc[0]; krem -= misc[1];
            __syncthreads();
        }
        int neq = 0;
#pragma unroll
        for (int c = 0; c < 4; ++c) { const int i = 4 * tid + c; if (i < n && bits[c] == prefix) ++neq; }
        int tot_eq; int eqr = block_excl_scan(neq, stmp, lane, wave, tot_eq);
        bool sel[4]; int nsel = 0;
#pragma unroll
        for (int c = 0; c < 4; ++c) { const int i = 4 * tid + c; bool s2 = false; if (i < n) { if (bits[c] > prefix) s2 = true; else if (bits[c] == prefix) { s2 = eqr < krem; ++eqr; } } sel[c] = s2; nsel += s2 ? 1 : 0; }
        int tot_sel; int slot = block_excl_scan(nsel, stmp, lane, wave, tot_sel);
#pragma unroll
        for (int c = 0; c < 4; ++c) { const int i = 4 * tid + c; if (i < n) { int v = -1; if (sel[c]) { if (slot < cap) { list[slot] = i; v = slot0 + slot; } ++slot; } W_TSLOT(F)[(size_t)(base + i) * NE + e] = v; } }
        __syncthreads();
        for (int sl0 = wave; sl0 < cap; sl0 += 4 * NWAVES) {
            u32x4 cr[4][2]; float cs4[4]; int tk[4];
#pragma unroll
            for (int j = 0; j < 4; ++j) { tk[j] = list[sl0 + j * NWAVES]; const signed char* src = W_HQ(F) + (size_t)(base + tk[j]) * D; cr[j][0] = *(const u32x4*)(src + 16 * lane); cr[j][1] = *(const u32x4*)(src + 1024 + 16 * lane); cs4[j] = W_HS(F)[base + tk[j]]; }
#pragma unroll
            for (int j = 0; j < 4; ++j) { const int sl = sl0 + j * NWAVES; signed char* dst = W_XSQ(F) + ((size_t)e * ME + slot0 + sl) * D; *(u32x4*)(dst + 16 * lane) = cr[j][0]; *(u32x4*)(dst + 1024 + 16 * lane) = cr[j][1];
                if (lane == 0) W_XSS(F)[(size_t)e * ME + slot0 + sl] = cs4[j]; }
        }
        __syncthreads();
    }
}

__device__ __forceinline__ void p_actq(Frame& F, int l) {
    const int gw = F.vcu * NWAVES + F.wave, NGW = F.G * NWAVES, lane = F.lane, nrows = NE * ((l == 0) ? ME0 : ME1);
    for (int row = gw; row < nrows; row += 2 * NGW) {
        const int row2 = (row + NGW < nrows) ? row + NGW : row;
        float v[32], v2[32]; row_load_bf16_nt(W_ACT(F) + (size_t)row * FF, lane, v); row_load_bf16_nt(W_ACT(F) + (size_t)row2 * FF, lane, v2);
        const float t1 = W_TM(F)[(size_t)row * 64 + lane], t2 = W_TM(F)[(size_t)row2 * 64 + lane];
        const float am = wave_max(t1), am2 = wave_max(t2);
        const float scale = am > 0.f ? am * (1.0f / 127.0f) : 1.0f, scale2 = am2 > 0.f ? am2 * (1.0f / 127.0f) : 1.0f;
        row_store_i8(W_ACTQ(F) + (size_t)row * FF, lane, v, 1.0f / scale); row_store_i8(W_ACTQ(F) + (size_t)row2 * FF, lane, v2, 1.0f / scale2);
        if (lane == 0) { W_ACTS(F)[row] = scale; W_ACTS(F)[row2] = scale2; }
    }
}

__device__ __forceinline__ void p_combine(Frame& F, int l, bool dry) {
    const int gw = F.vcu * NWAVES + F.wave, NGW = F.G * NWAVES, lane = F.lane, nrows = (l == 0) ? NROW : NLAT, ME = (l == 0) ? ME0 : ME1;
    for (int row = gw; row < nrows; row += NGW) {
        const int m = row < NLAT ? row / SEQ : 8;
        float acc[32];
#pragma unroll
        for (int i = 0; i < 32; ++i) acc[i] = 0.f;
        {
            const int sl16 = (lane < NE) ? W_TSLOT(F)[(size_t)row * NE + lane] : -1; const float gt16 = (lane < NE) ? W_AFF(F)[(size_t)row * NE + lane] : 0.f;
            unsigned long long msk = __ballot(sl16 >= 0);
            while (msk) {
                int ee[4]; int ns = 0;
#pragma unroll
                for (int j = 0; j < 4; ++j) { ee[j] = msk ? (int)__builtin_ctzll(msk) : 0; if (msk) { ++ns; msk &= msk - 1; } }
                u32x4 yr[4][4]; float gg[4];
#pragma unroll
                for (int j = 0; j < 4; ++j) if (j < ns) {
                    const int slot = __builtin_amdgcn_readlane(sl16, ee[j]); gg[j] = __builtin_bit_cast(float, __builtin_amdgcn_readlane(__builtin_bit_cast(int, gt16), ee[j]));
                    const bf16* yp = W_XS(F) + ((size_t)ee[j] * ME + slot) * D + 8 * lane;
#pragma unroll
                    for (int q = 0; q < 4; ++q) yr[j][q] = __builtin_nontemporal_load((const u32x4*)(yp + 512 * q)); }
#pragma unroll
                for (int j = 0; j < 4; ++j) if (j < ns) {
#pragma unroll
                    for (int q = 0; q < 4; ++q) { const u32x4 a = yr[j][q];
                        acc[8 * q + 0] += gg[j] * bflo(a.x); acc[8 * q + 1] += gg[j] * bfhi(a.x); acc[8 * q + 2] += gg[j] * bflo(a.y); acc[8 * q + 3] += gg[j] * bfhi(a.y);
                        acc[8 * q + 4] += gg[j] * bflo(a.z); acc[8 * q + 5] += gg[j] * bfhi(a.z); acc[8 * q + 6] += gg[j] * bflo(a.w); acc[8 * q + 7] += gg[j] * bfhi(a.w); } }
            }
        }
        const float r1 = 1.0f / sqrtf(row_sumsq(acc) * (1.0f / D) + EPS);
        float xv[32], c3[32];
        row_load_bf16_nt(W_XB(F) + (size_t)row * D, lane, xv); row_load_bf16(W_CV(F) + (((size_t)l * 9 + m) * 6 + 3) * D, lane, c3);
#pragma unroll
        for (int i = 0; i < 32; ++i) xv[i] = xv[i] + c3[i] * (acc[i] * r1);
        if (l + 1 < DEPTH) row_store_bf16(dry ? (bf16*)(F.ws + WS_DUMMY) + (size_t)row * D : W_XB(F) + (size_t)row * D, lane, xv);
        else row_store_f32(dry ? (float*)(F.ws + WS_DUMMY) + (size_t)(row & 8191) * D : F.out + (size_t)row * D, lane, xv);
        if (l + 1 < DEPTH) prenorm_row_cv(F, l + 1, m, xv, row);
    }
}
struct Args { const float* in[24]; float* out; unsigned char* ws; int ph_lo, ph_hi; };
constexpr int NPHASE = 2 + 11 * DEPTH;
__global__ void __launch_bounds__(NTHR, 2) mk_fwd(Args args) {
    extern __shared__ __attribute__((aligned(16))) unsigned char lds_raw[];
    Frame F;
    F.lds = (LAS unsigned char*)lds_raw;
    F.tid = threadIdx.x; F.lane = F.tid & 63; F.wave = __builtin_amdgcn_readfirstlane(F.tid >> 6);
    F.G = gridDim.x; { const int bx = blockIdx.x; F.vcu = (F.G % 8 == 0) ? (bx % 8) * (F.G / 8) + bx / 8 : bx; }
    F.x = args.in[0]; F.c = args.in[1]; F.ctx = args.in[2]; F.c_ctx = args.in[3]; F.w_ada = args.in[4]; F.b_ada = args.in[5]; F.g_pre_mix = args.in[6]; F.g_post_mix = args.in[7];
    F.g_pre_ffn = args.in[8]; F.g_post_ffn = args.in[9]; F.w_in = args.in[10]; F.w_dec = args.in[11]; F.b_dec = args.in[12]; F.rpb = args.in[13]; F.g_gla = args.in[14]; F.ln_v_g = args.in[15];
    F.ln_v_b = args.in[16]; F.w_sp = args.in[17]; F.b_sp = args.in[18]; F.w_out = args.in[19]; F.w_router = args.in[20]; F.w_gate = args.in[21]; F.w_up = args.in[22]; F.w_down = args.in[23];
    F.out = args.out;
    unsigned char* ws = args.ws;
    F.ws = ws;

    const int lo = args.ph_lo, hi = args.ph_hi;
    unsigned* ctl = (unsigned*)(ws + WS_CTL);
    if (F.tid < 16) ((LAS unsigned*)(F.lds + LDS_XB))[F.tid] = 0u;
    __syncthreads();
    XcdBarrier bar; bar.bar = (unsigned*)(ws + WS_CTL) + CW_BAR; bar.x = 0; bar.st = nullptr;
    if (hi - lo > 1) bar = xcd_barrier_post((unsigned*)(ws + WS_CTL) + CW_BAR, (volatile LAS unsigned*)(F.lds + LDS_XB));
#ifndef MK_MASK
#define MK_MASK 0xFFFFFFFFu
#endif
#define PH(b) ((MK_MASK >> (b)) & 1u)
#ifndef MK_REP
#define MK_REP 0u
#endif
#define NREP(b) (1 + (int)((MK_REP >> (b)) & 1u))
#define REPBAR(b, rep) do { if ((rep) + 1 < NREP(b)) xcd_barrier(bar); } while (0)
#define IN(k) (lo <= (k) && (k) < hi)
#define SEAM(k) do { if (IN(k) && IN((k) + 1)) xcd_barrier(bar); } while (0)

    if (PH(0) && IN(0)) { for (int rep = 0; rep < NREP(0); ++rep) { launder(F); p0a(F); REPBAR(0, rep); } } SEAM(0);
    if (PH(1) && IN(1)) { for (int rep = 0; rep < NREP(1); ++rep) { launder(F); p0b(F); REPBAR(1, rep); } } SEAM(1);
    for (int l = 0; l < DEPTH; ++l) {
        const int pb = 2 + 11 * l;
        if (PH(2) && IN(pb + 0)) {
          for (int rep = 0; rep < NREP(2); ++rep) {
            launder(F);
            pg8::Gemm g{(const pg8::bf16_t*)W_HQ(F), (const pg8::bf16_t*)(F.ws + WS_WIN + (size_t)l * NU * D), NROW, NU, D / 2};
            constexpr int GG = 237;
            unsigned* sig = ctl + CW_SIG + 64 * (pb + 0);
            if ((int)blockIdx.x < GG || F.G != 256) {
                pg8::GroupedOrder S; S.init(1, NROW / 256, NU / 256, F.G == 256 ? GG : F.G, (int)blockIdx.x, sig);
                pg8::EpiStoreI8 E{W_U(F), NU, NU / 256, W_HS(F), W_SIN(F) + (size_t)l * NU};
                pg8::gemm_phase<pg8::EpiStoreI8, pg8::GroupedOrder, true, true>(F.lds, g, S, E, F.tid);
            } else bg_loop(F, ctl, sig, BG_TOTAL);
            REPBAR(2, rep); }
        } SEAM(pb + 0);
        if (PH(3) && IN(pb + 1)) { for (int rep = 0; rep < NREP(3); ++rep) { launder(F); p_mixers(F, l); REPBAR(3, rep); } } SEAM(pb + 1);
        if (PH(11) && IN(pb + 2)) { for (int rep = 0; rep < NREP(11); ++rep) { launder(F); p_chains(F, l); REPBAR(11, rep); } } SEAM(pb + 2);
        if (PH(4) && IN(pb + 3)) { for (int rep = 0; rep < NREP(4); ++rep) { launder(F); p_glaout(F, l); REPBAR(4, rep); } } SEAM(pb + 3);
        if (PH(5) && IN(pb + 4)) {
          for (int rep = 0; rep < NREP(5); ++rep) {
            launder(F);
            const int M = (l == 0) ? NROW : NLAT;
            pg8::Gemm g{W_MIX(F), W_WOUT(F) + (size_t)l * D * D, M, D, D};
            const int GG = (l == 0) ? 192 : 256;
            unsigned* sig = ctl + CW_SIG + 64 * (pb + 4);
            if ((int)blockIdx.x < GG || F.G != 256) {
                pg8::GroupedOrder S; S.init(1, M / 256, D / 256, F.G == 256 ? GG : F.G, (int)blockIdx.x, sig);
                pg8::EpiStore E{W_Y(F), D, D / 256};
                pg8::gemm_phase<pg8::EpiStore, pg8::GroupedOrder, true, true>(F.lds, g, S, E, F.tid);
            } else bg_loop(F, ctl, sig, BG_TOTAL);
            REPBAR(5, rep); }
        } SEAM(pb + 4);
        if (PH(6) && IN(pb + 5)) { if (MK_REPMIX & 16u) { launder(F); p_postmix(F, l, true); xcd_barrier(bar); } launder(F); p_postmix(F, l, false); } SEAM(pb + 5);
        if (PH(7) && IN(pb + 6)) { for (int rep = 0; rep < NREP(7); ++rep) { launder(F); p_topk(F, l); launder(F); bg_loop(F, ctl, nullptr, l == 0 ? BG_A : BG_TOTAL); REPBAR(7, rep); } } SEAM(pb + 6);
        if (PH(8) && IN(pb + 7)) {
          for (int rep = 0; rep < NREP(8); ++rep) {
            launder(F);
            const int ME = (l == 0) ? ME0 : ME1;
            pg8::Gemm g{(const pg8::bf16_t*)W_XSQ(F), (const pg8::bf16_t*)((F).ws + WS_W1 + (size_t)l * NE * (2 * FF) * D), NE * ME, NE * 2 * FF, D / 2};
            pg8::GroupedOrder S; S.init(NE, ME / 256, 2 * FF / 256, F.G, (int)blockIdx.x);
            pg8::EpiSwiGLUI8 E{W_ACT(F), FF, 2 * FF / 256, W_XSS(F), W_S1(F) + (size_t)l * NE * (2 * FF), W_TM(F)};
            pg8::gemm_phase<pg8::EpiSwiGLUI8, pg8::GroupedOrder, true, true>(F.lds, g, S, E, F.tid); REPBAR(8, rep); }
        } SEAM(pb + 7);
        if (PH(12) && IN(pb + 8)) { launder(F); p_actq(F, l); } SEAM(pb + 8);
        if (PH(9) && IN(pb + 9)) {
          for (int rep = 0; rep < NREP(9); ++rep) {
            launder(F);
            const int ME = (l == 0) ? ME0 : ME1;
            pg8::Gemm g{(const pg8::bf16_t*)W_ACTQ(F), (const pg8::bf16_t*)((F).ws + WS_W2 + (size_t)l * NE * D * FF), NE * ME, NE * D, FF / 2};
            const int GG = (l == 0) ? 231 : 256;
            unsigned* sig = ctl + CW_SIG + 64 * (pb + 9);
            if ((int)blockIdx.x < GG || F.G != 256) {
                pg8::GroupedOrder S; S.init(NE, ME / 256, D / 256, F.G == 256 ? GG : F.G, (int)blockIdx.x, sig);
                pg8::EpiStoreI8 E{W_XS(F), D, D / 256, W_ACTS(F), W_S2(F) + (size_t)l * NE * D};
                pg8::gemm_phase<pg8::EpiStoreI8, pg8::GroupedOrder, true, true>(F.lds, g, S, E, F.tid);
            } else bg_loop(F, ctl, sig, BG_TOTAL);
            REPBAR(9, rep); }
        } SEAM(pb + 9);
        if (PH(10) && IN(pb + 10)) { if (MK_REPMIX & 32u) { launder(F); p_combine(F, l, true); xcd_barrier(bar); } launder(F); p_combine(F, l, false); if (l == 0) { launder(F); bg_loop(F, ctl, nullptr, BG_B); } } SEAM(pb + 10);
    }
#undef IN
#undef SEAM
}

extern "C" void kernel_launch(void* const* d_in, const int* in_sizes, int n_in, void* d_out, int out_size, void* d_ws, size_t ws_size, hipStream_t stream) {
    static int grid = 0;
    if (grid == 0) {
        if (n_in != 24 || out_size != NLAT * D || ws_size < WS_END2) { fprintf(stderr, "kernel_launch: unexpected shapes (n_in %d out %d ws %zu)\n", n_in, out_size, ws_size); grid = -1; return; }
        int dev = 0, cus = 0, per_cu = 0;
        if (hipGetDevice(&dev) != hipSuccess || hipDeviceGetAttribute(&cus, hipDeviceAttributeMultiprocessorCount, dev) != hipSuccess) { grid = -1; return; }
        if (hipFuncSetAttribute((const void*)mk_fwd, hipFuncAttributeMaxDynamicSharedMemorySize, LDS_BYTES) != hipSuccess) { fprintf(stderr, "kernel_launch: hipFuncSetAttribute failed\n"); grid = -1; return; }
        if (hipOccupancyMaxActiveBlocksPerMultiprocessor(&per_cu, (const void*)mk_fwd, NTHR, LDS_BYTES) != hipSuccess || per_cu < 1) { fprintf(stderr, "kernel_launch: occupancy query says %d\n", per_cu); }
        (void)hipGetLastError();
        grid = cus;
    }
    if (grid < 0) return;
    if (hipMemsetAsync((char*)d_ws + WS_CTL, 0, CTL_ZERO_BYTES, stream) != hipSuccess) return;
    Args a{};
    for (int i = 0; i < 24; ++i) a.in[i] = (const float*)d_in[i];
    a.out = (float*)d_out; a.ws = (unsigned char*)d_ws;
#if MK_N_LAUNCHES == 1
    a.ph_lo = 0; a.ph_hi = NPHASE;
    hipLaunchKernelGGL(mk_fwd, dim3(grid), dim3(NTHR), LDS_BYTES, stream, a);
#else
    for (int p = 0; p < NPHASE; ++p) { a.ph_lo = p; a.ph_hi = p + 1; hipLaunchKernelGGL(mk_fwd, dim3(grid), dim3(NTHR), LDS_BYTES, stream, a); }
#endif
}
```
